# Optimizing an MI355X kernel written in HIP

```python
import jax, jax.numpy as jnp
from jax import lax
import numpy as np

D_MODEL = 2048
BATCH = 2
SEQ = 8192
DEPTH = 1

D_FF = 5632
POOL_WINDOWS = (2, 4, 8, 16)
POOL_GROUPS = 4
POOL_GROUP_DIM = 256
POOL_WIDTH = POOL_GROUPS * POOL_GROUP_DIM
N_HEADS = 16
N_KV_GROUPS = 4
HEADS_PER_GROUP = N_HEADS // N_KV_GROUPS
HEAD_DIM = 128
Q_WIDTH = N_HEADS * HEAD_DIM
KV_WIDTH = N_KV_GROUPS * HEAD_DIM
CMP_BLOCK = 32
CMP_STRIDE = 16
CMP_HIDDEN = 256
SEL_BLOCK = 64
SEL_TOPK = 16
WINDOW = 512
NSA_Q_BLOCK = 64
N_NSA_BRANCHES = 3
FORCE_BONUS = 1000.0
IN_WIDTH = POOL_WIDTH + Q_WIDTH + 6 * KV_WIDTH + N_NSA_BRANCHES * N_HEADS + 2 * D_MODEL
RMS_EPS = 1e-6

kernel_name = 'hybrid_pool_nsa_macaron_block'


def rms_norm(x, g):
    xf = x.astype(jnp.float32)
    y = xf * lax.rsqrt(jnp.mean(xf * xf, axis=-1, keepdims=True) + RMS_EPS)
    return (y * g.astype(jnp.float32)).astype(x.dtype)


def swiglu(x, w_gate, w_up, w_down):
    return (jax.nn.silu(x @ w_gate) * (x @ w_up)) @ w_down


def masked_softmax(s, mask):
    s = jnp.where(mask, s.astype(jnp.float32), -jnp.inf)
    m = jnp.max(s, axis=-1, keepdims=True)
    m = jnp.where(jnp.isfinite(m), m, 0.0)
    p = jnp.exp(s - m)
    return p / jnp.maximum(jnp.sum(p, axis=-1, keepdims=True), 1e-30)


def pool_mixer(xp, pool_w, pool_scale):
    B, S, _ = xp.shape
    xf = xp.astype(jnp.float32)
    csum = jnp.concatenate([jnp.zeros((B, 1, POOL_WIDTH), jnp.float32), jnp.cumsum(xf, axis=1)], axis=1)
    t = jnp.arange(S)
    outs = []
    for gi, win in enumerate(POOL_WINDOWS):
        sl = slice(gi * POOL_GROUP_DIM, (gi + 1) * POOL_GROUP_DIM)
        cg = csum[..., sl]
        lo = jnp.maximum(t + 1 - win, 0)
        cnt = jnp.minimum(t + 1, win).astype(jnp.float32)
        outs.append((cg[:, 1:] - cg[:, lo]) / cnt[None, :, None] - xf[..., sl])
    pooled = jnp.stack(outs, axis=2).astype(xp.dtype)
    y = jnp.einsum('bsgc,gcd->bsgd', pooled, pool_w).reshape(B, S, POOL_WIDTH)
    return y * pool_scale


def compress_blocks(t, pe, w1, w2):
    B, S, G, Dh = t.shape
    n_sub = CMP_BLOCK // CMP_STRIDE
    n_chunk = S // CMP_STRIDE
    n_cmp = n_chunk - n_sub + 1
    c = t.reshape(B, n_chunk, CMP_STRIDE, G, Dh)
    blocks = jnp.concatenate([c[:, i:i + n_cmp] for i in range(n_sub)], axis=2)
    blocks = blocks + pe[None, None, :, None, :]
    flat = jnp.transpose(blocks, (0, 1, 3, 2, 4)).reshape(B, n_cmp, G, CMP_BLOCK * Dh)
    return jax.nn.silu(flat @ w1) @ w2


def nsa_mixer(q, kc, vc, ks, vs, kw, vw, gate_logits, pe_k, pe_v, k_w1, k_w2, v_w1, v_w2):
    B, S = q.shape[0], q.shape[1]
    G, HPG, DH = N_KV_GROUPS, HEADS_PER_GROUP, HEAD_DIM
    q = q.reshape(B, S, G, HPG, DH) * (DH ** -0.5)
    kc, vc, ks, vs, kw, vw = [a.reshape(B, S, G, DH) for a in (kc, vc, ks, vs, kw, vw)]
    gates = jax.nn.sigmoid(gate_logits.reshape(B, S, N_NSA_BRANCHES, G, HPG))

    k_cmp = compress_blocks(kc, pe_k, k_w1, k_w2)
    v_cmp = compress_blocks(vc, pe_v, v_w1, v_w2)
    n_cmp = k_cmp.shape[1]
    cmp_start = jnp.arange(n_cmp) * CMP_STRIDE
    cmp_end = cmp_start + CMP_BLOCK - 1

    n_blk = S // SEL_BLOCK
    n_sel = min(SEL_TOPK, n_blk)
    blk = jnp.arange(n_blk)
    sel_start = blk * SEL_BLOCK
    overlap = ((cmp_start[:, None] <= sel_start[None, :] + SEL_BLOCK - 1)
               & (cmp_end[:, None] >= sel_start[None, :])).astype(jnp.float32)
    ksb = jnp.transpose(ks.reshape(B, n_blk, SEL_BLOCK, G, DH), (0, 3, 1, 2, 4))
    vsb = jnp.transpose(vs.reshape(B, n_blk, SEL_BLOCK, G, DH), (0, 3, 1, 2, 4))
    b_idx = jnp.arange(B)[:, None, None, None]
    g_idx = jnp.arange(G)[None, None, :, None]

    kwp = jnp.pad(kw, ((0, 0), (WINDOW, 0), (0, 0), (0, 0)))
    vwp = jnp.pad(vw, ((0, 0), (WINDOW, 0), (0, 0), (0, 0)))

    def q_block(i):
        s0 = i * NSA_Q_BLOCK
        qb = lax.dynamic_slice_in_dim(q, s0, NSA_Q_BLOCK, axis=1)
        gb = lax.dynamic_slice_in_dim(gates, s0, NSA_Q_BLOCK, axis=1)
        t = s0 + jnp.arange(NSA_Q_BLOCK)

        s_c = jnp.einsum('bqghd,bngd->bqghn', qb, k_cmp)
        m_c = (cmp_end[None, :] <= t[:, None])[None, :, None, None, :]
        p_c = masked_softmax(s_c, m_c)
        o_c = jnp.einsum('bqghn,bngd->bqghd', p_c.astype(v_cmp.dtype), v_cmp)

        imp = jnp.einsum('bqghn,nm->bqgm', p_c, overlap)
        cur = t // SEL_BLOCK
        valid = sel_start[None, :] <= t[:, None]
        forced = (blk[None, :] == 0) | (blk[None, :] == cur[:, None]) | (blk[None, :] == cur[:, None] - 1)
        score = jnp.where(valid[None, :, None, :],
                          imp + jnp.where(forced, FORCE_BONUS, 0.0)[None, :, None, :], -FORCE_BONUS)
        top_v, top_i = lax.top_k(score, n_sel)
        sel_ok = top_v > -1.0
        k_g = ksb[b_idx, g_idx, top_i]
        v_g = vsb[b_idx, g_idx, top_i].reshape(B, NSA_Q_BLOCK, G, n_sel * SEL_BLOCK, DH)
        s_s = jnp.einsum('bqghd,bqgnld->bqghnl', qb, k_g).reshape(B, NSA_Q_BLOCK, G, HPG, n_sel * SEL_BLOCK)
        kpos = (top_i[..., None] * SEL_BLOCK + jnp.arange(SEL_BLOCK)).reshape(B, NSA_Q_BLOCK, G, n_sel * SEL_BLOCK)
        m_s = jnp.repeat(sel_ok, SEL_BLOCK, axis=-1) & (kpos <= t[None, :, None, None])
        p_s = masked_softmax(s_s, m_s[:, :, :, None, :])
        o_s = jnp.einsum('bqghk,bqgkd->bqghd', p_s.astype(v_g.dtype), v_g)

        k_w = lax.dynamic_slice_in_dim(kwp, s0, NSA_Q_BLOCK + WINDOW, axis=1)
        v_w = lax.dynamic_slice_in_dim(vwp, s0, NSA_Q_BLOCK + WINDOW, axis=1)
        kpos_w = s0 - WINDOW + jnp.arange(NSA_Q_BLOCK + WINDOW)
        m_w = ((kpos_w[None, :] <= t[:, None]) & (kpos_w[None, :] > t[:, None] - WINDOW)
               & (kpos_w[None, :] >= 0))[None, :, None, None, :]
        s_w = jnp.einsum('bqghd,bkgd->bqghk', qb, k_w)
        p_w = masked_softmax(s_w, m_w)
        o_w = jnp.einsum('bqghk,bkgd->bqghd', p_w.astype(v_w.dtype), v_w)

        return (gb[:, :, 0, :, :, None] * o_c + gb[:, :, 1, :, :, None] * o_s
                + gb[:, :, 2, :, :, None] * o_w)

    out = lax.map(q_block, jnp.arange(S // NSA_Q_BLOCK))
    return jnp.moveaxis(out, 0, 1).reshape(B, S, Q_WIDTH)


def setup_inputs(seed: int = 0) -> dict:
    key = jax.random.key(seed)
    k = jax.random.split(key, 23)
    L = DEPTH
    f32 = jnp.float32

    def w(kk, shape, fan_in):
        return jax.random.normal(kk, shape, f32) * (fan_in ** -0.5)

    def gain(kk, shape):
        return 1.0 + 0.02 * jax.random.normal(kk, shape, f32)

    return {
        'x': jax.random.normal(k[0], (BATCH, SEQ, D_MODEL), f32),
        'ffn1_norm': gain(k[1], (L, D_MODEL)),
        'ffn1_w_gate': w(k[2], (L, D_MODEL, D_FF), D_MODEL),
        'ffn1_w_up': w(k[3], (L, D_MODEL, D_FF), D_MODEL),
        'ffn1_w_down': w(k[4], (L, D_FF, D_MODEL), D_FF),
        'mix_norm': gain(k[5], (L, D_MODEL)),
        'w_in': w(k[6], (L, D_MODEL, IN_WIDTH), D_MODEL),
        'pool_w': w(k[7], (L, POOL_GROUPS, POOL_GROUP_DIM, POOL_GROUP_DIM), POOL_GROUP_DIM),
        'pool_scale': gain(k[8], (L, POOL_WIDTH)),
        'cmp_pe_k': 0.1 * jax.random.normal(k[9], (L, CMP_BLOCK, HEAD_DIM), f32),
        'cmp_pe_v': 0.1 * jax.random.normal(k[10], (L, CMP_BLOCK, HEAD_DIM), f32),
        'cmp_k_w1': w(k[11], (L, CMP_BLOCK * HEAD_DIM, CMP_HIDDEN), CMP_BLOCK * HEAD_DIM),
        'cmp_k_w2': w(k[12], (L, CMP_HIDDEN, HEAD_DIM), CMP_HIDDEN),
        'cmp_v_w1': w(k[13], (L, CMP_BLOCK * HEAD_DIM, CMP_HIDDEN), CMP_BLOCK * HEAD_DIM),
        'cmp_v_w2': w(k[14], (L, CMP_HIDDEN, HEAD_DIM), CMP_HIDDEN),
        'w_pool_up': w(k[15], (L, POOL_WIDTH, D_MODEL), POOL_WIDTH),
        'w_nsa_up': w(k[16], (L, Q_WIDTH, D_MODEL), Q_WIDTH),
        'w_out': w(k[17], (L, D_MODEL, D_MODEL), D_MODEL),
        'ffn2_norm': gain(k[18], (L, D_MODEL)),
        'ffn2_w_gate': w(k[19], (L, D_MODEL, D_FF), D_MODEL),
        'ffn2_w_up': w(k[20], (L, D_MODEL, D_FF), D_MODEL),
        'ffn2_w_down': w(k[21], (L, D_FF, D_MODEL), D_FF),
        'final_norm': gain(k[22], (D_MODEL,)),
    }


def reference(x, ffn1_norm, ffn1_w_gate, ffn1_w_up, ffn1_w_down, mix_norm, w_in, pool_w, pool_scale,
              cmp_pe_k, cmp_pe_v, cmp_k_w1, cmp_k_w2, cmp_v_w1, cmp_v_w2, w_pool_up, w_nsa_up, w_out,
              ffn2_norm, ffn2_w_gate, ffn2_w_up, ffn2_w_down, final_norm):
    splits = np.cumsum([POOL_WIDTH, Q_WIDTH] + [KV_WIDTH] * 6 + [N_NSA_BRANCHES * N_HEADS, D_MODEL])
    h = x
    for l in range(DEPTH):
        h = h + 0.5 * swiglu(rms_norm(h, ffn1_norm[l]), ffn1_w_gate[l], ffn1_w_up[l], ffn1_w_down[l])
        u = rms_norm(h, mix_norm[l])
        proj = u @ w_in[l]
        (xp, q, kc, vc, ks, vs, kw, vw, nsa_g, g_pool, g_nsa) = jnp.split(proj, splits, axis=-1)
        a = pool_mixer(xp, pool_w[l], pool_scale[l])
        b = nsa_mixer(q, kc, vc, ks, vs, kw, vw, nsa_g, cmp_pe_k[l], cmp_pe_v[l],
                      cmp_k_w1[l], cmp_k_w2[l], cmp_v_w1[l], cmp_v_w2[l])
        merged = jax.nn.sigmoid(g_pool) * (a @ w_pool_up[l]) + jax.nn.sigmoid(g_nsa) * (b @ w_nsa_up[l])
        h = h + merged @ w_out[l]
        h = h + 0.5 * swiglu(rms_norm(h, ffn2_norm[l]), ffn2_w_gate[l], ffn2_w_up[l], ffn2_w_down[l])
    return rms_norm(h, final_norm)
```

```cpp
#include <hip/hip_runtime.h>
#include <hip/hip_cooperative_groups.h>
#include <cstdio>
#include <cstdint>
namespace cg = cooperative_groups;
namespace pg8 {
#define PG8_LAS __attribute__((address_space(3)))
typedef unsigned short bf16_t;
typedef short bf16x8 __attribute__((ext_vector_type(8)));
typedef float f32x4 __attribute__((ext_vector_type(4)));
typedef unsigned u32x4 __attribute__((ext_vector_type(4)));
constexpr int BM = 256, BK = 64, HALF = 128, HTB = HALF * BK * 2  , STAGE_BYTES = 8 * HTB, NXCD = 8, WGM = 8;

__host__ __device__ __forceinline__ int lds_byte(int r, int c) { const int st = (r >> 4) * 2 + (c >> 5), rr = r & 15, cc = c & 31, ob = rr * 64 + cc * 2; return st * 1024 + (ob ^ (((ob >> 9) & 1) << 5)); }
__host__ __device__ __forceinline__ void stage_rc(int b, int& R, int& C) { const int st = b / 1024, sb = b % 1024, swz = sb ^ (((sb >> 9) & 1) << 5); R = (st >> 1) * 16 + swz / 64; C = (st & 1) * 32 + (swz % 64) / 2; }
__host__ __device__ __forceinline__ int perm32(int rho) { const int n = rho >> 4, i = rho & 15; return 8 * (i >> 2) + 4 * n + (i & 3); }

struct Unit { int pm, pn; };
struct Gemm { const bf16_t* A; const bf16_t* Bt; int M, N, K, lda, ldb; int apn  , bdiv, bbytes  ; };

struct StaticOrder {
    int nM, nN, nwg, G, c;
    __host__ __device__ void init(int M, int N, int G_, int c_) { nM = M / BM; nN = N / BM; nwg = nM * nN; G = G_; c = c_; }
    __host__ __device__ bool next(int i, Unit& u) const {
        const long L = (long)i * G + c; if (L >= nwg) return false;
        int wgid = (int)L; { const int q = nwg / NXCD, r = nwg % NXCD, xcd = wgid % NXCD, off = wgid / NXCD; wgid = (xcd < r ? xcd * (q + 1) : r * (q + 1) + (xcd - r) * q) + off; }
        const int nig = WGM * nN, gid = wgid / nig, fm = gid * WGM, gsz = (nM - fm) < WGM ? (nM - fm) : WGM;
        u.pm = fm + ((wgid % nig) % gsz); u.pn = (wgid % nig) / gsz; return true;
    }
    __device__ __forceinline__ void a_ready(const Unit&) const {}
    __device__ __forceinline__ void done(const Unit&) const {}
};

__device__ __forceinline__ unsigned cvt_pk_bf16(float lo, float hi) { unsigned r; asm volatile("v_cvt_pk_bf16_f32 %0, %1, %2" : "=v"(r) : "v"(lo), "v"(hi)); return r; }
__device__ __forceinline__ float bf_lo(unsigned w) { return __builtin_bit_cast(float, w << 16); }
__device__ __forceinline__ float bf_hi(unsigned w) { return __builtin_bit_cast(float, w & 0xffff0000u); }
__device__ __forceinline__ float sigmoidf_(float x) { return __builtin_amdgcn_rcpf(1.f + __builtin_amdgcn_exp2f(-1.4426950408889634f * x)); }
__device__ __forceinline__ float siluf_(float x) { return x * sigmoidf_(x); }
__device__ __forceinline__ u32x4 pack8(f32x4 a, f32x4 b) { u32x4 w; w.x = cvt_pk_bf16(a[0], a[1]); w.y = cvt_pk_bf16(a[2], a[3]); w.z = cvt_pk_bf16(b[0], b[1]); w.w = cvt_pk_bf16(b[2], b[3]); return w; }

template <class F> struct EpiP8 {
    static constexpr bool PERM = true, AFTER_DRAIN = false;
    F f;
    __device__ __forceinline__ void operator()(const f32x4 (&acc)[2][2][4][2], const Unit& u, int wr, int wc, int fr, int fq) const {
        const int row0 = u.pm * BM + wr * 64 + fr, col0 = u.pn * BM + wc * 32 + 8 * fq;
#pragma unroll
        for (int ai = 0; ai < 2; ++ai)
#pragma unroll
            for (int m = 0; m < 4; ++m) {
                const int row = row0 + ai * HALF + m * 16;
#pragma unroll
                for (int bj = 0; bj < 2; ++bj) f(row, col0 + bj * HALF, u.pn, acc[ai][bj][m][0], acc[ai][bj][m][1]);
            }
    }
};
struct EpiSwiglu {
    static constexpr bool PERM = true, AFTER_DRAIN = false;
    bf16_t* O; int ldc;
    __device__ __forceinline__ void operator()(const f32x4 (&acc)[2][2][4][2], const Unit& u, int wr, int wc, int fr, int fq) const {
        const int row0 = u.pm * BM + wr * 64 + fr, col0 = u.pn * HALF + wc * 32 + 8 * fq;
#pragma unroll
        for (int ai = 0; ai < 2; ++ai)
#pragma unroll
            for (int m = 0; m < 4; ++m) {
                const int row = row0 + ai * HALF + m * 16;
                f32x4 h0, h1;
#pragma unroll
                for (int j = 0; j < 4; ++j) { h0[j] = siluf_(acc[ai][0][m][0][j]) * acc[ai][1][m][0][j]; h1[j] = siluf_(acc[ai][0][m][1][j]) * acc[ai][1][m][1][j]; }
                *(u32x4*)(O + (size_t)row * ldc + col0) = pack8(h0, h1);
            }
    }
};
struct EpiResF32 {
    static constexpr bool PERM = false, AFTER_DRAIN = false;
    const float* base; float* out; int ldc; float coef;
    __device__ __forceinline__ void operator()(const f32x4 (&acc)[2][2][4][2], const Unit& u, int wr, int wc, int fr, int fq) const {
        const int row0 = u.pm * BM + wr * 64 + fr, col0 = u.pn * BM + wc * 32 + 4 * fq;
#pragma unroll
        for (int ai = 0; ai < 2; ++ai)
#pragma unroll
            for (int m = 0; m < 4; ++m) {
                const size_t off = (size_t)(row0 + ai * HALF + m * 16) * ldc + col0;
#pragma unroll
                for (int bj = 0; bj < 2; ++bj)
#pragma unroll
                    for (int n = 0; n < 2; ++n) { const f32x4 b = *(const f32x4*)(base + off + bj * HALF + n * 16); *(f32x4*)(out + off + bj * HALF + n * 16) = b + acc[ai][bj][m][n] * coef; }
            }
    }
};
template <class Epi, class Sched, bool ALIGN_EPI = false, bool SP2 = false>
__device__ __forceinline__ void gemm_phase(PG8_LAS unsigned char* lds, const Gemm g, const Sched& S, const Epi& E) {
    const int tid = threadIdx.x, wid = __builtin_amdgcn_readfirstlane(tid >> 6), lane = tid & 63, wr = wid >> 2, wc = wid & 3, fr = lane & 15, fq = lane >> 4;
    const int K = g.K, nt = K / BK;
    unsigned voffA[2], voffB[2];
#pragma unroll
    for (int i = 0; i < 2; ++i) { int R, C; stage_rc(tid * 16 + i * 8192, R, C); const int Rb = Epi::PERM ? ((R & ~31) + perm32(R & 31)) : R;
        voffA[i] = (unsigned)(R * g.lda + C) * 2u; voffB[i] = (unsigned)(Rb * g.ldb + C) * 2u; }
    const size_t kstep = (size_t)(BK * 2);
    const size_t hstepA = (size_t)HALF * g.lda * 2, hstepB = (size_t)HALF * g.ldb * 2;
    const size_t tstepA = 2 * hstepA, tstepB = 2 * hstepB;
    const unsigned ldsw = (unsigned)wid * 1024u;
    const int aoff = lds_byte(wr * 64 + fr, fq * 8), boff = lds_byte(wc * 32 + fr, fq * 8);
#define PG8_SA(b, h) (((b) * 2 + (h)) * HTB)
#define PG8_SB(b, h) ((4 + (b) * 2 + (h)) * HTB)
#define PG8_STAGE(bufoff, gbase, voff) do { _Pragma("unroll") for (int _i = 0; _i < 2; ++_i) \
        __builtin_amdgcn_global_load_lds((const unsigned*)((const char*)(gbase) + (voff)[_i]), (PG8_LAS unsigned*)(lds + (bufoff) + ldsw + _i * 8192), 16, 0, 0); } while (0)
#define PG8_LDA(dst, b, h) do { _Pragma("unroll") for (int m = 0; m < 4; ++m) _Pragma("unroll") for (int k = 0; k < 2; ++k) dst[m][k] = *(const PG8_LAS bf16x8*)(lds + PG8_SA(b, h) + aoff + m * 2048 + k * 1024); } while (0)
#define PG8_LDB(dst, b, h) do { _Pragma("unroll") for (int n = 0; n < 2; ++n) _Pragma("unroll") for (int k = 0; k < 2; ++k) dst[n][k] = *(const PG8_LAS bf16x8*)(lds + PG8_SB(b, h) + boff + n * 2048 + k * 1024); } while (0)
#define PG8_MMA(ai, bj, At, Bt) do { __builtin_amdgcn_s_setprio(1); _Pragma("unroll") for (int m = 0; m < 4; ++m) _Pragma("unroll") for (int n = 0; n < 2; ++n) _Pragma("unroll") for (int k = 0; k < 2; ++k) \
        acc[ai][bj][m][n] = __builtin_amdgcn_mfma_f32_16x16x32_bf16(Bt[n][k], At[m][k], acc[ai][bj][m][n], 0, 0, 0); __builtin_amdgcn_s_setprio(0); } while (0)
#define PG8_WAIT_V(n) asm volatile("s_waitcnt vmcnt(" #n ")" ::: "memory")
#define PG8_WAIT_L(n) asm volatile("s_waitcnt lgkmcnt(" #n ")" ::: "memory")
#define PG8_BAR __builtin_amdgcn_s_barrier()
#define PG8_SCHED __builtin_amdgcn_sched_barrier(0)
    Unit cur, nxt; int ui = 0;
    if (!S.next(0, cur)) return;
    f32x4 acc[2][2][4][2];
#pragma unroll
    for (int a = 0; a < 2; ++a)
#pragma unroll
        for (int b = 0; b < 2; ++b)
#pragma unroll
            for (int m = 0; m < 4; ++m)
#pragma unroll
                for (int n = 0; n < 2; ++n) acc[a][b][m][n] = (f32x4){0.f, 0.f, 0.f, 0.f};
    bf16x8 At[4][2], B0[2][2], B1[2][2];
    const char* cA = (const char*)g.A + (size_t)cur.pm * tstepA + (size_t)cur.pn * g.apn; const char* cB = (const char*)g.Bt + (size_t)cur.pn * tstepB + (size_t)(cur.pm / g.bdiv) * g.bbytes;
    S.a_ready(cur);
    if constexpr (SP2) {
        PG8_STAGE(PG8_SB(0, 0), cB, voffB); PG8_STAGE(PG8_SB(0, 1), cB + hstepB, voffB); PG8_STAGE(PG8_SA(0, 0), cA, voffA); PG8_STAGE(PG8_SA(0, 1), cA + hstepA, voffA);
        if (wr == 1) PG8_BAR;
        PG8_WAIT_V(2); PG8_BAR;
        PG8_STAGE(PG8_SB(1, 0), cB + kstep, voffB); PG8_STAGE(PG8_SA(1, 0), cA + kstep, voffA); PG8_STAGE(PG8_SB(1, 1), cB + hstepB + kstep, voffB);
        PG8_WAIT_V(6); PG8_BAR;
    } else {
        PG8_STAGE(PG8_SB(0, 0), cB, voffB); PG8_STAGE(PG8_SA(0, 0), cA, voffA); PG8_STAGE(PG8_SB(0, 1), cB + hstepB, voffB); PG8_STAGE(PG8_SA(0, 1), cA + hstepA, voffA);
        if (wr == 1) PG8_BAR;
        PG8_WAIT_V(4); PG8_BAR;
        PG8_STAGE(PG8_SB(1, 0), cB + kstep, voffB); PG8_STAGE(PG8_SA(1, 0), cA + kstep, voffA); PG8_STAGE(PG8_SB(1, 1), cB + hstepB + kstep, voffB);
        PG8_WAIT_V(6); PG8_BAR;
    }
    for (;;) {
        const bool has_next = S.next(ui + 1, nxt);
        const char* nA = has_next ? (const char*)g.A + (size_t)nxt.pm * tstepA + (size_t)nxt.pn * g.apn : cA; const char* nB = has_next ? (const char*)g.Bt + (size_t)nxt.pn * tstepB + (size_t)(nxt.pm / g.bdiv) * g.bbytes : cB;
#pragma nounroll
        for (int t = 0; t < nt; t += 2) {
            const bool last = (t == nt - 2);
            const char* a1 = cA + (size_t)(t + 1) * kstep;
            const char* a2 = last ? nA : cA + (size_t)(t + 2) * kstep; const char* b2 = last ? nB : cB + (size_t)(t + 2) * kstep;
            const char* a3 = a2 + kstep; const char* b3 = b2 + kstep;
            if (last && has_next) S.a_ready(nxt);
            if constexpr (SP2) {
            PG8_LDB(B0, 0, 0); PG8_LDB(B1, 0, 1); PG8_SCHED; PG8_LDA(At, 0, 0); PG8_STAGE(PG8_SA(1, 1), a1 + hstepA, voffA);
            PG8_WAIT_V(8); PG8_WAIT_L(0); PG8_BAR; PG8_MMA(0, 0, At, B0); PG8_MMA(0, 1, At, B1); PG8_BAR; PG8_SCHED;
            PG8_LDA(At, 0, 1); PG8_STAGE(PG8_SB(0, 0), b2, voffB); PG8_STAGE(PG8_SB(0, 1), b2 + hstepB, voffB); PG8_STAGE(PG8_SA(0, 0), a2, voffA);
            PG8_WAIT_V(8); PG8_WAIT_L(0); PG8_BAR; PG8_MMA(1, 0, At, B0); PG8_MMA(1, 1, At, B1); PG8_BAR; PG8_SCHED;
            PG8_LDB(B0, 1, 0); PG8_LDB(B1, 1, 1); PG8_SCHED; PG8_LDA(At, 1, 0); PG8_STAGE(PG8_SA(0, 1), a2 + hstepA, voffA);
            PG8_WAIT_V(8); PG8_WAIT_L(0); PG8_BAR; PG8_MMA(0, 0, At, B0); PG8_MMA(0, 1, At, B1); PG8_BAR; PG8_SCHED;
            PG8_LDA(At, 1, 1); PG8_STAGE(PG8_SB(1, 0), b3, voffB); PG8_STAGE(PG8_SB(1, 1), b3 + hstepB, voffB); PG8_STAGE(PG8_SA(1, 0), a3, voffA);
            PG8_WAIT_V(8); PG8_WAIT_L(0); PG8_BAR; PG8_MMA(1, 0, At, B0); PG8_MMA(1, 1, At, B1); PG8_BAR; PG8_SCHED;
            } else {
            PG8_LDB(B0, 0, 0); PG8_SCHED; PG8_LDA(At, 0, 0); PG8_STAGE(PG8_SA(1, 1), a1 + hstepA, voffA);
            PG8_WAIT_L(8); PG8_BAR; PG8_WAIT_L(0); PG8_MMA(0, 0, At, B0); PG8_BAR; PG8_SCHED;
            PG8_LDB(B1, 0, 1); PG8_STAGE(PG8_SB(0, 0), b2, voffB);
            PG8_BAR; PG8_WAIT_L(0); PG8_MMA(0, 1, At, B1); PG8_BAR;
            PG8_LDA(At, 0, 1); PG8_STAGE(PG8_SA(0, 0), a2, voffA);
            PG8_BAR; PG8_WAIT_L(0); PG8_MMA(1, 0, At, B0); PG8_BAR; PG8_SCHED;
            PG8_STAGE(PG8_SB(0, 1), b2 + hstepB, voffB);
            PG8_WAIT_V(6); PG8_BAR; PG8_MMA(1, 1, At, B1); PG8_BAR;
            PG8_LDB(B0, 1, 0); PG8_SCHED; PG8_LDA(At, 1, 0); PG8_STAGE(PG8_SA(0, 1), a2 + hstepA, voffA);
            PG8_WAIT_L(8); PG8_BAR; PG8_WAIT_L(0); PG8_MMA(0, 0, At, B0); PG8_BAR; PG8_SCHED;
            PG8_LDB(B1, 1, 1); PG8_STAGE(PG8_SB(1, 0), b3, voffB);
            PG8_BAR; PG8_WAIT_L(0); PG8_MMA(0, 1, At, B1); PG8_BAR;
            PG8_LDA(At, 1, 1); PG8_STAGE(PG8_SA(1, 0), a3, voffA);
            PG8_BAR; PG8_WAIT_L(0); PG8_MMA(1, 0, At, B0); PG8_BAR; PG8_SCHED;
            PG8_STAGE(PG8_SB(1, 1), b3 + hstepB, voffB);
            PG8_WAIT_V(6); PG8_BAR; PG8_MMA(1, 1, At, B1); PG8_BAR;
            }
        }
        if constexpr (ALIGN_EPI) { if (wr == 0) PG8_BAR; }
        if constexpr (!Epi::AFTER_DRAIN) { E(acc, cur, wr, wc, fr, fq); S.done(cur); }
        if (!has_next) break;
#pragma unroll
        for (int a = 0; a < 2; ++a)
#pragma unroll
            for (int b = 0; b < 2; ++b)
#pragma unroll
                for (int m = 0; m < 4; ++m)
#pragma unroll
                    for (int n = 0; n < 2; ++n) acc[a][b][m][n] = (f32x4){0.f, 0.f, 0.f, 0.f};
        cur = nxt; cA = nA; cB = nB; ++ui;
        if constexpr (ALIGN_EPI) { if (wr == 1) PG8_BAR; }
    }
    PG8_WAIT_V(0);
    if constexpr (!ALIGN_EPI) { if (wr == 0) PG8_BAR; }
    PG8_BAR;
    if constexpr (Epi::AFTER_DRAIN) { E.fused(acc, cur, wr, wc, fr, fq, lds, wid, lane); S.done(cur); }
#undef PG8_SA
#undef PG8_SB
#undef PG8_STAGE
#undef PG8_LDA
#undef PG8_LDB
#undef PG8_MMA
#undef PG8_WAIT_V
#undef PG8_WAIT_L
#undef PG8_BAR
#undef PG8_SCHED
}
}
namespace nsa {
typedef unsigned short bf16_t;
typedef short bf16x8 __attribute__((ext_vector_type(8)));
typedef short s16x4 __attribute__((ext_vector_type(4)));
typedef float f32x16 __attribute__((ext_vector_type(16)));
typedef float f32x4 __attribute__((ext_vector_type(4)));
typedef unsigned u32x4 __attribute__((ext_vector_type(4)));
constexpr int D = 128, KVBLK = 64, SHM_K = 16384, SHM_V = 16384, SEQ = 8192;
constexpr float SCALE = 0.08838834764831845f, C2 = 1.4426950408889634f * SCALE, THR = 8.f;
constexpr int L_V = 0, L_K = 16384, L_WS = 32768, L_SELM = 34816, L_IMP = 36864, L_END = L_IMP + 64 * 128 * 4;
#define KSWZ(row, colB) ((row) * 256 + ((colB) ^ (((row) & 7) << 4)))
#define SBAR() __builtin_amdgcn_sched_barrier(0)
__device__ __forceinline__ int v_st(int k, int c) { const int kk = (k & ~0xC) | ((k & 4) << 1) | ((k & 8) >> 1); return ((kk >> 3) * 4 + (c >> 5)) * 512 + ((kk & 7) * 32 + (c & 31)) * 2; }
__device__ __forceinline__ int v_rd_base(int lane) { return ((lane & 3) << 3) | (((lane >> 2) & 3) << 6) | (((lane >> 4) & 1) << 5) | (((lane >> 5) & 1) << 8); }
constexpr int v_rd_off(int d0, int ks, int half) { return d0 * 512 + ks * 4096 + half * 2048; }
__device__ __forceinline__ int crow(int r, int hi) { return (r & 3) + 8 * (r >> 2) + 4 * hi; }
__device__ __forceinline__ unsigned cvtpk(float lo, float hi) { unsigned r; asm volatile("v_cvt_pk_bf16_f32 %0, %1, %2" : "=v"(r) : "v"(lo), "v"(hi)); return r; }
__device__ __forceinline__ void mask_tile(f32x16& p0, f32x16& p1, int dq, unsigned W) {
    const float NEG = -__builtin_inff();
#pragma unroll
    for (int r = 0; r < 16; ++r) {
        const int c = (r & 3) + 8 * (r >> 2);
        if ((unsigned)(dq - c) >= W) p0[r] = NEG;
        if ((unsigned)(dq - c - 32) >= W) p1[r] = NEG;
    }
}
__device__ __forceinline__ float rowmax32(const f32x16& p0, const f32x16& p1) {
    float pmax = p0[0];
#pragma unroll
    for (int r = 1; r < 16; ++r) pmax = fmaxf(pmax, p0[r]);
#pragma unroll
    for (int r = 0; r < 16; ++r) pmax = fmaxf(pmax, p1[r]);
    auto rr = __builtin_amdgcn_permlane32_swap(__float_as_uint(pmax), __float_as_uint(pmax), false, false);
    return fmaxf(__uint_as_float(rr[0]), __uint_as_float(rr[1]));
}
__device__ __forceinline__ float rowsum32(const f32x16& p0, const f32x16& p1) {
    float ps = 0.f;
#pragma unroll
    for (int r = 0; r < 16; ++r) ps += p0[r];
#pragma unroll
    for (int r = 0; r < 16; ++r) ps += p1[r];
    auto rr = __builtin_amdgcn_permlane32_swap(__float_as_uint(ps), __float_as_uint(ps), false, false);
    return __uint_as_float(rr[0]) + __uint_as_float(rr[1]);
}
__device__ __forceinline__ void packP(const f32x16& p0, const f32x16& p1, bf16x8& pa0, bf16x8& pa1, bf16x8& pa2, bf16x8& pa3) {
#define PK4(P, B_, OUT) do { unsigned a0 = cvtpk(P[B_+0], P[B_+1]), a1 = cvtpk(P[B_+2], P[B_+3]);                          \
        unsigned b0 = cvtpk(P[B_+4], P[B_+5]), b1 = cvtpk(P[B_+6], P[B_+7]);                                             \
        auto r0 = __builtin_amdgcn_permlane32_swap(a0, b0, false, false); auto r1 = __builtin_amdgcn_permlane32_swap(a1, b1, false, false); \
        u32x4 w = {r0[0], r1[0], r0[1], r1[1]}; OUT = *reinterpret_cast<bf16x8*>(&w); } while (0)
    PK4(p0, 0, pa0); PK4(p0, 8, pa1); PK4(p1, 0, pa2); PK4(p1, 8, pa3);
#undef PK4
}
__device__ __forceinline__ void qkt(f32x16& p0, f32x16& p1, const char* K_lds, int r32, int hi, const bf16x8* qr) {
    p0 = f32x16{}; p1 = f32x16{};
    const char* kb[4];
#pragma unroll
    for (int dd = 0; dd < 4; ++dd) kb[dd] = K_lds + KSWZ(r32, (dd * 16 + hi * 8) * 2);
#pragma unroll
    for (int d0 = 0; d0 < 8; ++d0) { const char* a = kb[d0 & 3] + (d0 >> 2) * 128;
        bf16x8 b0 = *reinterpret_cast<const bf16x8*>(a);
        bf16x8 b1 = *reinterpret_cast<const bf16x8*>(a + 32 * 256);
        p0 = __builtin_amdgcn_mfma_f32_32x32x16_bf16(b0, qr[d0], p0, 0, 0, 0);
        p1 = __builtin_amdgcn_mfma_f32_32x32x16_bf16(b1, qr[d0], p1, 0, 0, 0); }
}
__device__ __forceinline__ void pv_tile(f32x16* o, int vb0, bf16x8 pa0, bf16x8 pa1, bf16x8 pa2, bf16x8 pa3) {
#define TRRD(dst, off) asm volatile("ds_read_b64_tr_b16 %0, %1 offset:%2" : "=&v"(dst) : "v"(vb0), "i"(off) : "memory")
#define PV_D0(d0) do { s16x4 l0, l1, l2, l3, h0, h1, h2, h3; constexpr int b_ = v_rd_off(d0, 0, 0); \
        TRRD(l0, b_); TRRD(h0, b_ + 2048); TRRD(l1, b_ + 4096); TRRD(h1, b_ + 6144); TRRD(l2, b_ + 8192); TRRD(h2, b_ + 10240); TRRD(l3, b_ + 12288); TRRD(h3, b_ + 14336); \
        asm volatile("s_waitcnt lgkmcnt(0)" ::: "memory"); SBAR();   \
        o[d0] = __builtin_amdgcn_mfma_f32_32x32x16_bf16(pa0, (bf16x8){l0[0], l0[1], l0[2], l0[3], h0[0], h0[1], h0[2], h0[3]}, o[d0], 0, 0, 0);   \
        o[d0] = __builtin_amdgcn_mfma_f32_32x32x16_bf16(pa1, (bf16x8){l1[0], l1[1], l1[2], l1[3], h1[0], h1[1], h1[2], h1[3]}, o[d0], 0, 0, 0);   \
        o[d0] = __builtin_amdgcn_mfma_f32_32x32x16_bf16(pa2, (bf16x8){l2[0], l2[1], l2[2], l2[3], h2[0], h2[1], h2[2], h2[3]}, o[d0], 0, 0, 0);   \
        o[d0] = __builtin_amdgcn_mfma_f32_32x32x16_bf16(pa3, (bf16x8){l3[0], l3[1], l3[2], l3[3], h3[0], h3[1], h3[2], h3[3]}, o[d0], 0, 0, 0); } while (0)
    PV_D0(0); PV_D0(1); PV_D0(2); PV_D0(3);
#undef PV_D0
#undef TRRD
}

template <bool STATS, int KIND>
__device__ __forceinline__ void attend(const bf16_t* __restrict__ Kg, const bf16_t* __restrict__ Vg, int j_lo, int j_hi, int pos, unsigned W,
                                       char* lds, const bf16x8* qr, float& m_reg, float& l_reg, f32x16* o, float f_imp, float f_o, int qb) {
    const int tid = threadIdx.x, wid = __builtin_amdgcn_readfirstlane(tid >> 6), lane = tid & 63, r32 = lane & 31, hi = lane >> 5;
    char* V_lds = lds + L_V; char* K_lds = lds + L_K;
    const int sr = tid >> 4, sc = (tid & 15) * 8, vst0 = v_st(sr, sc), vst1 = v_st(32 + sr, sc), kws = KSWZ(sr, sc * 2);
    const int vb0 = (int)(uintptr_t)V_lds + v_rd_base(lane);
    const int qloc = wid * 8 + (r32 >> 2);
    bf16x8 sk0, sk1, sv0, sv1;
#define NSA_GLOAD(j) do { const bf16_t* kp_ = Kg + (size_t)((j) * KVBLK + sr) * D + sc; sk0 = *(const bf16x8*)kp_; sk1 = *(const bf16x8*)(kp_ + 32 * D); \
        if (!STATS) { const bf16_t* vp_ = Vg + (size_t)((j) * KVBLK + sr) * D + sc; sv0 = *(const bf16x8*)vp_; sv1 = *(const bf16x8*)(vp_ + 32 * D); } } while (0)
    if (j_lo < j_hi) NSA_GLOAD(j_lo);
    for (int j = j_lo; j < j_hi; ++j) {
        __syncthreads();
        *(bf16x8*)(K_lds + kws) = sk0; *(bf16x8*)(K_lds + kws + 32 * 256) = sk1;
        if (!STATS) { *(bf16x8*)(V_lds + vst0) = sv0; *(bf16x8*)(V_lds + vst1) = sv1; }
        __syncthreads();
        if (j + 1 < j_hi) NSA_GLOAD(j + 1);
        const int kb = j * KVBLK;
        bool rowsel = true, act = true;
        if (KIND == 2) { const unsigned wsel = ((const unsigned*)(lds + L_SELM))[qloc * 4 + (j >> 5)]; rowsel = ((wsel >> (j & 31)) & 1u) != 0u; act = __any(rowsel); }
        if (act) {
            f32x16 p0, p1;
            qkt(p0, p1, K_lds, r32, hi, qr);
            if (KIND == 2) {
                if (j == qb) mask_tile(p0, p1, pos - kb - 4 * hi, W);
                if (!rowsel) { const float NEG = -__builtin_inff();
#pragma unroll
                    for (int r = 0; r < 16; ++r) { p0[r] = NEG; p1[r] = NEG; } }
            } else mask_tile(p0, p1, pos - kb - 4 * hi, W);
            if (STATS) {
                const float pmax = rowmax32(p0, p1), mn = fmaxf(m_reg, pmax), alpha = __builtin_amdgcn_exp2f((m_reg - mn) * C2), mnL = -mn * C2;
#pragma unroll
                for (int r = 0; r < 16; ++r) { p0[r] = __builtin_amdgcn_exp2f(fmaf(p0[r], C2, mnL)); p1[r] = __builtin_amdgcn_exp2f(fmaf(p1[r], C2, mnL)); }
                l_reg = l_reg * alpha + rowsum32(p0, p1); m_reg = mn;
            } else {
                const float mnL = -m_reg * C2;
#pragma unroll
                for (int r = 0; r < 16; ++r) { p0[r] = __builtin_amdgcn_exp2f(fmaf(p0[r], C2, mnL)); p1[r] = __builtin_amdgcn_exp2f(fmaf(p1[r], C2, mnL)); }
                if (KIND == 1) {
                    float* imp = (float*)(lds + L_IMP) + qloc * 128 + (kb >> 2);
#pragma unroll
                    for (int half = 0; half < 2; ++half)
#pragma unroll
                        for (int i = 0; i < 4; ++i) {
                            const f32x16& P = half ? p1 : p0;
                            float G = ((P[4 * i] + P[4 * i + 1]) + (P[4 * i + 2] + P[4 * i + 3])) * f_imp, L = P[4 * i + 3] * f_imp;
                            G += __shfl_xor(G, 1); G += __shfl_xor(G, 2); L += __shfl_xor(L, 1); L += __shfl_xor(L, 2);
                            const int jl = half * 8 + 2 * i + hi;
                            if ((r32 & 3) == 0) { atomicAdd(imp + jl, G); if ((kb >> 2) + jl + 1 < 128) atomicAdd(imp + jl + 1, L); }
                        }
                }
#pragma unroll
                for (int r = 0; r < 16; ++r) { p0[r] *= f_o; p1[r] *= f_o; }
                bf16x8 pa0, pa1, pa2, pa3;
                packP(p0, p1, pa0, pa1, pa2, pa3);
                pv_tile(o, vb0, pa0, pa1, pa2, pa3);
            }
        }
    }
#undef NSA_GLOAD
}

__device__ __forceinline__ float bf2f(bf16_t v) { return __builtin_bit_cast(float, (unsigned)v << 16); }
__device__ __forceinline__ float sigm(float x) { return __builtin_amdgcn_rcpf(1.f + __builtin_amdgcn_exp2f(-1.4426950408889634f * x)); }

__device__ __forceinline__ void nsa_unit(int b, int g, int qb, const bf16_t* Q, const bf16_t* KV4, const bf16_t* KCMP, const bf16_t* VCMP, const bf16_t* NSAG, bf16_t* OUT, char* lds) {
    const int tid = threadIdx.x, wid = __builtin_amdgcn_readfirstlane(tid >> 6), lane = tid & 63, r32 = lane & 31, hi = lane >> 5;
    const int ql = wid * 8 + (r32 >> 2), h = r32 & 3, t = qb * 64 + ql;
    const size_t row = (size_t)b * SEQ + t;
    bf16x8 qr[8];
    { const bf16_t* qp = Q + row * 2048 + g * 512 + h * 128 + hi * 8;
#pragma unroll
      for (int d0 = 0; d0 < 8; ++d0) qr[d0] = *(const bf16x8*)(qp + d0 * 16); }
    { f32x4* z = (f32x4*)((float*)(lds + L_IMP) + wid * 8 * 128) + lane;
#pragma unroll
      for (int i = 0; i < 4; ++i) z[64 * i] = (f32x4){0.f, 0.f, 0.f, 0.f}; }
    const float gc = sigm(bf2f(NSAG[row * 256 + 0 * 16 + g * 4 + h])), gs = sigm(bf2f(NSAG[row * 256 + 1 * 16 + g * 4 + h])), gw = sigm(bf2f(NSAG[row * 256 + 2 * 16 + g * 4 + h]));
    const int bg = b * 4 + g;
    const size_t TSTR = (size_t)8 * SEQ * D;
    f32x16 comb[4];
#pragma unroll
    for (int d_ = 0; d_ < 4; ++d_) comb[d_] = f32x16{};
    {
        const bf16_t* kc = KCMP + (size_t)bg * 512 * D; const bf16_t* vc = VCMP + (size_t)bg * 512 * D;
        const int nmax = (t - 31) >> 4, jh = (4 * qb + 3 + 63) >> 6;
        float m1 = -1e30f, l1 = 0.f;
        attend<true, 1>(kc, vc, 0, jh, nmax, 0x7fffffffu, lds, qr, m1, l1, comb, 0.f, 0.f, qb);
        const float inv_l = l1 > 0.f ? 1.f / l1 : 0.f;
        attend<false, 1>(kc, vc, 0, jh, nmax, 0x7fffffffu, lds, qr, m1, l1, comb, inv_l, gc * inv_l, qb);
    }
    {
        asm volatile("s_waitcnt lgkmcnt(0)" ::: "memory");
        unsigned* SELM = (unsigned*)(lds + L_SELM);
        const unsigned* IMPu = (const unsigned*)(lds + L_IMP);
        if (qb >= 16) {
            for (int i = 0; i < 8; ++i) {
                const int q = wid * 8 + i;
                const unsigned vlo = IMPu[q * 128 + lane], vhi = IMPu[q * 128 + 64 + lane];
                const bool clo = (lane >= 1) && (lane <= qb - 2), chi = (64 + lane <= qb - 2);
                unsigned T = 0u;
                for (int bit = 30; bit >= 0; --bit) { const unsigned c = T | (1u << bit);
                    const int cnt = __popcll(__ballot(clo && vlo >= c)) + __popcll(__ballot(chi && vhi >= c));
                    if (cnt >= 13) T = c; }
                unsigned long long sel_lo = __ballot(clo && vlo > T), sel_hi = __ballot(chi && vhi > T);
                unsigned long long eq_lo = __ballot(clo && vlo == T), eq_hi = __ballot(chi && vhi == T);
                int need = 13 - __popcll(sel_lo) - __popcll(sel_hi);
                for (; need > 0; --need) {
                    if (eq_lo) { const unsigned long long lb = eq_lo & (0ull - eq_lo); sel_lo |= lb; eq_lo ^= lb; }
                    else if (eq_hi) { const unsigned long long lb = eq_hi & (0ull - eq_hi); sel_hi |= lb; eq_hi ^= lb; }
                }
                sel_lo |= 1ull;
                if (qb - 1 < 64) sel_lo |= 1ull << (qb - 1); else sel_hi |= 1ull << (qb - 1 - 64);
                if (qb < 64) sel_lo |= 1ull << qb; else sel_hi |= 1ull << (qb - 64);
                if (lane == 0) { SELM[q * 4 + 0] = (unsigned)sel_lo; SELM[q * 4 + 1] = (unsigned)(sel_lo >> 32); SELM[q * 4 + 2] = (unsigned)sel_hi; SELM[q * 4 + 3] = (unsigned)(sel_hi >> 32); }
            }
        } else {
            if (lane < 8) { const int q = wid * 8 + lane; SELM[q * 4 + 0] = (2u << qb) - 1u; SELM[q * 4 + 1] = 0u; SELM[q * 4 + 2] = 0u; SELM[q * 4 + 3] = 0u; }
        }
        asm volatile("s_waitcnt lgkmcnt(0)" ::: "memory");
    }
    {
        const bf16_t* ks = KV4 + 0 * TSTR + (size_t)bg * SEQ * D; const bf16_t* vs = KV4 + 1 * TSTR + (size_t)bg * SEQ * D;
        float m = -1e30f, l = 0.f;
        attend<true, 2>(ks, vs, 0, qb + 1, t, 0x7fffffffu, lds, qr, m, l, comb, 0.f, 0.f, qb);
        attend<false, 2>(ks, vs, 0, qb + 1, t, 0x7fffffffu, lds, qr, m, l, comb, 0.f, l > 0.f ? gs / l : 0.f, qb);
    }
    {
        const bf16_t* kw = KV4 + 2 * TSTR + (size_t)bg * SEQ * D; const bf16_t* vw = KV4 + 3 * TSTR + (size_t)bg * SEQ * D;
        const int jl = qb >= 8 ? qb - 8 : 0;
        float m = -1e30f, l = 0.f;
        attend<true, 0>(kw, vw, jl, qb + 1, t, 512u, lds, qr, m, l, comb, 0.f, 0.f, qb);
        attend<false, 0>(kw, vw, jl, qb + 1, t, 512u, lds, qr, m, l, comb, 0.f, l > 0.f ? gw / l : 0.f, qb);
    }
#pragma unroll
    for (int r = 0; r < 16; ++r) { const int wrow = crow(r, hi), oq = wid * 8 + (wrow >> 2), oh = wrow & 3;
        bf16_t* op = OUT + ((size_t)b * SEQ + qb * 64 + oq) * 2048 + g * 512 + oh * 128;
#pragma unroll
        for (int d0 = 0; d0 < 4; ++d0) { const float v = comb[d0][r], vn = __shfl_xor(v, 1);
            if ((r32 & 1) == 0) *(unsigned*)(op + d0 * 32 + r32) = cvtpk(v, vn); } }
    __syncthreads();
}
#undef KSWZ
#undef SBAR
}
constexpr int NWAVES = 8;
constexpr int SEQ = 8192, M = 2 * SEQ, DM = 2048, FF = 5632, INW_SRC = 10288, INW = 10496, PW = 1024;
constexpr float RMS_EPS = 1e-6f;
constexpr size_t MiB = 1u << 20;
constexpr size_t WS_WIN = 0, WS_WPU = 42 * MiB, WS_WNU = 46 * MiB, WS_WOUT = 54 * MiB, WS_POOLW = 62 * MiB, WS_CW1 = 63 * MiB, WS_CW2 = 67 * MiB;
constexpr size_t WS_PEBP = 68 * MiB, WS_PEB = 68 * MiB + 512 * 1024, WS_HIDC = 69 * MiB, WS_KVCMP = 73 * MiB;
constexpr size_t WS_WGU = 76 * MiB, WS_WD = 120 * MiB, WS_GNSA = 76 * MiB;
constexpr size_t WS_XN = 142 * MiB, WS_POOLED = 142 * MiB, WS_APOOL = 174 * MiB;
constexpr size_t WS_HID = 206 * MiB, WS_XP = 206 * MiB, WS_Q = 238 * MiB, WS_NSAG = 302 * MiB, WS_KV4 = 310 * MiB;
constexpr size_t WS_GPOOL = 382 * MiB, WS_KCVC = 446 * MiB, WS_END = 480 * MiB;
static_assert(WS_WIN + (size_t)INW * DM * 2 <= WS_WPU && WS_WGU + (size_t)2 * FF * DM * 2 <= WS_WD && WS_WD + (size_t)DM * FF * 2 <= WS_XN && WS_GNSA + (size_t)M * DM * 2 <= WS_XN, "ws map 1");
static_assert(WS_HID + (size_t)M * FF * 2 <= WS_GPOOL && WS_KV4 + (size_t)4 * M * 512 * 2 <= WS_GPOOL && WS_NSAG + (size_t)M * 256 * 2 <= WS_KV4 && WS_KCVC + (size_t)2 * M * 512 * 2 + 8192 <= WS_END, "ws map 2");
constexpr int LDS_BYTES = 147456;
#define GAS __attribute__((address_space(1)))
#define LAS __attribute__((address_space(3)))
typedef unsigned short bf16;
typedef unsigned v4u __attribute__((ext_vector_type(4)));
typedef float f32x4 __attribute__((ext_vector_type(4)));
#define LDS_WAIT() asm volatile("s_waitcnt lgkmcnt(0)" ::: "memory")
__device__ __forceinline__ unsigned f2bf(float f) { unsigned u = __builtin_bit_cast(unsigned, f); return (u + 0x7fffu + ((u >> 16) & 1u)) >> 16; }
__device__ __forceinline__ unsigned pk2(float lo, float hi) { return f2bf(lo) | (f2bf(hi) << 16); }
__device__ __forceinline__ float wave_sum(float v) {
#pragma unroll
    for (int o = 1; o < 64; o <<= 1) v += __shfl_xor(v, o);
    return v;
}
__device__ __forceinline__ void transpose_item(const float* W, int K, int N, int c0, int nvalid, bf16* WT, int drow, int k0, LAS float* scr, int lane) {
    const bool cv = (lane & 31) < nvalid;
#pragma unroll 8
    for (int i = 0; i < 32; ++i) { const int kk = 2 * i + (lane >> 5); scr[kk * 33 + (lane & 31)] = cv ? W[(size_t)(k0 + kk) * N + c0 + (lane & 31)] : 0.f; }
    LDS_WAIT(); asm volatile("" ::: "memory");
    const int c = lane & 7;
#pragma unroll
    for (int j = 0; j < 4; ++j) { const int n = (lane >> 3) + 8 * j; const LAS float* s = scr + (8 * c) * 33 + n;
        v4u o; o.x = pk2(s[0 * 33], s[1 * 33]); o.y = pk2(s[2 * 33], s[3 * 33]); o.z = pk2(s[4 * 33], s[5 * 33]); o.w = pk2(s[6 * 33], s[7 * 33]);
        if (n < nvalid) *(v4u*)(WT + (size_t)(drow + n) * K + k0 + 8 * c) = o; }
    LDS_WAIT(); asm volatile("" ::: "memory");
}
__device__ __forceinline__ void transpose_seg(const float* W, int K, int N, int src0, int ncols, bf16* WT, int drow0, bool gu, LAS float* scr, int lane, int gw, int NGW, int& base) {
    const int nblk = (ncols + 31) >> 5, nitems = (K >> 6) * nblk;
    int first = (gw - base) % NGW; if (first < 0) first += NGW;
    for (int it = first; it < nitems; it += NGW) {
        const int kb = it / nblk, nb = it - kb * nblk, c0 = nb * 32, nv = (ncols - c0) < 32 ? (ncols - c0) : 32;
        const int drow = gu ? (256 * (c0 >> 7) + (c0 & 127) + drow0) : (drow0 + c0);
        transpose_item(W, K, N, src0 + c0, nv, WT, drow, kb * 64, scr, lane);
    }
    base = (base + nitems) % NGW;
}
__device__ __forceinline__ void rms_row_bf16(const float* xrow, const float* g, bf16* orow, int lane) {
    const f32x4* xr = (const f32x4*)xrow + lane; const f32x4* gr = (const f32x4*)g + lane;
    f32x4 v[8]; float s = 0.f;
#pragma unroll
    for (int j = 0; j < 8; ++j) { v[j] = xr[64 * j]; s += (v[j].x * v[j].x + v[j].y * v[j].y) + (v[j].z * v[j].z + v[j].w * v[j].w); }
    const float rs = 1.f / sqrtf(wave_sum(s) * (1.f / DM) + RMS_EPS);
    unsigned long long* o8 = (unsigned long long*)orow + lane;
#pragma unroll
    for (int j = 0; j < 8; ++j) { const f32x4 gg = gr[64 * j];
        o8[64 * j] = (unsigned long long)pk2(v[j].x * rs * gg.x, v[j].y * rs * gg.y) | ((unsigned long long)pk2(v[j].z * rs * gg.z, v[j].w * rs * gg.w) << 32); }
}
__device__ __forceinline__ void rms_row_f32(float* xrow, const float* g, int lane) {
    f32x4* xr = (f32x4*)xrow + lane; const f32x4* gr = (const f32x4*)g + lane;
    f32x4 v[8]; float s = 0.f;
#pragma unroll
    for (int j = 0; j < 8; ++j) { v[j] = xr[64 * j]; s += (v[j].x * v[j].x + v[j].y * v[j].y) + (v[j].z * v[j].z + v[j].w * v[j].w); }
    const float rs = 1.f / sqrtf(wave_sum(s) * (1.f / DM) + RMS_EPS);
#pragma unroll
    for (int j = 0; j < 8; ++j) { const f32x4 gg = gr[64 * j]; xr[64 * j] = (f32x4){v[j].x * rs * gg.x, v[j].y * rs * gg.y, v[j].z * rs * gg.z, v[j].w * rs * gg.w}; }
}
using pg8::u32x4;
struct FWin {
    bf16 *XP, *Q, *KCVC, *KV4, *GPOOL, *GNSA, *NSAG;
    __device__ __forceinline__ void operator()(int row, int col, int pn, pg8::f32x4 v0, pg8::f32x4 v1) const {
        const u32x4 w = pg8::pack8(v0, v1); bf16* dst;
        if (pn < 4) dst = XP + (size_t)row * 1024 + col;
        else if (pn < 12) dst = Q + (size_t)row * 2048 + (col - 1024);
        else if (pn < 24) { const int c = col - 3072, tensor = c >> 9, g = (c >> 7) & 3, d = c & 127, b = row >> 13, t = row & 8191;
            dst = (tensor < 2 ? KCVC + (size_t)tensor * 8 * SEQ * 128 : KV4 + (size_t)(tensor - 2) * 8 * SEQ * 128) + ((size_t)(b * 4 + g) * SEQ + t) * 128 + d; }
        else if (pn < 32) dst = GPOOL + (size_t)row * 2048 + (col - 6144);
        else if (pn < 40) dst = GNSA + (size_t)row * 2048 + (col - 8192);
        else dst = NSAG + (size_t)row * 256 + (col - 10240);
        *(u32x4*)dst = w;
    }
};
struct FSiluBias { bf16* O; const float* bias;
    __device__ __forceinline__ void operator()(int row, int col, int pn, pg8::f32x4 v0, pg8::f32x4 v1) const {
        const float* bp = bias + ((row >> 12) << 8) + col; const pg8::f32x4 b0 = *(const pg8::f32x4*)bp, b1 = *(const pg8::f32x4*)(bp + 4);
#pragma unroll
        for (int j = 0; j < 4; ++j) { v0[j] = pg8::siluf_(v0[j] + b0[j]); v1[j] = pg8::siluf_(v1[j] + b1[j]); }
        *(u32x4*)(O + (size_t)row * 256 + col) = pg8::pack8(v0, v1);
    }
};
struct FStore128 { bf16* O;
    __device__ __forceinline__ void operator()(int row, int col, int pn, pg8::f32x4 v0, pg8::f32x4 v1) const {
        if (col < 128) *(u32x4*)(O + (size_t)row * 128 + col) = pg8::pack8(v0, v1);
    }
};
struct FPool { bf16* O; const float* scale;
    __device__ __forceinline__ void operator()(int row, int col, int pn, pg8::f32x4 v0, pg8::f32x4 v1) const {
        const pg8::f32x4 s0 = *(const pg8::f32x4*)(scale + col), s1 = *(const pg8::f32x4*)(scale + col + 4);
        *(u32x4*)(O + (size_t)row * PW + col) = pg8::pack8(v0 * s0, v1 * s1);
    }
};
struct FGate { bf16* MG; const bf16* Gt; bool add;
    __device__ __forceinline__ void operator()(int row, int col, int pn, pg8::f32x4 v0, pg8::f32x4 v1) const {
        const size_t off = (size_t)row * DM + col;
        const u32x4 gw = *(const u32x4*)(Gt + off);
        pg8::f32x4 r0, r1;
        r0[0] = pg8::sigmoidf_(pg8::bf_lo(gw.x)) * v0[0]; r0[1] = pg8::sigmoidf_(pg8::bf_hi(gw.x)) * v0[1]; r0[2] = pg8::sigmoidf_(pg8::bf_lo(gw.y)) * v0[2]; r0[3] = pg8::sigmoidf_(pg8::bf_hi(gw.y)) * v0[3];
        r1[0] = pg8::sigmoidf_(pg8::bf_lo(gw.z)) * v1[0]; r1[1] = pg8::sigmoidf_(pg8::bf_hi(gw.z)) * v1[1]; r1[2] = pg8::sigmoidf_(pg8::bf_lo(gw.w)) * v1[2]; r1[3] = pg8::sigmoidf_(pg8::bf_hi(gw.w)) * v1[3];
        if (add) { const u32x4 mw = *(const u32x4*)(MG + off);
            r0[0] += pg8::bf_lo(mw.x); r0[1] += pg8::bf_hi(mw.x); r0[2] += pg8::bf_lo(mw.y); r0[3] += pg8::bf_hi(mw.y);
            r1[0] += pg8::bf_lo(mw.z); r1[1] += pg8::bf_hi(mw.z); r1[2] += pg8::bf_lo(mw.w); r1[3] += pg8::bf_hi(mw.w); }
        *(u32x4*)(MG + off) = pg8::pack8(r0, r1);
    }
};

struct Args { const float* in[23]; float* out; unsigned char* ws; int ph_lo, ph_hi; };
enum { I_X = 0, I_F1N, I_F1G, I_F1U, I_F1D, I_MIXN, I_WIN, I_POOLW, I_POOLS, I_PEK, I_PEV, I_CKW1, I_CKW2, I_CVW1, I_CVW2, I_WPU, I_WNU, I_WOUT, I_F2N, I_F2G, I_F2U, I_F2D, I_FINN };
constexpr int N_PHASES = 14;

template <class Epi> __device__ __forceinline__ void run_gemm(LAS unsigned char* lds, const bf16* A, int lda, const bf16* Bt, int ldb, int Mr, int N, int K, int G, int c, const Epi& E, int apn = 0, int bdiv = 1 << 30, int bbytes = 0) {
    pg8::Gemm g{A, Bt, Mr, N, K, lda, ldb, apn, bdiv, bbytes}; pg8::StaticOrder S; S.init(Mr, N, G, c);
    pg8::gemm_phase<Epi, pg8::StaticOrder, true, true>(lds, g, S, E);
    __syncthreads();
}

__global__ void __launch_bounds__(NWAVES * 64, 2) mk_fwd(Args a) {
    extern __shared__ __attribute__((aligned(16))) unsigned char lds_raw[];
    LAS unsigned char* lds = (LAS unsigned char*)lds_raw;
    const int tid = threadIdx.x, lane = tid & 63, wave = __builtin_amdgcn_readfirstlane(tid >> 6);
    const int G = gridDim.x, bx = blockIdx.x;
    const int vcu = (G % 8 == 0) ? (bx % 8) * (G / 8) + bx / 8 : bx;
    const int gw = vcu * NWAVES + wave, NGW = G * NWAVES;
    unsigned char* ws = a.ws;
    bf16* Win_t = (bf16*)(ws + WS_WIN); bf16* Wpu_t = (bf16*)(ws + WS_WPU); bf16* Wnu_t = (bf16*)(ws + WS_WNU); bf16* Wout_t = (bf16*)(ws + WS_WOUT);
    bf16* Poolw_t = (bf16*)(ws + WS_POOLW); bf16* Cw1_t = (bf16*)(ws + WS_CW1); bf16* Cw2_t = (bf16*)(ws + WS_CW2);
    float* PEBP = (float*)(ws + WS_PEBP); float* PEB = (float*)(ws + WS_PEB);
    bf16* HIDC = (bf16*)(ws + WS_HIDC); bf16* KVCMP = (bf16*)(ws + WS_KVCMP);
    bf16* Wgu_t = (bf16*)(ws + WS_WGU); bf16* Wd_t = (bf16*)(ws + WS_WD); bf16* GNSA = (bf16*)(ws + WS_GNSA);
    bf16* XN = (bf16*)(ws + WS_XN); bf16* POOLED = (bf16*)(ws + WS_POOLED); bf16* APOOL = (bf16*)(ws + WS_APOOL);
    bf16* HID = (bf16*)(ws + WS_HID); bf16* XP = (bf16*)(ws + WS_XP); bf16* Q = (bf16*)(ws + WS_Q); bf16* KV4 = (bf16*)(ws + WS_KV4); bf16* KCVC = (bf16*)(ws + WS_KCVC); bf16* NSAG = (bf16*)(ws + WS_NSAG);
    bf16* GPOOL = (bf16*)(ws + WS_GPOOL);
    float* H = a.out;
    const int lo = a.ph_lo, hi = a.ph_hi;
#ifndef MK_PHASE_MASK
#define MK_PHASE_MASK 0x3fff
#endif
#define IN(k) (((MK_PHASE_MASK >> (k)) & 1) && lo <= (k) && (k) < hi)
#define SEAM(k) do { if (IN(k) && IN((k) + 1)) { __syncthreads(); cg::this_grid().sync(); } } while (0)
    LAS float* scr = (LAS float*)(lds + wave * 16384);

    if (IN(0)) {
        int base = 0;
        transpose_seg(a.in[I_F1G], DM, FF, 0, FF, Wgu_t, 0, true, scr, lane, gw, NGW, base);
        transpose_seg(a.in[I_F1U], DM, FF, 0, FF, Wgu_t, 128, true, scr, lane, gw, NGW, base);
        transpose_seg(a.in[I_F1D], FF, DM, 0, DM, Wd_t, 0, false, scr, lane, gw, NGW, base);
        transpose_seg(a.in[I_WIN], DM, INW_SRC, 0, 6144, Win_t, 0, false, scr, lane, gw, NGW, base);
        transpose_seg(a.in[I_WIN], DM, INW_SRC, 6192, 2048, Win_t, 6144, false, scr, lane, gw, NGW, base);
        transpose_seg(a.in[I_WIN], DM, INW_SRC, 8240, 2048, Win_t, 8192, false, scr, lane, gw, NGW, base);
        transpose_seg(a.in[I_WIN], DM, INW_SRC, 6144, 48, Win_t, 10240, false, scr, lane, gw, NGW, base);
        transpose_seg(a.in[I_WPU], PW, DM, 0, DM, Wpu_t, 0, false, scr, lane, gw, NGW, base);
        transpose_seg(a.in[I_WNU], DM, DM, 0, DM, Wnu_t, 0, false, scr, lane, gw, NGW, base);
        transpose_seg(a.in[I_WOUT], DM, DM, 0, DM, Wout_t, 0, false, scr, lane, gw, NGW, base);
        for (int gi = 0; gi < 4; ++gi) transpose_seg(a.in[I_POOLW] + (size_t)gi * 65536, 256, 256, 0, 256, Poolw_t + (size_t)gi * 65536, 0, false, scr, lane, gw, NGW, base);
        transpose_seg(a.in[I_CKW1], 4096, 256, 0, 256, Cw1_t, 0, false, scr, lane, gw, NGW, base);
        transpose_seg(a.in[I_CVW1], 4096, 256, 0, 256, Cw1_t + (size_t)256 * 4096, 0, false, scr, lane, gw, NGW, base);
        transpose_seg(a.in[I_CKW2], 256, 128, 0, 128, Cw2_t, 0, false, scr, lane, gw, NGW, base);
        transpose_seg(a.in[I_CVW2], 256, 128, 0, 128, Cw2_t + 65536, 0, false, scr, lane, gw, NGW, base);
        for (int m = gw; m < M; m += NGW) rms_row_bf16(a.in[I_X] + (size_t)m * DM, a.in[I_F1N], XN + (size_t)m * DM, lane);
        for (int task = gw; task < 256; task += NGW) {
            const int tensor = task >> 7, chunk = (task >> 2) & 31, col = (task & 3) * 64 + lane;
            const float* pe = a.in[tensor ? I_PEV : I_PEK] + chunk * 128; const float* w1 = a.in[tensor ? I_CVW1 : I_CKW1] + (size_t)chunk * 128 * 256 + col;
            float acc = 0.f;
#pragma unroll 8
            for (int k = 0; k < 128; ++k) acc += pe[k] * w1[(size_t)k * 256];
            PEBP[(tensor * 32 + chunk) * 256 + col] = acc;
        }
    }
    SEAM(0);
    if (IN(1)) { pg8::EpiSwiglu E{HID, FF}; run_gemm(lds, XN, DM, Wgu_t, DM, M, 2 * FF, DM, G, bx, E); }
    SEAM(1);
    if (IN(2)) { pg8::EpiResF32 E{a.in[I_X], H, DM, 0.5f}; run_gemm(lds, HID, FF, Wd_t, FF, M, DM, FF, G, bx, E); }
    SEAM(2);
    if (IN(3)) {
        for (int m = gw; m < M; m += NGW) rms_row_bf16(H + (size_t)m * DM, a.in[I_MIXN], XN + (size_t)m * DM, lane);
        if (bx == 0) { float s = 0.f; for (int c = 0; c < 32; ++c) s += PEBP[((tid >> 8) * 32 + c) * 256 + (tid & 255)]; PEB[tid] = s; }
    }
    SEAM(3);
    if (IN(4)) { pg8::EpiP8<FWin> E{FWin{XP, Q, KCVC, KV4, GPOOL, GNSA, NSAG}}; run_gemm(lds, XN, DM, Win_t, DM, M, INW, DM, G, bx, E); }
    SEAM(4);
    if (IN(5)) {
        { pg8::EpiP8<FSiluBias> E{FSiluBias{HIDC, PEB}}; run_gemm(lds, KCVC, 2048, Cw1_t, 4096, 8192, 256, 4096, G, bx, E, 0, 16, 256 * 4096 * 2); }
        const int nthr = G * NWAVES * 64;
        for (int idx = vcu * 512 + tid; idx < M * 128; idx += nthr) {
            const int row = idx >> 7, c8 = (idx & 127) * 8, win = 2 << (c8 >> 8), t = row & (SEQ - 1), n = (t + 1) < win ? (t + 1) : win;
            float acc[8] = {0.f, 0.f, 0.f, 0.f, 0.f, 0.f, 0.f, 0.f}, x0[8];
            for (int j = 0; j < n; ++j) { const v4u w = *(const v4u*)(XP + (size_t)(row - j) * PW + c8);
                const float f[8] = {pg8::bf_lo(w.x), pg8::bf_hi(w.x), pg8::bf_lo(w.y), pg8::bf_hi(w.y), pg8::bf_lo(w.z), pg8::bf_hi(w.z), pg8::bf_lo(w.w), pg8::bf_hi(w.w)};
#pragma unroll
                for (int e = 0; e < 8; ++e) { acc[e] += f[e]; if (j == 0) x0[e] = f[e]; } }
            const float inv = 1.f / (float)n;
            v4u o; o.x = pk2(acc[0] * inv - x0[0], acc[1] * inv - x0[1]); o.y = pk2(acc[2] * inv - x0[2], acc[3] * inv - x0[3]);
            o.z = pk2(acc[4] * inv - x0[4], acc[5] * inv - x0[5]); o.w = pk2(acc[6] * inv - x0[6], acc[7] * inv - x0[7]);
            *(v4u*)(POOLED + (size_t)row * PW + c8) = o;
        }
    }
    SEAM(5);
    if (IN(6)) {
        { pg8::EpiP8<FPool> E{FPool{APOOL, a.in[I_POOLS]}}; run_gemm(lds, POOLED, PW, Poolw_t, 256, M, PW, 256, G, bx, E, 256 * 2); }
        { pg8::EpiP8<FStore128> E{FStore128{KVCMP}}; run_gemm(lds, HIDC, 256, Cw2_t, 256, 8192, 256, 256, G, bx, E, 0, 16, 65536 * 2); }
    }
    SEAM(6);
    if (IN(7)) {
        { pg8::EpiP8<FGate> E{FGate{GPOOL, GPOOL, false}}; run_gemm(lds, APOOL, PW, Wpu_t, PW, M, DM, PW, G, bx, E); }
        for (int it = vcu; it < 1024; it += G) {
            const int c = it & 255, k = it >> 8, bg = c >> 5, i = c & 31;
            const int qb = (k == 0) ? i : (k == 1) ? 63 - i : (k == 2) ? 64 + i : 127 - i;
            nsa::nsa_unit(bg >> 2, bg & 3, qb, Q, KV4, KVCMP, KVCMP + (size_t)4096 * 128, NSAG, Q, (char*)lds_raw);
        }
    }
    SEAM(7);
    if (IN(8)) { pg8::EpiP8<FGate> E{FGate{GPOOL, GNSA, true}}; run_gemm(lds, Q, DM, Wnu_t, DM, M, DM, DM, G, bx, E); }
    SEAM(8);
    if (IN(9)) { pg8::EpiResF32 E{H, H, DM, 1.0f}; run_gemm(lds, GPOOL, DM, Wout_t, DM, M, DM, DM, G, bx, E); }
    SEAM(9);
    if (IN(10)) {
        int base = 0;
        transpose_seg(a.in[I_F2G], DM, FF, 0, FF, Wgu_t, 0, true, scr, lane, gw, NGW, base);
        transpose_seg(a.in[I_F2U], DM, FF, 0, FF, Wgu_t, 128, true, scr, lane, gw, NGW, base);
        transpose_seg(a.in[I_F2D], FF, DM, 0, DM, Wd_t, 0, false, scr, lane, gw, NGW, base);
        for (int m = gw; m < M; m += NGW) rms_row_bf16(H + (size_t)m * DM, a.in[I_F2N], XN + (size_t)m * DM, lane);
    }
    SEAM(10);
    if (IN(11)) { pg8::EpiSwiglu E{HID, FF}; run_gemm(lds, XN, DM, Wgu_t, DM, M, 2 * FF, DM, G, bx, E); }
    SEAM(11);
    if (IN(12)) { pg8::EpiResF32 E{H, H, DM, 0.5f}; run_gemm(lds, HID, FF, Wd_t, FF, M, DM, FF, G, bx, E); }
    SEAM(12);
    if (IN(13)) { for (int m = gw; m < M; m += NGW) rms_row_f32(H + (size_t)m * DM, a.in[I_FINN], lane); }
#undef IN
#undef SEAM
}

#ifndef MK_ONE_LAUNCH
#define MK_ONE_LAUNCH 0
#endif
extern "C" void kernel_launch(void* const* d_in, const int* in_sizes, int n_in, void* d_out, int out_size, void* d_ws, size_t ws_size, hipStream_t stream) {
    static int grid = 0;
    if (grid == 0) {
        if (n_in != 23 || out_size != M * DM || ws_size < WS_END) { fprintf(stderr, "kernel_launch: unexpected shapes (n_in %d out %d ws %zu)\n", n_in, out_size, ws_size); grid = -1; return; }
        int dev = 0, cus = 0, per_cu = 0;
        (void)hipGetDevice(&dev); (void)hipDeviceGetAttribute(&cus, hipDeviceAttributeMultiprocessorCount, dev);
        if (hipFuncSetAttribute((const void*)mk_fwd, hipFuncAttributeMaxDynamicSharedMemorySize, LDS_BYTES) != hipSuccess) { fprintf(stderr, "kernel_launch: hipFuncSetAttribute failed\n"); grid = -1; return; }
        if (hipOccupancyMaxActiveBlocksPerMultiprocessor(&per_cu, (const void*)mk_fwd, NWAVES * 64, LDS_BYTES) != hipSuccess || per_cu < 1) { fprintf(stderr, "kernel_launch: occupancy query says %d\n", per_cu); per_cu = 1; }
        (void)hipGetLastError();
        grid = cus > 0 ? cus : 256;
    }
    if (grid < 0) return;
    Args a{};
    for (int i = 0; i < 23; ++i) a.in[i] = (const float*)d_in[i];
    a.out = (float*)d_out; a.ws = (unsigned char*)d_ws;
#if MK_ONE_LAUNCH
    a.ph_lo = 0; a.ph_hi = N_PHASES;
    void* args[] = {&a};
    hipError_t e = hipLaunchCooperativeKernel((const void*)mk_fwd, dim3(grid), dim3(NWAVES * 64), args, LDS_BYTES, stream);
    if (e != hipSuccess) fprintf(stderr, "kernel_launch: cooperative launch failed: %s (grid %d)\n", hipGetErrorString(e), grid);
#else
    for (int p = 0; p < N_PHASES; ++p) { a.ph_lo = p; a.ph_hi = p + 1; hipLaunchKernelGGL(mk_fwd, dim3(grid), dim3(NWAVES * 64), LDS_BYTES, stream, a); }
#endif
}
```

```cpp
#include <hip/hip_runtime.h>
#include <hip/hip_cooperative_groups.h>
#include <cstdio>
#include <cstdint>
namespace cg = cooperative_groups;
namespace pg8 {
#define PG8_LAS __attribute__((address_space(3)))
typedef unsigned short bf16_t;
typedef short bf16x8 __attribute__((ext_vector_type(8)));
typedef float f32x4 __attribute__((ext_vector_type(4)));
typedef unsigned u32x4 __attribute__((ext_vector_type(4)));
constexpr int BM = 256, BK = 64, HALF = 128, HTB = HALF * BK * 2  , STAGE_BYTES = 8 * HTB, NXCD = 8, WGM = 8;

__host__ __device__ __forceinline__ int lds_byte(int r, int c) { const int st = (r >> 4) * 2 + (c >> 5), rr = r & 15, cc = c & 31, ob = rr * 64 + cc * 2; return st * 1024 + (ob ^ (((ob >> 9) & 1) << 5)); }
__host__ __device__ __forceinline__ void stage_rc(int b, int& R, int& C) { const int st = b / 1024, sb = b % 1024, swz = sb ^ (((sb >> 9) & 1) << 5); R = (st >> 1) * 16 + swz / 64; C = (st & 1) * 32 + (swz % 64) / 2; }
__host__ __device__ __forceinline__ int perm32(int rho) { const int n = rho >> 4, i = rho & 15; return 8 * (i >> 2) + 4 * n + (i & 3); }

struct Unit { int pm, pn; };
struct Gemm { const bf16_t* A; const bf16_t* Bt; int M, N, K, lda, ldb; int apn  , bdiv, bbytes  ; };

struct StaticOrder {
    int nM, nN, nwg, G, c;
    __host__ __device__ void init(int M, int N, int G_, int c_) { nM = M / BM; nN = N / BM; nwg = nM * nN; G = G_; c = c_; }
    __host__ __device__ bool next(int i, Unit& u) const {
        const long L = (long)i * G + c; if (L >= nwg) return false;
        int wgid = (int)L; { const int q = nwg / NXCD, r = nwg % NXCD, xcd = wgid % NXCD, off = wgid / NXCD; wgid = (xcd < r ? xcd * (q + 1) : r * (q + 1) + (xcd - r) * q) + off; }
        const int nig = WGM * nN, gid = wgid / nig, fm = gid * WGM, gsz = (nM - fm) < WGM ? (nM - fm) : WGM;
        u.pm = fm + ((wgid % nig) % gsz); u.pn = (wgid % nig) / gsz; return true;
    }
    __device__ __forceinline__ void a_ready(const Unit&) const {}
    __device__ __forceinline__ void done(const Unit&) const {}
};

__device__ __forceinline__ unsigned cvt_pk_bf16(float lo, float hi) { unsigned r; asm volatile("v_cvt_pk_bf16_f32 %0, %1, %2" : "=v"(r) : "v"(lo), "v"(hi)); return r; }
__device__ __forceinline__ float bf_lo(unsigned w) { return __builtin_bit_cast(float, w << 16); }
__device__ __forceinline__ float bf_hi(unsigned w) { return __builtin_bit_cast(float, w & 0xffff0000u); }
__device__ __forceinline__ float sigmoidf_(float x) { return __builtin_amdgcn_rcpf(1.f + __builtin_amdgcn_exp2f(-1.4426950408889634f * x)); }
__device__ __forceinline__ float siluf_(float x) { return x * sigmoidf_(x); }
__device__ __forceinline__ u32x4 pack8(f32x4 a, f32x4 b) { u32x4 w; w.x = cvt_pk_bf16(a[0], a[1]); w.y = cvt_pk_bf16(a[2], a[3]); w.z = cvt_pk_bf16(b[0], b[1]); w.w = cvt_pk_bf16(b[2], b[3]); return w; }

template <class F> struct EpiP8 {
    static constexpr bool PERM = true, AFTER_DRAIN = false;
    F f;
    __device__ __forceinline__ void operator()(const f32x4 (&acc)[2][2][4][2], const Unit& u, int wr, int wc, int fr, int fq) const {
        const int row0 = u.pm * BM + wr * 64 + fr, col0 = u.pn * BM + wc * 32 + 8 * fq;
#pragma unroll
        for (int ai = 0; ai < 2; ++ai)
#pragma unroll
            for (int m = 0; m < 4; ++m) {
                const int row = row0 + ai * HALF + m * 16;
#pragma unroll
                for (int bj = 0; bj < 2; ++bj) f(row, col0 + bj * HALF, u.pn, acc[ai][bj][m][0], acc[ai][bj][m][1]);
            }
    }
};
struct EpiSwiglu {
    static constexpr bool PERM = true, AFTER_DRAIN = false;
    bf16_t* O; int ldc;
    __device__ __forceinline__ void operator()(const f32x4 (&acc)[2][2][4][2], const Unit& u, int wr, int wc, int fr, int fq) const {
        const int row0 = u.pm * BM + wr * 64 + fr, col0 = u.pn * HALF + wc * 32 + 8 * fq;
#pragma unroll
        for (int ai = 0; ai < 2; ++ai)
#pragma unroll
            for (int m = 0; m < 4; ++m) {
                const int row = row0 + ai * HALF + m * 16;
                f32x4 h0, h1;
#pragma unroll
                for (int j = 0; j < 4; ++j) { h0[j] = siluf_(acc[ai][0][m][0][j]) * acc[ai][1][m][0][j]; h1[j] = siluf_(acc[ai][0][m][1][j]) * acc[ai][1][m][1][j]; }
                *(u32x4*)(O + (size_t)row * ldc + col0) = pack8(h0, h1);
            }
    }
};
struct EpiResF32 {
    static constexpr bool PERM = false, AFTER_DRAIN = false;
    const float* base; float* out; int ldc; float coef;
    __device__ __forceinline__ void operator()(const f32x4 (&acc)[2][2][4][2], const Unit& u, int wr, int wc, int fr, int fq) const {
        const int row0 = u.pm * BM + wr * 64 + fr, col0 = u.pn * BM + wc * 32 + 4 * fq;
#pragma unroll
        for (int ai = 0; ai < 2; ++ai)
#pragma unroll
            for (int m = 0; m < 4; ++m) {
                const size_t off = (size_t)(row0 + ai * HALF + m * 16) * ldc + col0;
#pragma unroll
                for (int bj = 0; bj < 2; ++bj)
#pragma unroll
                    for (int n = 0; n < 2; ++n) { const f32x4 b = *(const f32x4*)(base + off + bj * HALF + n * 16); *(f32x4*)(out + off + bj * HALF + n * 16) = b + acc[ai][bj][m][n] * coef; }
            }
    }
};
template <class Epi, class Sched, bool ALIGN_EPI = false, bool SP2 = false>
__device__ __forceinline__ void gemm_phase(PG8_LAS unsigned char* lds, const Gemm g, const Sched& S, const Epi& E) {
    const int tid = threadIdx.x, wid = __builtin_amdgcn_readfirstlane(tid >> 6), lane = tid & 63, wr = wid >> 2, wc = wid & 3, fr = lane & 15, fq = lane >> 4;
    const int K = g.K, nt = K / BK;
    unsigned voffA[2], voffB[2];
#pragma unroll
    for (int i = 0; i < 2; ++i) { int R, C; stage_rc(tid * 16 + i * 8192, R, C); const int Rb = Epi::PERM ? ((R & ~31) + perm32(R & 31)) : R;
        voffA[i] = (unsigned)(R * g.lda + C) * 2u; voffB[i] = (unsigned)(Rb * g.ldb + C) * 2u; }
    const size_t kstep = (size_t)(BK * 2);
    const size_t hstepA = (size_t)HALF * g.lda * 2, hstepB = (size_t)HALF * g.ldb * 2;
    const size_t tstepA = 2 * hstepA, tstepB = 2 * hstepB;
    const unsigned ldsw = (unsigned)wid * 1024u;
    const int aoff = lds_byte(wr * 64 + fr, fq * 8), boff = lds_byte(wc * 32 + fr, fq * 8);
#define PG8_SA(b, h) (((b) * 2 + (h)) * HTB)
#define PG8_SB(b, h) ((4 + (b) * 2 + (h)) * HTB)
#define PG8_STAGE(bufoff, gbase, voff) do { _Pragma("unroll") for (int _i = 0; _i < 2; ++_i) \
        __builtin_amdgcn_global_load_lds((const unsigned*)((const char*)(gbase) + (voff)[_i]), (PG8_LAS unsigned*)(lds + (bufoff) + ldsw + _i * 8192), 16, 0, 0); } while (0)
#define PG8_LDA(dst, b, h) do { _Pragma("unroll") for (int m = 0; m < 4; ++m) _Pragma("unroll") for (int k = 0; k < 2; ++k) dst[m][k] = *(const PG8_LAS bf16x8*)(lds + PG8_SA(b, h) + aoff + m * 2048 + k * 1024); } while (0)
#define PG8_LDB(dst, b, h) do { _Pragma("unroll") for (int n = 0; n < 2; ++n) _Pragma("unroll") for (int k = 0; k < 2; ++k) dst[n][k] = *(const PG8_LAS bf16x8*)(lds + PG8_SB(b, h) + boff + n * 2048 + k * 1024); } while (0)
#define PG8_MMA(ai, bj, At, Bt) do { __builtin_amdgcn_s_setprio(1); _Pragma("unroll") for (int m = 0; m < 4; ++m) _Pragma("unroll") for (int n = 0; n < 2; ++n) _Pragma("unroll") for (int k = 0; k < 2; ++k) \
        acc[ai][bj][m][n] = __builtin_amdgcn_mfma_f32_16x16x32_bf16(Bt[n][k], At[m][k], acc[ai][bj][m][n], 0, 0, 0); __builtin_amdgcn_s_setprio(0); } while (0)
#define PG8_WAIT_V(n) asm volatile("s_waitcnt vmcnt(" #n ")" ::: "memory")
#define PG8_WAIT_L(n) asm volatile("s_waitcnt lgkmcnt(" #n ")" ::: "memory")
#define PG8_BAR __builtin_amdgcn_s_barrier()
#define PG8_SCHED __builtin_amdgcn_sched_barrier(0)
    Unit cur, nxt; int ui = 0;
    if (!S.next(0, cur)) return;
    f32x4 acc[2][2][4][2];
#pragma unroll
    for (int a = 0; a < 2; ++a)
#pragma unroll
        for (int b = 0; b < 2; ++b)
#pragma unroll
            for (int m = 0; m < 4; ++m)
#pragma unroll
                for (int n = 0; n < 2; ++n) acc[a][b][m][n] = (f32x4){0.f, 0.f, 0.f, 0.f};
    bf16x8 At[4][2], B0[2][2], B1[2][2];
    const char* cA = (const char*)g.A + (size_t)cur.pm * tstepA + (size_t)cur.pn * g.apn; const char* cB = (const char*)g.Bt + (size_t)cur.pn * tstepB + (size_t)(cur.pm / g.bdiv) * g.bbytes;
    S.a_ready(cur);
    if constexpr (SP2) {
        PG8_STAGE(PG8_SB(0, 0), cB, voffB); PG8_STAGE(PG8_SB(0, 1), cB + hstepB, voffB); PG8_STAGE(PG8_SA(0, 0), cA, voffA); PG8_STAGE(PG8_SA(0, 1), cA + hstepA, voffA);
        if (wr == 1) PG8_BAR;
        PG8_WAIT_V(2); PG8_BAR;
        PG8_STAGE(PG8_SB(1, 0), cB + kstep, voffB); PG8_STAGE(PG8_SA(1, 0), cA + kstep, voffA); PG8_STAGE(PG8_SB(1, 1), cB + hstepB + kstep, voffB);
        PG8_WAIT_V(6); PG8_BAR;
    } else {
        PG8_STAGE(PG8_SB(0, 0), cB, voffB); PG8_STAGE(PG8_SA(0, 0), cA, voffA); PG8_STAGE(PG8_SB(0, 1), cB + hstepB, voffB); PG8_STAGE(PG8_SA(0, 1), cA + hstepA, voffA);
        if (wr == 1) PG8_BAR;
        PG8_WAIT_V(4); PG8_BAR;
        PG8_STAGE(PG8_SB(1, 0), cB + kstep, voffB); PG8_STAGE(PG8_SA(1, 0), cA + kstep, voffA); PG8_STAGE(PG8_SB(1, 1), cB + hstepB + kstep, voffB);
        PG8_WAIT_V(6); PG8_BAR;
    }
    for (;;) {
        const bool has_next = S.next(ui + 1, nxt);
        const char* nA = has_next ? (const char*)g.A + (size_t)nxt.pm * tstepA + (size_t)nxt.pn * g.apn : cA; const char* nB = has_next ? (const char*)g.Bt + (size_t)nxt.pn * tstepB + (size_t)(nxt.pm / g.bdiv) * g.bbytes : cB;
#pragma nounroll
        for (int t = 0; t < nt; t += 2) {
            const bool last = (t == nt - 2);
            const char* a1 = cA + (size_t)(t + 1) * kstep;
            const char* a2 = last ? nA : cA + (size_t)(t + 2) * kstep; const char* b2 = last ? nB : cB + (size_t)(t + 2) * kstep;
            const char* a3 = a2 + kstep; const char* b3 = b2 + kstep;
            if (last && has_next) S.a_ready(nxt);
            if constexpr (SP2) {
            PG8_LDB(B0, 0, 0); PG8_LDB(B1, 0, 1); PG8_SCHED; PG8_LDA(At, 0, 0); PG8_STAGE(PG8_SA(1, 1), a1 + hstepA, voffA);
            PG8_WAIT_V(8); PG8_WAIT_L(0); PG8_BAR; PG8_MMA(0, 0, At, B0); PG8_MMA(0, 1, At, B1); PG8_BAR; PG8_SCHED;
            PG8_LDA(At, 0, 1); PG8_STAGE(PG8_SB(0, 0), b2, voffB); PG8_STAGE(PG8_SB(0, 1), b2 + hstepB, voffB); PG8_STAGE(PG8_SA(0, 0), a2, voffA);
            PG8_WAIT_V(8); PG8_WAIT_L(0); PG8_BAR; PG8_MMA(1, 0, At, B0); PG8_MMA(1, 1, At, B1); PG8_BAR; PG8_SCHED;
            PG8_LDB(B0, 1, 0); PG8_LDB(B1, 1, 1); PG8_SCHED; PG8_LDA(At, 1, 0); PG8_STAGE(PG8_SA(0, 1), a2 + hstepA, voffA);
            PG8_WAIT_V(8); PG8_WAIT_L(0); PG8_BAR; PG8_MMA(0, 0, At, B0); PG8_MMA(0, 1, At, B1); PG8_BAR; PG8_SCHED;
            PG8_LDA(At, 1, 1); PG8_STAGE(PG8_SB(1, 0), b3, voffB); PG8_STAGE(PG8_SB(1, 1), b3 + hstepB, voffB); PG8_STAGE(PG8_SA(1, 0), a3, voffA);
            PG8_WAIT_V(8); PG8_WAIT_L(0); PG8_BAR; PG8_MMA(1, 0, At, B0); PG8_MMA(1, 1, At, B1); PG8_BAR; PG8_SCHED;
            } else {
            PG8_LDB(B0, 0, 0); PG8_SCHED; PG8_LDA(At, 0, 0); PG8_STAGE(PG8_SA(1, 1), a1 + hstepA, voffA);
            PG8_WAIT_L(8); PG8_BAR; PG8_WAIT_L(0); PG8_MMA(0, 0, At, B0); PG8_BAR; PG8_SCHED;
            PG8_LDB(B1, 0, 1); PG8_STAGE(PG8_SB(0, 0), b2, voffB);
            PG8_BAR; PG8_WAIT_L(0); PG8_MMA(0, 1, At, B1); PG8_BAR;
            PG8_LDA(At, 0, 1); PG8_STAGE(PG8_SA(0, 0), a2, voffA);
            PG8_BAR; PG8_WAIT_L(0); PG8_MMA(1, 0, At, B0); PG8_BAR; PG8_SCHED;
            PG8_STAGE(PG8_SB(0, 1), b2 + hstepB, voffB);
            PG8_WAIT_V(6); PG8_BAR; PG8_MMA(1, 1, At, B1); PG8_BAR;
            PG8_LDB(B0, 1, 0); PG8_SCHED; PG8_LDA(At, 1, 0); PG8_STAGE(PG8_SA(0, 1), a2 + hstepA, voffA);
            PG8_WAIT_L(8); PG8_BAR; PG8_WAIT_L(0); PG8_MMA(0, 0, At, B0); PG8_BAR; PG8_SCHED;
            PG8_LDB(B1, 1, 1); PG8_STAGE(PG8_SB(1, 0), b3, voffB);
            PG8_BAR; PG8_WAIT_L(0); PG8_MMA(0, 1, At, B1); PG8_BAR;
            PG8_LDA(At, 1, 1); PG8_STAGE(PG8_SA(1, 0), a3, voffA);
            PG8_BAR; PG8_WAIT_L(0); PG8_MMA(1, 0, At, B0); PG8_BAR; PG8_SCHED;
            PG8_STAGE(PG8_SB(1, 1), b3 + hstepB, voffB);
            PG8_WAIT_V(6); PG8_BAR; PG8_MMA(1, 1, At, B1); PG8_BAR;
            }
        }
        if constexpr (ALIGN_EPI) { if (wr == 0) PG8_BAR; }
        if constexpr (!Epi::AFTER_DRAIN) { E(acc, cur, wr, wc, fr, fq); S.done(cur); }
        if (!has_next) break;
#pragma unroll
        for (int a = 0; a < 2; ++a)
#pragma unroll
            for (int b = 0; b < 2; ++b)
#pragma unroll
                for (int m = 0; m < 4; ++m)
#pragma unroll
                    for (int n = 0; n < 2; ++n) acc[a][b][m][n] = (f32x4){0.f, 0.f, 0.f, 0.f};
        cur = nxt; cA = nA; cB = nB; ++ui;
        if constexpr (ALIGN_EPI) { if (wr == 1) PG8_BAR; }
    }
    PG8_WAIT_V(0);
    if constexpr (!ALIGN_EPI) { if (wr == 0) PG8_BAR; }
    PG8_BAR;
    if constexpr (Epi::AFTER_DRAIN) { E.fused(acc, cur, wr, wc, fr, fq, lds, wid, lane); S.done(cur); }
#undef PG8_SA
#undef PG8_SB
#undef PG8_STAGE
#undef PG8_LDA
#undef PG8_LDB
#undef PG8_MMA
#undef PG8_WAIT_V
#undef PG8_WAIT_L
#undef PG8_BAR
#undef PG8_SCHED
}
}
namespace nsa {
typedef unsigned short bf16_t;
typedef short bf16x8 __attribute__((ext_vector_type(8)));
typedef short s16x4 __attribute__((ext_vector_type(4)));
typedef float f32x16 __attribute__((ext_vector_type(16)));
typedef float f32x4 __attribute__((ext_vector_type(4)));
typedef unsigned u32x4 __attribute__((ext_vector_type(4)));
constexpr int D = 128, KVBLK = 64, SHM_K = 16384, SHM_V = 16384, SEQ = 8192;
constexpr float SCALE = 0.08838834764831845f, C2 = 1.4426950408889634f * SCALE, THR = 8.f;
constexpr int L_V = 0, L_K = 16384, L_WS = 32768, L_SELM = 34816, L_IMP = 36864, L_END = L_IMP + 64 * 128 * 4;
#define KSWZ(row, colB) ((row) * 256 + ((colB) ^ (((row) & 7) << 4)))
#define SBAR() __builtin_amdgcn_sched_barrier(0)
__device__ __forceinline__ int v_st(int k, int c) { const int kk = (k & ~0xC) | ((k & 4) << 1) | ((k & 8) >> 1); return ((kk >> 3) * 4 + (c >> 5)) * 512 + ((kk & 7) * 32 + (c & 31)) * 2; }
__device__ __forceinline__ int v_rd_base(int lane) { return ((lane & 3) << 3) | (((lane >> 2) & 3) << 6) | (((lane >> 4) & 1) << 5) | (((lane >> 5) & 1) << 8); }
constexpr int v_rd_off(int d0, int ks, int half) { return d0 * 512 + ks * 4096 + half * 2048; }
__device__ __forceinline__ int crow(int r, int hi) { return (r & 3) + 8 * (r >> 2) + 4 * hi; }
__device__ __forceinline__ unsigned cvtpk(float lo, float hi) { unsigned r; asm volatile("v_cvt_pk_bf16_f32 %0, %1, %2" : "=v"(r) : "v"(lo), "v"(hi)); return r; }
__device__ __forceinline__ void mask_tile(f32x16& p0, f32x16& p1, int dq, unsigned W) {
    const float NEG = -__builtin_inff();
#pragma unroll
    for (int r = 0; r < 16; ++r) {
        const int c = (r & 3) + 8 * (r >> 2);
        if ((unsigned)(dq - c) >= W) p0[r] = NEG;
        if ((unsigned)(dq - c - 32) >= W) p1[r] = NEG;
    }
}
__device__ __forceinline__ float rowmax32(const f32x16& p0, const f32x16& p1) {
    float pmax = p0[0];
#pragma unroll
    for (int r = 1; r < 16; ++r) pmax = fmaxf(pmax, p0[r]);
#pragma unroll
    for (int r = 0; r < 16; ++r) pmax = fmaxf(pmax, p1[r]);
    auto rr = __builtin_amdgcn_permlane32_swap(__float_as_uint(pmax), __float_as_uint(pmax), false, false);
    return fmaxf(__uint_as_float(rr[0]), __uint_as_float(rr[1]));
}
__device__ __forceinline__ float rowsum32(const f32x16& p0, const f32x16& p1) {
    float ps = 0.f;
#pragma unroll
    for (int r = 0; r < 16; ++r) ps += p0[r];
#pragma unroll
    for (int r = 0; r < 16; ++r) ps += p1[r];
    auto rr = __builtin_amdgcn_permlane32_swap(__float_as_uint(ps), __float_as_uint(ps), false, false);
    return __uint_as_float(rr[0]) + __uint_as_float(rr[1]);
}
__device__ __forceinline__ void packP(const f32x16& p0, const f32x16& p1, bf16x8& pa0, bf16x8& pa1, bf16x8& pa2, bf16x8& pa3) {
#define PK4(P, B_, OUT) do { unsigned a0 = cvtpk(P[B_+0], P[B_+1]), a1 = cvtpk(P[B_+2], P[B_+3]);                          \
        unsigned b0 = cvtpk(P[B_+4], P[B_+5]), b1 = cvtpk(P[B_+6], P[B_+7]);                                             \
        auto r0 = __builtin_amdgcn_permlane32_swap(a0, b0, false, false); auto r1 = __builtin_amdgcn_permlane32_swap(a1, b1, false, false); \
        u32x4 w = {r0[0], r1[0], r0[1], r1[1]}; OUT = *reinterpret_cast<bf16x8*>(&w); } while (0)
    PK4(p0, 0, pa0); PK4(p0, 8, pa1); PK4(p1, 0, pa2); PK4(p1, 8, pa3);
#undef PK4
}
__device__ __forceinline__ void qkt(f32x16& p0, f32x16& p1, const char* K_lds, int r32, int hi, const bf16x8* qr) {
    p0 = f32x16{}; p1 = f32x16{};
    const char* kb[4];
#pragma unroll
    for (int dd = 0; dd < 4; ++dd) kb[dd] = K_lds + KSWZ(r32, (dd * 16 + hi * 8) * 2);
#pragma unroll
    for (int d0 = 0; d0 < 8; ++d0) { const char* a = kb[d0 & 3] + (d0 >> 2) * 128;
        bf16x8 b0 = *reinterpret_cast<const bf16x8*>(a);
        bf16x8 b1 = *reinterpret_cast<const bf16x8*>(a + 32 * 256);
        p0 = __builtin_amdgcn_mfma_f32_32x32x16_bf16(b0, qr[d0], p0, 0, 0, 0);
        p1 = __builtin_amdgcn_mfma_f32_32x32x16_bf16(b1, qr[d0], p1, 0, 0, 0); }
}
__device__ __forceinline__ void pv_tile(f32x16* o, int vb0, bf16x8 pa0, bf16x8 pa1, bf16x8 pa2, bf16x8 pa3) {
#define TRRD(dst, off) asm volatile("ds_read_b64_tr_b16 %0, %1 offset:%2" : "=&v"(dst) : "v"(vb0), "i"(off) : "memory")
#define PV_D0(d0) do { s16x4 l0, l1, l2, l3, h0, h1, h2, h3; constexpr int b_ = v_rd_off(d0, 0, 0); \
        TRRD(l0, b_); TRRD(h0, b_ + 2048); TRRD(l1, b_ + 4096); TRRD(h1, b_ + 6144); TRRD(l2, b_ + 8192); TRRD(h2, b_ + 10240); TRRD(l3, b_ + 12288); TRRD(h3, b_ + 14336); \
        asm volatile("s_waitcnt lgkmcnt(0)" ::: "memory"); SBAR();   \
        o[d0] = __builtin_amdgcn_mfma_f32_32x32x16_bf16(pa0, (bf16x8){l0[0], l0[1], l0[2], l0[3], h0[0], h0[1], h0[2], h0[3]}, o[d0], 0, 0, 0);   \
        o[d0] = __builtin_amdgcn_mfma_f32_32x32x16_bf16(pa1, (bf16x8){l1[0], l1[1], l1[2], l1[3], h1[0], h1[1], h1[2], h1[3]}, o[d0], 0, 0, 0);   \
        o[d0] = __builtin_amdgcn_mfma_f32_32x32x16_bf16(pa2, (bf16x8){l2[0], l2[1], l2[2], l2[3], h2[0], h2[1], h2[2], h2[3]}, o[d0], 0, 0, 0);   \
        o[d0] = __builtin_amdgcn_mfma_f32_32x32x16_bf16(pa3, (bf16x8){l3[0], l3[1], l3[2], l3[3], h3[0], h3[1], h3[2], h3[3]}, o[d0], 0, 0, 0); } while (0)
    PV_D0(0); PV_D0(1); PV_D0(2); PV_D0(3);
#undef PV_D0
#undef TRRD
}

template <bool STATS, int KIND>
__device__ __forceinline__ void attend(const bf16_t* __restrict__ Kg, const bf16_t* __restrict__ Vg, int j_lo, int j_hi, int pos, unsigned W,
                                       char* lds, const bf16x8* qr, float& m_reg, float& l_reg, f32x16* o, float f_imp, float f_o, int qb) {
    const int tid = threadIdx.x, wid = __builtin_amdgcn_readfirstlane(tid >> 6), lane = tid & 63, r32 = lane & 31, hi = lane >> 5;
    char* V_lds = lds + L_V; char* K_lds = lds + L_K;
    const int sr = tid >> 4, sc = (tid & 15) * 8, vst0 = v_st(sr, sc), vst1 = v_st(32 + sr, sc), kws = KSWZ(sr, sc * 2);
    const int vb0 = (int)(uintptr_t)V_lds + v_rd_base(lane);
    const int qloc = wid * 8 + (r32 >> 2);
    bf16x8 sk0, sk1, sv0, sv1;
#define NSA_GLOAD(j) do { const bf16_t* kp_ = Kg + (size_t)((j) * KVBLK + sr) * D + sc; sk0 = *(const bf16x8*)kp_; sk1 = *(const bf16x8*)(kp_ + 32 * D); \
        if (!STATS) { const bf16_t* vp_ = Vg + (size_t)((j) * KVBLK + sr) * D + sc; sv0 = *(const bf16x8*)vp_; sv1 = *(const bf16x8*)(vp_ + 32 * D); } } while (0)
    if (j_lo < j_hi) NSA_GLOAD(j_lo);
    for (int j = j_lo; j < j_hi; ++j) {
        __syncthreads();
        *(bf16x8*)(K_lds + kws) = sk0; *(bf16x8*)(K_lds + kws + 32 * 256) = sk1;
        if (!STATS) { *(bf16x8*)(V_lds + vst0) = sv0; *(bf16x8*)(V_lds + vst1) = sv1; }
        __syncthreads();
        if (j + 1 < j_hi) NSA_GLOAD(j + 1);
        const int kb = j * KVBLK;
        bool rowsel = true, act = true;
        if (KIND == 2) { const unsigned wsel = ((const unsigned*)(lds + L_SELM))[qloc * 4 + (j >> 5)]; rowsel = ((wsel >> (j & 31)) & 1u) != 0u; act = __any(rowsel); }
        if (act) {
            f32x16 p0, p1;
            qkt(p0, p1, K_lds, r32, hi, qr);
            if (KIND == 2) {
                if (j == qb) mask_tile(p0, p1, pos - kb - 4 * hi, W);
                if (!rowsel) { const float NEG = -__builtin_inff();
#pragma unroll
                    for (int r = 0; r < 16; ++r) { p0[r] = NEG; p1[r] = NEG; } }
            } else mask_tile(p0, p1, pos - kb - 4 * hi, W);
            if (STATS) {
                const float pmax = rowmax32(p0, p1), mn = fmaxf(m_reg, pmax), alpha = __builtin_amdgcn_exp2f((m_reg - mn) * C2), mnL = -mn * C2;
#pragma unroll
                for (int r = 0; r < 16; ++r) { p0[r] = __builtin_amdgcn_exp2f(fmaf(p0[r], C2, mnL)); p1[r] = __builtin_amdgcn_exp2f(fmaf(p1[r], C2, mnL)); }
                l_reg = l_reg * alpha + rowsum32(p0, p1); m_reg = mn;
            } else {
                const float mnL = -m_reg * C2;
#pragma unroll
                for (int r = 0; r < 16; ++r) { p0[r] = __builtin_amdgcn_exp2f(fmaf(p0[r], C2, mnL)); p1[r] = __builtin_amdgcn_exp2f(fmaf(p1[r], C2, mnL)); }
                if (KIND == 1) {
                    float* imp = (float*)(lds + L_IMP) + qloc * 128 + (kb >> 2);
#pragma unroll
                    for (int half = 0; half < 2; ++half)
#pragma unroll
                        for (int i = 0; i < 4; ++i) {
                            const f32x16& P = half ? p1 : p0;
                            float G = ((P[4 * i] + P[4 * i + 1]) + (P[4 * i + 2] + P[4 * i + 3])) * f_imp, L = P[4 * i + 3] * f_imp;
                            G += __shfl_xor(G, 1); G += __shfl_xor(G, 2); L += __shfl_xor(L, 1); L += __shfl_xor(L, 2);
                            const int jl = half * 8 + 2 * i + hi;
                            if ((r32 & 3) == 0) { atomicAdd(imp + jl, G); if ((kb >> 2) + jl + 1 < 128) atomicAdd(imp + jl + 1, L); }
                        }
                }
#pragma unroll
                for (int r = 0; r < 16; ++r) { p0[r] *= f_o; p1[r] *= f_o; }
                bf16x8 pa0, pa1, pa2, pa3;
                packP(p0, p1, pa0, pa1, pa2, pa3);
                pv_tile(o, vb0, pa0, pa1, pa2, pa3);
            }
        }
    }
#undef NSA_GLOAD
}

__device__ __forceinline__ float bf2f(bf16_t v) { return __builtin_bit_cast(float, (unsigned)v << 16); }
__device__ __forceinline__ float sigm(float x) { return __builtin_amdgcn_rcpf(1.f + __builtin_amdgcn_exp2f(-1.4426950408889634f * x)); }

__device__ __forceinline__ void nsa_unit(int b, int g, int qb, const bf16_t* Q, const bf16_t* KV4, const bf16_t* KCMP, const bf16_t* VCMP, const bf16_t* NSAG, bf16_t* OUT, char* lds) {
    const int tid = threadIdx.x, wid = __builtin_amdgcn_readfirstlane(tid >> 6), lane = tid & 63, r32 = lane & 31, hi = lane >> 5;
    const int ql = wid * 8 + (r32 >> 2), h = r32 & 3, t = qb * 64 + ql;
    const size_t row = (size_t)b * SEQ + t;
    bf16x8 qr[8];
    { const bf16_t* qp = Q + row * 2048 + g * 512 + h * 128 + hi * 8;
#pragma unroll
      for (int d0 = 0; d0 < 8; ++d0) qr[d0] = *(const bf16x8*)(qp + d0 * 16); }
    { f32x4* z = (f32x4*)((float*)(lds + L_IMP) + wid * 8 * 128) + lane;
#pragma unroll
      for (int i = 0; i < 4; ++i) z[64 * i] = (f32x4){0.f, 0.f, 0.f, 0.f}; }
    const float gc = sigm(bf2f(NSAG[row * 256 + 0 * 16 + g * 4 + h])), gs = sigm(bf2f(NSAG[row * 256 + 1 * 16 + g * 4 + h])), gw = sigm(bf2f(NSAG[row * 256 + 2 * 16 + g * 4 + h]));
    const int bg = b * 4 + g;
    const size_t TSTR = (size_t)8 * SEQ * D;
    f32x16 comb[4];
#pragma unroll
    for (int d_ = 0; d_ < 4; ++d_) comb[d_] = f32x16{};
    {
        const bf16_t* kc = KCMP + (size_t)bg * 512 * D; const bf16_t* vc = VCMP + (size_t)bg * 512 * D;
        const int nmax = (t - 31) >> 4, jh = (4 * qb + 3 + 63) >> 6;
        float m1 = -1e30f, l1 = 0.f;
        attend<true, 1>(kc, vc, 0, jh, nmax, 0x7fffffffu, lds, qr, m1, l1, comb, 0.f, 0.f, qb);
        const float inv_l = l1 > 0.f ? 1.f / l1 : 0.f;
        attend<false, 1>(kc, vc, 0, jh, nmax, 0x7fffffffu, lds, qr, m1, l1, comb, inv_l, gc * inv_l, qb);
    }
    {
        asm volatile("s_waitcnt lgkmcnt(0)" ::: "memory");
        unsigned* SELM = (unsigned*)(lds + L_SELM);
        const unsigned* IMPu = (const unsigned*)(lds + L_IMP);
        if (qb >= 16) {
            for (int i = 0; i < 8; ++i) {
                const int q = wid * 8 + i;
                const unsigned vlo = IMPu[q * 128 + lane], vhi = IMPu[q * 128 + 64 + lane];
                const bool clo = (lane >= 1) && (lane <= qb - 2), chi = (64 + lane <= qb - 2);
                unsigned T = 0u;
                for (int bit = 30; bit >= 0; --bit) { const unsigned c = T | (1u << bit);
                    const int cnt = __popcll(__ballot(clo && vlo >= c)) + __popcll(__ballot(chi && vhi >= c));
                    if (cnt >= 13) T = c; }
                unsigned long long sel_lo = __ballot(clo && vlo > T), sel_hi = __ballot(chi && vhi > T);
                unsigned long long eq_lo = __ballot(clo && vlo == T), eq_hi = __ballot(chi && vhi == T);
                int need = 13 - __popcll(sel_lo) - __popcll(sel_hi);
                for (; need > 0; --need) {
                    if (eq_lo) { const unsigned long long lb = eq_lo & (0ull - eq_lo); sel_lo |= lb; eq_lo ^= lb; }
                    else if (eq_hi) { const unsigned long long lb = eq_hi & (0ull - eq_hi); sel_hi |= lb; eq_hi ^= lb; }
                }
                sel_lo |= 1ull;
                if (qb - 1 < 64) sel_lo |= 1ull << (qb - 1); else sel_hi |= 1ull << (qb - 1 - 64);
                if (qb < 64) sel_lo |= 1ull << qb; else sel_hi |= 1ull << (qb - 64);
                if (lane == 0) { SELM[q * 4 + 0] = (unsigned)sel_lo; SELM[q * 4 + 1] = (unsigned)(sel_lo >> 32); SELM[q * 4 + 2] = (unsigned)sel_hi; SELM[q * 4 + 3] = (unsigned)(sel_hi >> 32); }
            }
        } else {
            if (lane < 8) { const int q = wid * 8 + lane; SELM[q * 4 + 0] = (2u << qb) - 1u; SELM[q * 4 + 1] = 0u; SELM[q * 4 + 2] = 0u; SELM[q * 4 + 3] = 0u; }
        }
        asm volatile("s_waitcnt lgkmcnt(0)" ::: "memory");
    }
    {
        const bf16_t* ks = KV4 + 0 * TSTR + (size_t)bg * SEQ * D; const bf16_t* vs = KV4 + 1 * TSTR + (size_t)bg * SEQ * D;
        float m = -1e30f, l = 0.f;
        attend<true, 2>(ks, vs, 0, qb + 1, t, 0x7fffffffu, lds, qr, m, l, comb, 0.f, 0.f, qb);
        attend<false, 2>(ks, vs, 0, qb + 1, t, 0x7fffffffu, lds, qr, m, l, comb, 0.f, l > 0.f ? gs / l : 0.f, qb);
    }
    {
        const bf16_t* kw = KV4 + 2 * TSTR + (size_t)bg * SEQ * D; const bf16_t* vw = KV4 + 3 * TSTR + (size_t)bg * SEQ * D;
        const int jl = qb >= 8 ? qb - 8 : 0;
        float m = -1e30f, l = 0.f;
        attend<true, 0>(kw, vw, jl, qb + 1, t, 512u, lds, qr, m, l, comb, 0.f, 0.f, qb);
        attend<false, 0>(kw, vw, jl, qb + 1, t, 512u, lds, qr, m, l, comb, 0.f, l > 0.f ? gw / l : 0.f, qb);
    }
#pragma unroll
    for (int r = 0; r < 16; ++r) { const int wrow = crow(r, hi), oq = wid * 8 + (wrow >> 2), oh = wrow & 3;
        bf16_t* op = OUT + ((size_t)b * SEQ + qb * 64 + oq) * 2048 + g * 512 + oh * 128;
#pragma unroll
        for (int d0 = 0; d0 < 4; ++d0) { const float v = comb[d0][r], vn = __shfl_xor(v, 1);
            if ((r32 & 1) == 0) *(unsigned*)(op + d0 * 32 + r32) = cvtpk(v, vn); } }
    __syncthreads();
}
#undef KSWZ
#undef SBAR
}
constexpr int NWAVES = 8;
constexpr int SEQ = 8192, M = 2 * SEQ, DM = 2048, FF = 5632, INW_SRC = 10288, INW = 10496, PW = 1024;
constexpr float RMS_EPS = 1e-6f;
constexpr size_t MiB = 1u << 20;
constexpr size_t WS_WIN = 0, WS_WPU = 42 * MiB, WS_WNU = 46 * MiB, WS_WOUT = 54 * MiB, WS_POOLW = 62 * MiB, WS_CW1 = 63 * MiB, WS_CW2 = 67 * MiB;
constexpr size_t WS_PEBP = 68 * MiB, WS_PEB = 68 * MiB + 512 * 1024, WS_HIDC = 69 * MiB, WS_KVCMP = 73 * MiB;
constexpr size_t WS_WGU = 76 * MiB, WS_WD = 120 * MiB, WS_GNSA = 76 * MiB;
constexpr size_t WS_XN = 142 * MiB, WS_POOLED = 142 * MiB, WS_APOOL = 174 * MiB;
constexpr size_t WS_HID = 206 * MiB, WS_XP = 206 * MiB, WS_Q = 238 * MiB, WS_NSAG = 302 * MiB, WS_KV4 = 310 * MiB;
constexpr size_t WS_GPOOL = 382 * MiB, WS_KCVC = 446 * MiB, WS_END = 480 * MiB;
static_assert(WS_WIN + (size_t)INW * DM * 2 <= WS_WPU && WS_WGU + (size_t)2 * FF * DM * 2 <= WS_WD && WS_WD + (size_t)DM * FF * 2 <= WS_XN && WS_GNSA + (size_t)M * DM * 2 <= WS_XN, "ws map 1");
static_assert(WS_HID + (size_t)M * FF * 2 <= WS_GPOOL && WS_KV4 + (size_t)4 * M * 512 * 2 <= WS_GPOOL && WS_NSAG + (size_t)M * 256 * 2 <= WS_KV4 && WS_KCVC + (size_t)2 * M * 512 * 2 + 8192 <= WS_END, "ws map 2");
constexpr int LDS_BYTES = 147456;
#define GAS __attribute__((address_space(1)))
#define LAS __attribute__((address_space(3)))
typedef unsigned short bf16;
typedef unsigned v4u __attribute__((ext_vector_type(4)));
typedef float f32x4 __attribute__((ext_vector_type(4)));
#define LDS_WAIT() asm volatile("s_waitcnt lgkmcnt(0)" ::: "memory")
__device__ __forceinline__ unsigned f2bf(float f) { unsigned u = __builtin_bit_cast(unsigned, f); return (u + 0x7fffu + ((u >> 16) & 1u)) >> 16; }
__device__ __forceinline__ unsigned pk2(float lo, float hi) { return f2bf(lo) | (f2bf(hi) << 16); }
__device__ __forceinline__ float wave_sum(float v) {
#pragma unroll
    for (int o = 1; o < 64; o <<= 1) v += __shfl_xor(v, o);
    return v;
}
__device__ __forceinline__ void transpose_item(const float* W, int K, int N, int c0, int nvalid, bf16* WT, int drow, int k0, LAS float* scr, int lane) {
    const bool cv = (lane & 31) < nvalid;
#pragma unroll 8
    for (int i = 0; i < 32; ++i) { const int kk = 2 * i + (lane >> 5); scr[kk * 33 + (lane & 31)] = cv ? W[(size_t)(k0 + kk) * N + c0 + (lane & 31)] : 0.f; }
    LDS_WAIT(); asm volatile("" ::: "memory");
    const int c = lane & 7;
#pragma unroll
    for (int j = 0; j < 4; ++j) { const int n = (lane >> 3) + 8 * j; const LAS float* s = scr + (8 * c) * 33 + n;
        v4u o; o.x = pk2(s[0 * 33], s[1 * 33]); o.y = pk2(s[2 * 33], s[3 * 33]); o.z = pk2(s[4 * 33], s[5 * 33]); o.w = pk2(s[6 * 33], s[7 * 33]);
        if (n < nvalid) *(v4u*)(WT + (size_t)(drow + n) * K + k0 + 8 * c) = o; }
    LDS_WAIT(); asm volatile("" ::: "memory");
}
__device__ __forceinline__ void transpose_seg(const float* W, int K, int N, int src0, int ncols, bf16* WT, int drow0, bool gu, LAS float* scr, int lane, int gw, int NGW, int& base) {
    const int nblk = (ncols + 31) >> 5, nitems = (K >> 6) * nblk;
    int first = (gw - base) % NGW; if (first < 0) first += NGW;
    for (int it = first; it < nitems; it += NGW) {
        const int kb = it / nblk, nb = it - kb * nblk, c0 = nb * 32, nv = (ncols - c0) < 32 ? (ncols - c0) : 32;
        const int drow = gu ? (256 * (c0 >> 7) + (c0 & 127) + drow0) : (drow0 + c0);
        transpose_item(W, K, N, src0 + c0, nv, WT, drow, kb * 64, scr, lane);
    }
    base = (base + nitems) % NGW;
}
__device__ __forceinline__ void rms_row_bf16(const float* xrow, const float* g, bf16* orow, int lane) {
    const f32x4* xr = (const f32x4*)xrow + lane; const f32x4* gr = (const f32x4*)g + lane;
    f32x4 v[8]; float s = 0.f;
#pragma unroll
    for (int j = 0; j < 8; ++j) { v[j] = xr[64 * j]; s += (v[j].x * v[j].x + v[j].y * v[j].y) + (v[j].z * v[j].z + v[j].w * v[j].w); }
    const float rs = 1.f / sqrtf(wave_sum(s) * (1.f / DM) + RMS_EPS);
    unsigned long long* o8 = (unsigned long long*)orow + lane;
#pragma unroll
    for (int j = 0; j < 8; ++j) { const f32x4 gg = gr[64 * j];
        o8[64 * j] = (unsigned long long)pk2(v[j].x * rs * gg.x, v[j].y * rs * gg.y) | ((unsigned long long)pk2(v[j].z * rs * gg.z, v[j].w * rs * gg.w) << 32); }
}
__device__ __forceinline__ void rms_row_f32(float* xrow, const float* g, int lane) {
    f32x4* xr = (f32x4*)xrow + lane; const f32x4* gr = (const f32x4*)g + lane;
    f32x4 v[8]; float s = 0.f;
#pragma unroll
    for (int j = 0; j < 8; ++j) { v[j] = xr[64 * j]; s += (v[j].x * v[j].x + v[j].y * v[j].y) + (v[j].z * v[j].z + v[j].w * v[j].w); }
    const float rs = 1.f / sqrtf(wave_sum(s) * (1.f / DM) + RMS_EPS);
#pragma unroll
    for (int j = 0; j < 8; ++j) { const f32x4 gg = gr[64 * j]; xr[64 * j] = (f32x4){v[j].x * rs * gg.x, v[j].y * rs * gg.y, v[j].z * rs * gg.z, v[j].w * rs * gg.w}; }
}
using pg8::u32x4;
struct FWin {
    bf16 *XP, *Q, *KCVC, *KV4, *GPOOL, *GNSA, *NSAG;
    __device__ __forceinline__ void operator()(int row, int col, int pn, pg8::f32x4 v0, pg8::f32x4 v1) const {
        const u32x4 w = pg8::pack8(v0, v1); bf16* dst;
        if (pn < 4) dst = XP + (size_t)row * 1024 + col;
        else if (pn < 12) dst = Q + (size_t)row * 2048 + (col - 1024);
        else if (pn < 24) { const int c = col - 3072, tensor = c >> 9, g = (c >> 7) & 3, d = c & 127, b = row >> 13, t = row & 8191;
            dst = (tensor < 2 ? KCVC + (size_t)tensor * 8 * SEQ * 128 : KV4 + (size_t)(tensor - 2) * 8 * SEQ * 128) + ((size_t)(b * 4 + g) * SEQ + t) * 128 + d; }
        else if (pn < 32) dst = GPOOL + (size_t)row * 2048 + (col - 6144);
        else if (pn < 40) dst = GNSA + (size_t)row * 2048 + (col - 8192);
        else dst = NSAG + (size_t)row * 256 + (col - 10240);
        *(u32x4*)dst = w;
    }
};
struct FSiluBias { bf16* O; const float* bias;
    __device__ __forceinline__ void operator()(int row, int col, int pn, pg8::f32x4 v0, pg8::f32x4 v1) const {
        const float* bp = bias + ((row >> 12) << 8) + col; const pg8::f32x4 b0 = *(const pg8::f32x4*)bp, b1 = *(const pg8::f32x4*)(bp + 4);
#pragma unroll
        for (int j = 0; j < 4; ++j) { v0[j] = pg8::siluf_(v0[j] + b0[j]); v1[j] = pg8::siluf_(v1[j] + b1[j]); }
        *(u32x4*)(O + (size_t)row * 256 + col) = pg8::pack8(v0, v1);
    }
};
struct FStore128 { bf16* O;
    __device__ __forceinline__ void operator()(int row, int col, int pn, pg8::f32x4 v0, pg8::f32x4 v1) const {
        if (col < 128) *(u32x4*)(O + (size_t)row * 128 + col) = pg8::pack8(v0, v1);
    }
};
struct FPool { bf16* O; const float* scale;
    __device__ __forceinline__ void operator()(int row, int col, int pn, pg8::f32x4 v0, pg8::f32x4 v1) const {
        const pg8::f32x4 s0 = *(const pg8::f32x4*)(scale + col), s1 = *(const pg8::f32x4*)(scale + col + 4);
        *(u32x4*)(O + (size_t)row * PW + col) = pg8::pack8(v0 * s0, v1 * s1);
    }
};
struct FGate { bf16* MG; const bf16* Gt; bool add;
    __device__ __forceinline__ void operator()(int row, int col, int pn, pg8::f32x4 v0, pg8::f32x4 v1) const {
        const size_t off = (size_t)row * DM + col;
        const u32x4 gw = *(const u32x4*)(Gt + off);
        pg8::f32x4 r0, r1;
        r0[0] = pg8::sigmoidf_(pg8::bf_lo(gw.x)) * v0[0]; r0[1] = pg8::sigmoidf_(pg8::bf_hi(gw.x)) * v0[1]; r0[2] = pg8::sigmoidf_(pg8::bf_lo(gw.y)) * v0[2]; r0[3] = pg8::sigmoidf_(pg8::bf_hi(gw.y)) * v0[3];
        r1[0] = pg8::sigmoidf_(pg8::bf_lo(gw.z)) * v1[0]; r1[1] = pg8::sigmoidf_(pg8::bf_hi(gw.z)) * v1[1]; r1[2] = pg8::sigmoidf_(pg8::bf_lo(gw.w)) * v1[2]; r1[3] = pg8::sigmoidf_(pg8::bf_hi(gw.w)) * v1[3];
        if (add) { const u32x4 mw = *(const u32x4*)(MG + off);
            r0[0] += pg8::bf_lo(mw.x); r0[1] += pg8::bf_hi(mw.x); r0[2] += pg8::bf_lo(mw.y); r0[3] += pg8::bf_hi(mw.y);
            r1[0] += pg8::bf_lo(mw.z); r1[1] += pg8::bf_hi(mw.z); r1[2] += pg8::bf_lo(mw.w); r1[3] += pg8::bf_hi(mw.w); }
        *(u32x4*)(MG + off) = pg8::pack8(r0, r1);
    }
};

struct Args { const float* in[23]; float* out; unsigned char* ws; int ph_lo, ph_hi; };
enum { I_X = 0, I_F1N, I_F1G, I_F1U, I_F1D, I_MIXN, I_WIN, I_POOLW, I_POOLS, I_PEK, I_PEV, I_CKW1, I_CKW2, I_CVW1, I_CVW2, I_WPU, I_WNU, I_WOUT, I_F2N, I_F2G, I_F2U, I_F2D, I_FINN };
constexpr int N_PHASES = 14;

template <class Epi> __device__ __forceinline__ void run_gemm(LAS unsigned char* lds, const bf16* A, int lda, const bf16* Bt, int ldb, int Mr, int N, int K, int G, int c, const Epi& E, int apn = 0, int bdiv = 1 << 30, int bbytes = 0) {
    pg8::Gemm g{A, Bt, Mr, N, K, lda, ldb, apn, bdiv, bbytes}; pg8::StaticOrder S; S.init(Mr, N, G, c);
    pg8::gemm_phase<Epi, pg8::StaticOrder, true, true>(lds, g, S, E);
    __syncthreads();
}

__global__ void __launch_bounds__(NWAVES * 64, 2) mk_fwd(Args a) {
    extern __shared__ __attribute__((aligned(16))) unsigned char lds_raw[];
    LAS unsigned char* lds = (LAS unsigned char*)lds_raw;
    const int tid = threadIdx.x, lane = tid & 63, wave = __builtin_amdgcn_readfirstlane(tid >> 6);
    const int G = gridDim.x, bx = blockIdx.x;
    const int vcu = (G % 8 == 0) ? (bx % 8) * (G / 8) + bx / 8 : bx;
    const int gw = vcu * NWAVES + wave, NGW = G * NWAVES;
    unsigned char* ws = a.ws;
    bf16* Win_t = (bf16*)(ws + WS_WIN); bf16* Wpu_t = (bf16*)(ws + WS_WPU); bf16* Wnu_t = (bf16*)(ws + WS_WNU); bf16* Wout_t = (bf16*)(ws + WS_WOUT);
    bf16* Poolw_t = (bf16*)(ws + WS_POOLW); bf16* Cw1_t = (bf16*)(ws + WS_CW1); bf16* Cw2_t = (bf16*)(ws + WS_CW2);
    float* PEBP = (float*)(ws + WS_PEBP); float* PEB = (float*)(ws + WS_PEB);
    bf16* HIDC = (bf16*)(ws + WS_HIDC); bf16* KVCMP = (bf16*)(ws + WS_KVCMP);
    bf16* Wgu_t = (bf16*)(ws + WS_WGU); bf16* Wd_t = (bf16*)(ws + WS_WD); bf16* GNSA = (bf16*)(ws + WS_GNSA);
    bf16* XN = (bf16*)(ws + WS_XN); bf16* POOLED = (bf16*)(ws + WS_POOLED); bf16* APOOL = (bf16*)(ws + WS_APOOL);
    bf16* HID = (bf16*)(ws + WS_HID); bf16* XP = (bf16*)(ws + WS_XP); bf16* Q = (bf16*)(ws + WS_Q); bf16* KV4 = (bf16*)(ws + WS_KV4); bf16* KCVC = (bf16*)(ws + WS_KCVC); bf16* NSAG = (bf16*)(ws + WS_NSAG);
    bf16* GPOOL = (bf16*)(ws + WS_GPOOL);
    float* H = a.out;
    const int lo = a.ph_lo, hi = a.ph_hi;
#ifndef MK_PHASE_MASK
#define MK_PHASE_MASK 0x3fff
#endif
#define IN(k) (((MK_PHASE_MASK >> (k)) & 1) && lo <= (k) && (k) < hi)
#define SEAM(k) do { if (IN(k) && IN((k) + 1)) { __syncthreads(); cg::this_grid().sync(); } } while (0)
    LAS float* scr = (LAS float*)(lds + wave * 16384);

    if (IN(0)) {
        int base = 0;
        transpose_seg(a.in[I_F1G], DM, FF, 0, FF, Wgu_t, 0, true, scr, lane, gw, NGW, base);
        transpose_seg(a.in[I_F1U], DM, FF, 0, FF, Wgu_t, 128, true, scr, lane, gw, NGW, base);
        transpose_seg(a.in[I_F1D], FF, DM, 0, DM, Wd_t, 0, false, scr, lane, gw, NGW, base);
        transpose_seg(a.in[I_WIN], DM, INW_SRC, 0, 6144, Win_t, 0, false, scr, lane, gw, NGW, base);
        transpose_seg(a.in[I_WIN], DM, INW_SRC, 6192, 2048, Win_t, 6144, false, scr, lane, gw, NGW, base);
        transpose_seg(a.in[I_WIN], DM, INW_SRC, 8240, 2048, Win_t, 8192, false, scr, lane, gw, NGW, base);
        transpose_seg(a.in[I_WIN], DM, INW_SRC, 6144, 48, Win_t, 10240, false, scr, lane, gw, NGW, base);
        transpose_seg(a.in[I_WPU], PW, DM, 0, DM, Wpu_t, 0, false, scr, lane, gw, NGW, base);
        transpose_seg(a.in[I_WNU], DM, DM, 0, DM, Wnu_t, 0, false, scr, lane, gw, NGW, base);
        transpose_seg(a.in[I_WOUT], DM, DM, 0, DM, Wout_t, 0, false, scr, lane, gw, NGW, base);
        for (int gi = 0; gi < 4; ++gi) transpose_seg(a.in[I_POOLW] + (size_t)gi * 65536, 256, 256, 0, 256, Poolw_t + (size_t)gi * 65536, 0, false, scr, lane, gw, NGW, base);
        transpose_seg(a.in[I_CKW1], 4096, 256, 0, 256, Cw1_t, 0, false, scr, lane, gw, NGW, base);
        transpose_seg(a.in[I_CVW1], 4096, 256, 0, 256, Cw1_t + (size_t)256 * 4096, 0, false, scr, lane, gw, NGW, base);
        transpose_seg(a.in[I_CKW2], 256, 128, 0, 128, Cw2_t, 0, false, scr, lane, gw, NGW, base);
        transpose_seg(a.in[I_CVW2], 256, 128, 0, 128, Cw2_t + 65536, 0, false, scr, lane, gw, NGW, base);
        for (int m = gw; m < M; m += NGW) rms_row_bf16(a.in[I_X] + (size_t)m * DM, a.in[I_F1N], XN + (size_t)m * DM, lane);
        for (int task = gw; task < 256; task += NGW) {
            const int tensor = task >> 7, chunk = (task >> 2) & 31, col = (task & 3) * 64 + lane;
            const float* pe = a.in[tensor ? I_PEV : I_PEK] + chunk * 128; const float* w1 = a.in[tensor ? I_CVW1 : I_CKW1] + (size_t)chunk * 128 * 256 + col;
            float acc = 0.f;
#pragma unroll 8
            for (int k = 0; k < 128; ++k) acc += pe[k] * w1[(size_t)k * 256];
            PEBP[(tensor * 32 + chunk) * 256 + col] = acc;
        }
    }
    SEAM(0);
    if (IN(1)) { pg8::EpiSwiglu E{HID, FF}; run_gemm(lds, XN, DM, Wgu_t, DM, M, 2 * FF, DM, G, bx, E); }
    SEAM(1);
    if (IN(2)) { pg8::EpiResF32 E{a.in[I_X], H, DM, 0.5f}; run_gemm(lds, HID, FF, Wd_t, FF, M, DM, FF, G, bx, E); }
    SEAM(2);
    if (IN(3)) {
        for (int m = gw; m < M; m += NGW) rms_row_bf16(H + (size_t)m * DM, a.in[I_MIXN], XN + (size_t)m * DM, lane);
        if (bx == 0) { float s = 0.f; for (int c = 0; c < 32; ++c) s += PEBP[((tid >> 8) * 32 + c) * 256 + (tid & 255)]; PEB[tid] = s; }
    }
    SEAM(3);
    if (IN(4)) { pg8::EpiP8<FWin> E{FWin{XP, Q, KCVC, KV4, GPOOL, GNSA, NSAG}}; run_gemm(lds, XN, DM, Win_t, DM, M, INW, DM, G, bx, E); }
    SEAM(4);
    if (IN(5)) {
        { pg8::EpiP8<FSiluBias> E{FSiluBias{HIDC, PEB}}; run_gemm(lds, KCVC, 2048, Cw1_t, 4096, 8192, 256, 4096, G, bx, E, 0, 16, 256 * 4096 * 2); }
        const int nthr = G * NWAVES * 64;
        for (int idx = vcu * 512 + tid; idx < M * 128; idx += nthr) {
            const int row = idx >> 7, c8 = (idx & 127) * 8, win = 2 << (c8 >> 8), t = row & (SEQ - 1), n = (t + 1) < win ? (t + 1) : win;
            float acc[8] = {0.f, 0.f, 0.f, 0.f, 0.f, 0.f, 0.f, 0.f}, x0[8];
            for (int j = 0; j < n; ++j) { const v4u w = *(const v4u*)(XP + (size_t)(row - j) * PW + c8);
                const float f[8] = {pg8::bf_lo(w.x), pg8::bf_hi(w.x), pg8::bf_lo(w.y), pg8::bf_hi(w.y), pg8::bf_lo(w.z), pg8::bf_hi(w.z), pg8::bf_lo(w.w), pg8::bf_hi(w.w)};
#pragma unroll
                for (int e = 0; e < 8; ++e) { acc[e] += f[e]; if (j == 0) x0[e] = f[e]; } }
            const float inv = 1.f / (float)n;
            v4u o; o.x = pk2(acc[0] * inv - x0[0], acc[1] * inv - x0[1]); o.y = pk2(acc[2] * inv - x0[2], acc[3] * inv - x0[3]);
            o.z = pk2(acc[4] * inv - x0[4], acc[5] * inv - x0[5]); o.w = pk2(acc[6] * inv - x0[6], acc[7] * inv - x0[7]);
            *(v4u*)(POOLED + (size_t)row * PW + c8) = o;
        }
    }
    SEAM(5);
    if (IN(6)) {
        { pg8::EpiP8<FPool> E{FPool{APOOL, a.in[I_POOLS]}}; run_gemm(lds, POOLED, PW, Poolw_t, 256, M, PW, 256, G, bx, E, 256 * 2); }
        { pg8::EpiP8<FStore128> E{FStore128{KVCMP}}; run_gemm(lds, HIDC, 256, Cw2_t, 256, 8192, 256, 256, G, bx, E, 0, 16, 65536 * 2); }
    }
    SEAM(6);
    if (IN(7)) {
        { pg8::EpiP8<FGate> E{FGate{GPOOL, GPOOL, false}}; run_gemm(lds, APOOL, PW, Wpu_t, PW, M, DM, PW, G, bx, E); }
        for (int it = vcu; it < 1024; it += G) {
            const int c = it & 255, k = it >> 8, bg = c >> 5, i = c & 31;
            const int qb = (k == 0) ? i : (k == 1) ? 63 - i : (k == 2) ? 64 + i : 127 - i;
            nsa::nsa_unit(bg >> 2, bg & 3, qb, Q, KV4, KVCMP, KVCMP + (size_t)4096 * 128, NSAG, Q, (char*)lds_raw);
        }
    }
    SEAM(7);
    if (IN(8)) { pg8::EpiP8<FGate> E{FGate{GPOOL, GNSA, true}}; run_gemm(lds, Q, DM, Wnu_t, DM, M, DM, DM, G, bx, E); }
    SEAM(8);
    if (IN(9)) { pg8::EpiResF32 E{H, H, DM, 1.0f}; run_gemm(lds, GPOOL, DM, Wout_t, DM, M, DM, DM, G, bx, E); }
    SEAM(9);
    if (IN(10)) {
        int base = 0;
        transpose_seg(a.in[I_F2G], DM, FF, 0, FF, Wgu_t, 0, true, scr, lane, gw, NGW, base);
        transpose_seg(a.in[I_F2U], DM, FF, 0, FF, Wgu_t, 128, true, scr, lane, gw, NGW, base);
        transpose_seg(a.in[I_F2D], FF, DM, 0, DM, Wd_t, 0, false, scr, lane, gw, NGW, base);
        for (int m = gw; m < M; m += NGW) rms_row_bf16(H + (size_t)m * DM, a.in[I_F2N], XN + (size_t)m * DM, lane);
    }
    SEAM(10);
    if (IN(11)) { pg8::EpiSwiglu E{HID, FF}; run_gemm(lds, XN, DM, Wgu_t, DM, M, 2 * FF, DM, G, bx, E); }
    SEAM(11);
    if (IN(12)) { pg8::EpiResF32 E{H, H, DM, 0.5f}; run_gemm(lds, HID, FF, Wd_t, FF, M, DM, FF, G, bx, E); }
    SEAM(12);
    if (IN(13)) { for (int m = gw; m < M; m += NGW) rms_row_f32(H + (size_t)m * DM, a.in[I_FINN], lane); }
#undef IN
#undef SEAM
}

#ifndef MK_ONE_LAUNCH
#define MK_ONE_LAUNCH 1
#endif
extern "C" void kernel_launch(void* const* d_in, const int* in_sizes, int n_in, void* d_out, int out_size, void* d_ws, size_t ws_size, hipStream_t stream) {
    static int grid = 0;
    if (grid == 0) {
        if (n_in != 23 || out_size != M * DM || ws_size < WS_END) { fprintf(stderr, "kernel_launch: unexpected shapes (n_in %d out %d ws %zu)\n", n_in, out_size, ws_size); grid = -1; return; }
        int dev = 0, cus = 0, per_cu = 0;
        (void)hipGetDevice(&dev); (void)hipDeviceGetAttribute(&cus, hipDeviceAttributeMultiprocessorCount, dev);
        if (hipFuncSetAttribute((const void*)mk_fwd, hipFuncAttributeMaxDynamicSharedMemorySize, LDS_BYTES) != hipSuccess) { fprintf(stderr, "kernel_launch: hipFuncSetAttribute failed\n"); grid = -1; return; }
        if (hipOccupancyMaxActiveBlocksPerMultiprocessor(&per_cu, (const void*)mk_fwd, NWAVES * 64, LDS_BYTES) != hipSuccess || per_cu < 1) { fprintf(stderr, "kernel_launch: occupancy query says %d\n", per_cu); per_cu = 1; }
        (void)hipGetLastError();
        grid = cus > 0 ? cus : 256;
    }
    if (grid < 0) return;
    Args a{};
    for (int i = 0; i < 23; ++i) a.in[i] = (const float*)d_in[i];
    a.out = (float*)d_out; a.ws = (unsigned char*)d_ws;
#if MK_ONE_LAUNCH
    a.ph_lo = 0; a.ph_hi = N_PHASES;
    void* args[] = {&a};
    hipError_t e = hipLaunchCooperativeKernel((const void*)mk_fwd, dim3(grid), dim3(NWAVES * 64), args, LDS_BYTES, stream);
    if (e != hipSuccess) fprintf(stderr, "kernel_launch: cooperative launch failed: %s (grid %d)\n", hipGetErrorString(e), grid);
#else
    for (int p = 0; p < N_PHASES; ++p) { a.ph_lo = p; a.ph_hi = p + 1; hipLaunchKernelGGL(mk_fwd, dim3(grid), dim3(NWAVES * 64), LDS_BYTES, stream, a); }
#endif
}
```

```cpp
#include <hip/hip_runtime.h>
#include <hip/hip_cooperative_groups.h>
#include <cstdio>
#include <cstdint>
namespace cg = cooperative_groups;
namespace pg8 {
#define PG8_LAS __attribute__((address_space(3)))
typedef unsigned short bf16_t;
typedef short bf16x8 __attribute__((ext_vector_type(8)));
typedef float f32x4 __attribute__((ext_vector_type(4)));
typedef unsigned u32x4 __attribute__((ext_vector_type(4)));
constexpr int BM = 256, BK = 64, HALF = 128, HTB = HALF * BK * 2  , STAGE_BYTES = 8 * HTB, NXCD = 8, WGM = 8;

__host__ __device__ __forceinline__ int lds_byte(int r, int c) { const int st = (r >> 4) * 2 + (c >> 5), rr = r & 15, cc = c & 31, ob = rr * 64 + cc * 2; return st * 1024 + (ob ^ (((ob >> 9) & 1) << 5)); }
__host__ __device__ __forceinline__ void stage_rc(int b, int& R, int& C) { const int st = b / 1024, sb = b % 1024, swz = sb ^ (((sb >> 9) & 1) << 5); R = (st >> 1) * 16 + swz / 64; C = (st & 1) * 32 + (swz % 64) / 2; }
__host__ __device__ __forceinline__ int perm32(int rho) { const int n = rho >> 4, i = rho & 15; return 8 * (i >> 2) + 4 * n + (i & 3); }

struct Unit { int pm, pn; };
struct Gemm { const bf16_t* A; const bf16_t* Bt; int M, N, K, lda, ldb; int apn  , bdiv, bbytes  ; };

struct StaticOrder {
    int nM, nN, nwg, G, c;
    __host__ __device__ void init(int M, int N, int G_, int c_) { nM = M / BM; nN = N / BM; nwg = nM * nN; G = G_; c = c_; }
    __host__ __device__ bool next(int i, Unit& u) const {
        const long L = (long)i * G + c; if (L >= nwg) return false;
        int wgid = (int)L; { const int q = nwg / NXCD, r = nwg % NXCD, xcd = wgid % NXCD, off = wgid / NXCD; wgid = (xcd < r ? xcd * (q + 1) : r * (q + 1) + (xcd - r) * q) + off; }
        const int nig = WGM * nN, gid = wgid / nig, fm = gid * WGM, gsz = (nM - fm) < WGM ? (nM - fm) : WGM;
        u.pm = fm + ((wgid % nig) % gsz); u.pn = (wgid % nig) / gsz; return true;
    }
    __device__ __forceinline__ void a_ready(const Unit&) const {}
    __device__ __forceinline__ void done(const Unit&) const {}
};

__device__ __forceinline__ unsigned cvt_pk_bf16(float lo, float hi) { unsigned r; asm volatile("v_cvt_pk_bf16_f32 %0, %1, %2" : "=v"(r) : "v"(lo), "v"(hi)); return r; }
__device__ __forceinline__ float bf_lo(unsigned w) { return __builtin_bit_cast(float, w << 16); }
__device__ __forceinline__ float bf_hi(unsigned w) { return __builtin_bit_cast(float, w & 0xffff0000u); }
__device__ __forceinline__ float sigmoidf_(float x) { return __builtin_amdgcn_rcpf(1.f + __builtin_amdgcn_exp2f(-1.4426950408889634f * x)); }
__device__ __forceinline__ float siluf_(float x) { return x * sigmoidf_(x); }
__device__ __forceinline__ u32x4 pack8(f32x4 a, f32x4 b) { u32x4 w; w.x = cvt_pk_bf16(a[0], a[1]); w.y = cvt_pk_bf16(a[2], a[3]); w.z = cvt_pk_bf16(b[0], b[1]); w.w = cvt_pk_bf16(b[2], b[3]); return w; }

template <class F> struct EpiP8 {
    static constexpr bool PERM = true, AFTER_DRAIN = false;
    F f;
    __device__ __forceinline__ void operator()(const f32x4 (&acc)[2][2][4][2], const Unit& u, int wr, int wc, int fr, int fq) const {
        const int row0 = u.pm * BM + wr * 64 + fr, col0 = u.pn * BM + wc * 32 + 8 * fq;
#pragma unroll
        for (int ai = 0; ai < 2; ++ai)
#pragma unroll
            for (int m = 0; m < 4; ++m) {
                const int row = row0 + ai * HALF + m * 16;
#pragma unroll
                for (int bj = 0; bj < 2; ++bj) f(row, col0 + bj * HALF, u.pn, acc[ai][bj][m][0], acc[ai][bj][m][1]);
            }
    }
};
struct EpiSwiglu {
    static constexpr bool PERM = true, AFTER_DRAIN = false;
    bf16_t* O; int ldc;
    __device__ __forceinline__ void operator()(const f32x4 (&acc)[2][2][4][2], const Unit& u, int wr, int wc, int fr, int fq) const {
        const int row0 = u.pm * BM + wr * 64 + fr, col0 = u.pn * HALF + wc * 32 + 8 * fq;
#pragma unroll
        for (int ai = 0; ai < 2; ++ai)
#pragma unroll
            for (int m = 0; m < 4; ++m) {
                const int row = row0 + ai * HALF + m * 16;
                f32x4 h0, h1;
#pragma unroll
                for (int j = 0; j < 4; ++j) { h0[j] = siluf_(acc[ai][0][m][0][j]) * acc[ai][1][m][0][j]; h1[j] = siluf_(acc[ai][0][m][1][j]) * acc[ai][1][m][1][j]; }
                *(u32x4*)(O + (size_t)row * ldc + col0) = pack8(h0, h1);
            }
    }
};
struct EpiResF32 {
    static constexpr bool PERM = false, AFTER_DRAIN = false;
    const float* base; float* out; int ldc; float coef;
    __device__ __forceinline__ void operator()(const f32x4 (&acc)[2][2][4][2], const Unit& u, int wr, int wc, int fr, int fq) const {
        const int row0 = u.pm * BM + wr * 64 + fr, col0 = u.pn * BM + wc * 32 + 4 * fq;
#pragma unroll
        for (int ai = 0; ai < 2; ++ai)
#pragma unroll
            for (int m = 0; m < 4; ++m) {
                const size_t off = (size_t)(row0 + ai * HALF + m * 16) * ldc + col0;
#pragma unroll
                for (int bj = 0; bj < 2; ++bj)
#pragma unroll
                    for (int n = 0; n < 2; ++n) { const f32x4 b = *(const f32x4*)(base + off + bj * HALF + n * 16); *(f32x4*)(out + off + bj * HALF + n * 16) = b + acc[ai][bj][m][n] * coef; }
            }
    }
};
template <class Epi, class Sched, bool ALIGN_EPI = false, bool SP2 = false>
__device__ __forceinline__ void gemm_phase(PG8_LAS unsigned char* lds, const Gemm g, const Sched& S, const Epi& E) {
    const int tid = threadIdx.x, wid = __builtin_amdgcn_readfirstlane(tid >> 6), lane = tid & 63, wr = wid >> 2, wc = wid & 3, fr = lane & 15, fq = lane >> 4;
    const int K = g.K, nt = K / BK;
    unsigned voffA[2], voffB[2];
#pragma unroll
    for (int i = 0; i < 2; ++i) { int R, C; stage_rc(tid * 16 + i * 8192, R, C); const int Rb = Epi::PERM ? ((R & ~31) + perm32(R & 31)) : R;
        voffA[i] = (unsigned)(R * g.lda + C) * 2u; voffB[i] = (unsigned)(Rb * g.ldb + C) * 2u; }
    const size_t kstep = (size_t)(BK * 2);
    const size_t hstepA = (size_t)HALF * g.lda * 2, hstepB = (size_t)HALF * g.ldb * 2;
    const size_t tstepA = 2 * hstepA, tstepB = 2 * hstepB;
    const unsigned ldsw = (unsigned)wid * 1024u;
    const int aoff = lds_byte(wr * 64 + fr, fq * 8), boff = lds_byte(wc * 32 + fr, fq * 8);
#define PG8_SA(b, h) (((b) * 2 + (h)) * HTB)
#define PG8_SB(b, h) ((4 + (b) * 2 + (h)) * HTB)
#define PG8_STAGE(bufoff, gbase, voff) do { _Pragma("unroll") for (int _i = 0; _i < 2; ++_i) \
        __builtin_amdgcn_global_load_lds((const unsigned*)((const char*)(gbase) + (voff)[_i]), (PG8_LAS unsigned*)(lds + (bufoff) + ldsw + _i * 8192), 16, 0, 0); } while (0)
#define PG8_LDA(dst, b, h) do { _Pragma("unroll") for (int m = 0; m < 4; ++m) _Pragma("unroll") for (int k = 0; k < 2; ++k) dst[m][k] = *(const PG8_LAS bf16x8*)(lds + PG8_SA(b, h) + aoff + m * 2048 + k * 1024); } while (0)
#define PG8_LDB(dst, b, h) do { _Pragma("unroll") for (int n = 0; n < 2; ++n) _Pragma("unroll") for (int k = 0; k < 2; ++k) dst[n][k] = *(const PG8_LAS bf16x8*)(lds + PG8_SB(b, h) + boff + n * 2048 + k * 1024); } while (0)
#define PG8_MMA(ai, bj, At, Bt) do { __builtin_amdgcn_s_setprio(1); _Pragma("unroll") for (int m = 0; m < 4; ++m) _Pragma("unroll") for (int n = 0; n < 2; ++n) _Pragma("unroll") for (int k = 0; k < 2; ++k) \
        acc[ai][bj][m][n] = __builtin_amdgcn_mfma_f32_16x16x32_bf16(Bt[n][k], At[m][k], acc[ai][bj][m][n], 0, 0, 0); __builtin_amdgcn_s_setprio(0); } while (0)
#define PG8_WAIT_V(n) asm volatile("s_waitcnt vmcnt(" #n ")" ::: "memory")
#define PG8_WAIT_L(n) asm volatile("s_waitcnt lgkmcnt(" #n ")" ::: "memory")
#define PG8_BAR __builtin_amdgcn_s_barrier()
#define PG8_SCHED __builtin_amdgcn_sched_barrier(0)
    Unit cur, nxt; int ui = 0;
    if (!S.next(0, cur)) return;
    f32x4 acc[2][2][4][2];
#pragma unroll
    for (int a = 0; a < 2; ++a)
#pragma unroll
        for (int b = 0; b < 2; ++b)
#pragma unroll
            for (int m = 0; m < 4; ++m)
#pragma unroll
                for (int n = 0; n < 2; ++n) acc[a][b][m][n] = (f32x4){0.f, 0.f, 0.f, 0.f};
    bf16x8 At[4][2], B0[2][2], B1[2][2];
    const char* cA = (const char*)g.A + (size_t)cur.pm * tstepA + (size_t)cur.pn * g.apn; const char* cB = (const char*)g.Bt + (size_t)cur.pn * tstepB + (size_t)(cur.pm / g.bdiv) * g.bbytes;
    S.a_ready(cur);
    if constexpr (SP2) {
        PG8_STAGE(PG8_SB(0, 0), cB, voffB); PG8_STAGE(PG8_SB(0, 1), cB + hstepB, voffB); PG8_STAGE(PG8_SA(0, 0), cA, voffA); PG8_STAGE(PG8_SA(0, 1), cA + hstepA, voffA);
        if (wr == 1) PG8_BAR;
        PG8_WAIT_V(2); PG8_BAR;
        PG8_STAGE(PG8_SB(1, 0), cB + kstep, voffB); PG8_STAGE(PG8_SA(1, 0), cA + kstep, voffA); PG8_STAGE(PG8_SB(1, 1), cB + hstepB + kstep, voffB);
        PG8_WAIT_V(6); PG8_BAR;
    } else {
        PG8_STAGE(PG8_SB(0, 0), cB, voffB); PG8_STAGE(PG8_SA(0, 0), cA, voffA); PG8_STAGE(PG8_SB(0, 1), cB + hstepB, voffB); PG8_STAGE(PG8_SA(0, 1), cA + hstepA, voffA);
        if (wr == 1) PG8_BAR;
        PG8_WAIT_V(4); PG8_BAR;
        PG8_STAGE(PG8_SB(1, 0), cB + kstep, voffB); PG8_STAGE(PG8_SA(1, 0), cA + kstep, voffA); PG8_STAGE(PG8_SB(1, 1), cB + hstepB + kstep, voffB);
        PG8_WAIT_V(6); PG8_BAR;
    }
    for (;;) {
        const bool has_next = S.next(ui + 1, nxt);
        const char* nA = has_next ? (const char*)g.A + (size_t)nxt.pm * tstepA + (size_t)nxt.pn * g.apn : cA; const char* nB = has_next ? (const char*)g.Bt + (size_t)nxt.pn * tstepB + (size_t)(nxt.pm / g.bdiv) * g.bbytes : cB;
#pragma nounroll
        for (int t = 0; t < nt; t += 2) {
            const bool last = (t == nt - 2);
            const char* a1 = cA + (size_t)(t + 1) * kstep;
            const char* a2 = last ? nA : cA + (size_t)(t + 2) * kstep; const char* b2 = last ? nB : cB + (size_t)(t + 2) * kstep;
            const char* a3 = a2 + kstep; const char* b3 = b2 + kstep;
            if (last && has_next) S.a_ready(nxt);
            if constexpr (SP2) {
            PG8_LDB(B0, 0, 0); PG8_LDB(B1, 0, 1); PG8_SCHED; PG8_LDA(At, 0, 0); PG8_STAGE(PG8_SA(1, 1), a1 + hstepA, voffA);
            PG8_WAIT_V(8); PG8_WAIT_L(0); PG8_BAR; PG8_MMA(0, 0, At, B0); PG8_MMA(0, 1, At, B1); PG8_BAR; PG8_SCHED;
            PG8_LDA(At, 0, 1); PG8_STAGE(PG8_SB(0, 0), b2, voffB); PG8_STAGE(PG8_SB(0, 1), b2 + hstepB, voffB); PG8_STAGE(PG8_SA(0, 0), a2, voffA);
            PG8_WAIT_V(8); PG8_WAIT_L(0); PG8_BAR; PG8_MMA(1, 0, At, B0); PG8_MMA(1, 1, At, B1); PG8_BAR; PG8_SCHED;
            PG8_LDB(B0, 1, 0); PG8_LDB(B1, 1, 1); PG8_SCHED; PG8_LDA(At, 1, 0); PG8_STAGE(PG8_SA(0, 1), a2 + hstepA, voffA);
            PG8_WAIT_V(8); PG8_WAIT_L(0); PG8_BAR; PG8_MMA(0, 0, At, B0); PG8_MMA(0, 1, At, B1); PG8_BAR; PG8_SCHED;
            PG8_LDA(At, 1, 1); PG8_STAGE(PG8_SB(1, 0), b3, voffB); PG8_STAGE(PG8_SB(1, 1), b3 + hstepB, voffB); PG8_STAGE(PG8_SA(1, 0), a3, voffA);
            PG8_WAIT_V(8); PG8_WAIT_L(0); PG8_BAR; PG8_MMA(1, 0, At, B0); PG8_MMA(1, 1, At, B1); PG8_BAR; PG8_SCHED;
            } else {
            PG8_LDB(B0, 0, 0); PG8_SCHED; PG8_LDA(At, 0, 0); PG8_STAGE(PG8_SA(1, 1), a1 + hstepA, voffA);
            PG8_WAIT_L(8); PG8_BAR; PG8_WAIT_L(0); PG8_MMA(0, 0, At, B0); PG8_BAR; PG8_SCHED;
            PG8_LDB(B1, 0, 1); PG8_STAGE(PG8_SB(0, 0), b2, voffB);
            PG8_BAR; PG8_WAIT_L(0); PG8_MMA(0, 1, At, B1); PG8_BAR;
            PG8_LDA(At, 0, 1); PG8_STAGE(PG8_SA(0, 0), a2, voffA);
            PG8_BAR; PG8_WAIT_L(0); PG8_MMA(1, 0, At, B0); PG8_BAR; PG8_SCHED;
            PG8_STAGE(PG8_SB(0, 1), b2 + hstepB, voffB);
            PG8_WAIT_V(6); PG8_BAR; PG8_MMA(1, 1, At, B1); PG8_BAR;
            PG8_LDB(B0, 1, 0); PG8_SCHED; PG8_LDA(At, 1, 0); PG8_STAGE(PG8_SA(0, 1), a2 + hstepA, voffA);
            PG8_WAIT_L(8); PG8_BAR; PG8_WAIT_L(0); PG8_MMA(0, 0, At, B0); PG8_BAR; PG8_SCHED;
            PG8_LDB(B1, 1, 1); PG8_STAGE(PG8_SB(1, 0), b3, voffB);
            PG8_BAR; PG8_WAIT_L(0); PG8_MMA(0, 1, At, B1); PG8_BAR;
            PG8_LDA(At, 1, 1); PG8_STAGE(PG8_SA(1, 0), a3, voffA);
            PG8_BAR; PG8_WAIT_L(0); PG8_MMA(1, 0, At, B0); PG8_BAR; PG8_SCHED;
            PG8_STAGE(PG8_SB(1, 1), b3 + hstepB, voffB);
            PG8_WAIT_V(6); PG8_BAR; PG8_MMA(1, 1, At, B1); PG8_BAR;
            }
        }
        if constexpr (ALIGN_EPI) { if (wr == 0) PG8_BAR; }
        if constexpr (!Epi::AFTER_DRAIN) { E(acc, cur, wr, wc, fr, fq); S.done(cur); }
        if (!has_next) break;
#pragma unroll
        for (int a = 0; a < 2; ++a)
#pragma unroll
            for (int b = 0; b < 2; ++b)
#pragma unroll
                for (int m = 0; m < 4; ++m)
#pragma unroll
                    for (int n = 0; n < 2; ++n) acc[a][b][m][n] = (f32x4){0.f, 0.f, 0.f, 0.f};
        cur = nxt; cA = nA; cB = nB; ++ui;
        if constexpr (ALIGN_EPI) { if (wr == 1) PG8_BAR; }
    }
    PG8_WAIT_V(0);
    if constexpr (!ALIGN_EPI) { if (wr == 0) PG8_BAR; }
    PG8_BAR;
    if constexpr (Epi::AFTER_DRAIN) { E.fused(acc, cur, wr, wc, fr, fq, lds, wid, lane); S.done(cur); }
#undef PG8_SA
#undef PG8_SB
#undef PG8_STAGE
#undef PG8_LDA
#undef PG8_LDB
#undef PG8_MMA
#undef PG8_WAIT_V
#undef PG8_WAIT_L
#undef PG8_BAR
#undef PG8_SCHED
}
}
namespace nsa {
typedef unsigned short bf16_t;
typedef short bf16x8 __attribute__((ext_vector_type(8)));
typedef short s16x4 __attribute__((ext_vector_type(4)));
typedef float f32x16 __attribute__((ext_vector_type(16)));
typedef float f32x4 __attribute__((ext_vector_type(4)));
typedef unsigned u32x4 __attribute__((ext_vector_type(4)));
constexpr int D = 128, KVBLK = 64, SHM_K = 16384, SHM_V = 16384, SEQ = 8192;
constexpr float SCALE = 0.08838834764831845f, C2 = 1.4426950408889634f * SCALE, THR = 8.f;
constexpr int L_V = 0, L_K = 16384, L_WS = 32768, L_SELM = 34816, L_IMP = 36864, L_END = L_IMP + 64 * 128 * 4;
#define KSWZ(row, colB) ((row) * 256 + ((colB) ^ (((row) & 7) << 4)))
#define SBAR() __builtin_amdgcn_sched_barrier(0)
__device__ __forceinline__ int v_st(int k, int c) { const int kk = (k & ~0xC) | ((k & 4) << 1) | ((k & 8) >> 1); return ((kk >> 3) * 4 + (c >> 5)) * 512 + ((kk & 7) * 32 + (c & 31)) * 2; }
__device__ __forceinline__ int v_rd_base(int lane) { return ((lane & 3) << 3) | (((lane >> 2) & 3) << 6) | (((lane >> 4) & 1) << 5) | (((lane >> 5) & 1) << 8); }
constexpr int v_rd_off(int d0, int ks, int half) { return d0 * 512 + ks * 4096 + half * 2048; }
__device__ __forceinline__ int crow(int r, int hi) { return (r & 3) + 8 * (r >> 2) + 4 * hi; }
__device__ __forceinline__ unsigned cvtpk(float lo, float hi) { unsigned r; asm volatile("v_cvt_pk_bf16_f32 %0, %1, %2" : "=v"(r) : "v"(lo), "v"(hi)); return r; }
__device__ __forceinline__ void mask_tile(f32x16& p0, f32x16& p1, int dq, unsigned W) {
    const float NEG = -__builtin_inff();
#pragma unroll
    for (int r = 0; r < 16; ++r) {
        const int c = (r & 3) + 8 * (r >> 2);
        if ((unsigned)(dq - c) >= W) p0[r] = NEG;
        if ((unsigned)(dq - c - 32) >= W) p1[r] = NEG;
    }
}
__device__ __forceinline__ float rowmax32(const f32x16& p0, const f32x16& p1) {
    float pmax = p0[0];
#pragma unroll
    for (int r = 1; r < 16; ++r) pmax = fmaxf(pmax, p0[r]);
#pragma unroll
    for (int r = 0; r < 16; ++r) pmax = fmaxf(pmax, p1[r]);
    auto rr = __builtin_amdgcn_permlane32_swap(__float_as_uint(pmax), __float_as_uint(pmax), false, false);
    return fmaxf(__uint_as_float(rr[0]), __uint_as_float(rr[1]));
}
__device__ __forceinline__ float rowsum32(const f32x16& p0, const f32x16& p1) {
    float ps = 0.f;
#pragma unroll
    for (int r = 0; r < 16; ++r) ps += p0[r];
#pragma unroll
    for (int r = 0; r < 16; ++r) ps += p1[r];
    auto rr = __builtin_amdgcn_permlane32_swap(__float_as_uint(ps), __float_as_uint(ps), false, false);
    return __uint_as_float(rr[0]) + __uint_as_float(rr[1]);
}
__device__ __forceinline__ void packP(const f32x16& p0, const f32x16& p1, bf16x8& pa0, bf16x8& pa1, bf16x8& pa2, bf16x8& pa3) {
#define PK4(P, B_, OUT) do { unsigned a0 = cvtpk(P[B_+0], P[B_+1]), a1 = cvtpk(P[B_+2], P[B_+3]);                          \
        unsigned b0 = cvtpk(P[B_+4], P[B_+5]), b1 = cvtpk(P[B_+6], P[B_+7]);                                             \
        auto r0 = __builtin_amdgcn_permlane32_swap(a0, b0, false, false); auto r1 = __builtin_amdgcn_permlane32_swap(a1, b1, false, false); \
        u32x4 w = {r0[0], r1[0], r0[1], r1[1]}; OUT = *reinterpret_cast<bf16x8*>(&w); } while (0)
    PK4(p0, 0, pa0); PK4(p0, 8, pa1); PK4(p1, 0, pa2); PK4(p1, 8, pa3);
#undef PK4
}
__device__ __forceinline__ void qkt(f32x16& p0, f32x16& p1, const char* K_lds, int r32, int hi, const bf16x8* qr) {
    p0 = f32x16{}; p1 = f32x16{};
    const char* kb[4];
#pragma unroll
    for (int dd = 0; dd < 4; ++dd) kb[dd] = K_lds + KSWZ(r32, (dd * 16 + hi * 8) * 2);
#pragma unroll
    for (int d0 = 0; d0 < 8; ++d0) { const char* a = kb[d0 & 3] + (d0 >> 2) * 128;
        bf16x8 b0 = *reinterpret_cast<const bf16x8*>(a);
        bf16x8 b1 = *reinterpret_cast<const bf16x8*>(a + 32 * 256);
        p0 = __builtin_amdgcn_mfma_f32_32x32x16_bf16(b0, qr[d0], p0, 0, 0, 0);
        p1 = __builtin_amdgcn_mfma_f32_32x32x16_bf16(b1, qr[d0], p1, 0, 0, 0); }
}
__device__ __forceinline__ void pv_tile(f32x16* o, int vb0, bf16x8 pa0, bf16x8 pa1, bf16x8 pa2, bf16x8 pa3) {
#define TRRD(dst, off) asm volatile("ds_read_b64_tr_b16 %0, %1 offset:%2" : "=&v"(dst) : "v"(vb0), "i"(off) : "memory")
#define PV_D0(d0) do { s16x4 l0, l1, l2, l3, h0, h1, h2, h3; constexpr int b_ = v_rd_off(d0, 0, 0); \
        TRRD(l0, b_); TRRD(h0, b_ + 2048); TRRD(l1, b_ + 4096); TRRD(h1, b_ + 6144); TRRD(l2, b_ + 8192); TRRD(h2, b_ + 10240); TRRD(l3, b_ + 12288); TRRD(h3, b_ + 14336); \
        asm volatile("s_waitcnt lgkmcnt(0)" ::: "memory"); SBAR();   \
        o[d0] = __builtin_amdgcn_mfma_f32_32x32x16_bf16(pa0, (bf16x8){l0[0], l0[1], l0[2], l0[3], h0[0], h0[1], h0[2], h0[3]}, o[d0], 0, 0, 0);   \
        o[d0] = __builtin_amdgcn_mfma_f32_32x32x16_bf16(pa1, (bf16x8){l1[0], l1[1], l1[2], l1[3], h1[0], h1[1], h1[2], h1[3]}, o[d0], 0, 0, 0);   \
        o[d0] = __builtin_amdgcn_mfma_f32_32x32x16_bf16(pa2, (bf16x8){l2[0], l2[1], l2[2], l2[3], h2[0], h2[1], h2[2], h2[3]}, o[d0], 0, 0, 0);   \
        o[d0] = __builtin_amdgcn_mfma_f32_32x32x16_bf16(pa3, (bf16x8){l3[0], l3[1], l3[2], l3[3], h3[0], h3[1], h3[2], h3[3]}, o[d0], 0, 0, 0); } while (0)
    PV_D0(0); PV_D0(1); PV_D0(2); PV_D0(3);
#undef PV_D0
#undef TRRD
}

template <bool STATS, int KIND>
__device__ __forceinline__ void attend(const bf16_t* __restrict__ Kg, const bf16_t* __restrict__ Vg, int j_lo, int j_hi, int pos, unsigned W,
                                       char* lds, const bf16x8* qr, float& m_reg, float& l_reg, f32x16* o, float f_imp, float f_o, int qb) {
    const int tid = threadIdx.x, wid = __builtin_amdgcn_readfirstlane(tid >> 6), lane = tid & 63, r32 = lane & 31, hi = lane >> 5;
    char* V_lds = lds + L_V; char* K_lds = lds + L_K;
    const int sr = tid >> 4, sc = (tid & 15) * 8, vst0 = v_st(sr, sc), vst1 = v_st(32 + sr, sc), kws = KSWZ(sr, sc * 2);
    const int vb0 = (int)(uintptr_t)V_lds + v_rd_base(lane);
    const int qloc = wid * 8 + (r32 >> 2);
    bf16x8 sk0, sk1, sv0, sv1;
#define NSA_GLOAD(j) do { const bf16_t* kp_ = Kg + (size_t)((j) * KVBLK + sr) * D + sc; sk0 = *(const bf16x8*)kp_; sk1 = *(const bf16x8*)(kp_ + 32 * D); \
        if (!STATS) { const bf16_t* vp_ = Vg + (size_t)((j) * KVBLK + sr) * D + sc; sv0 = *(const bf16x8*)vp_; sv1 = *(const bf16x8*)(vp_ + 32 * D); } } while (0)
    if (j_lo < j_hi) NSA_GLOAD(j_lo);
    for (int j = j_lo; j < j_hi; ++j) {
        __syncthreads();
        *(bf16x8*)(K_lds + kws) = sk0; *(bf16x8*)(K_lds + kws + 32 * 256) = sk1;
        if (!STATS) { *(bf16x8*)(V_lds + vst0) = sv0; *(bf16x8*)(V_lds + vst1) = sv1; }
        __syncthreads();
        if (j + 1 < j_hi) NSA_GLOAD(j + 1);
        const int kb = j * KVBLK;
        bool rowsel = true, act = true;
        if (KIND == 2) { const unsigned wsel = ((const unsigned*)(lds + L_SELM))[qloc * 4 + (j >> 5)]; rowsel = ((wsel >> (j & 31)) & 1u) != 0u; act = __any(rowsel); }
        if (act) {
            f32x16 p0, p1;
            qkt(p0, p1, K_lds, r32, hi, qr);
            if (KIND == 2) {
                if (j == qb) mask_tile(p0, p1, pos - kb - 4 * hi, W);
                if (!rowsel) { const float NEG = -__builtin_inff();
#pragma unroll
                    for (int r = 0; r < 16; ++r) { p0[r] = NEG; p1[r] = NEG; } }
            } else mask_tile(p0, p1, pos - kb - 4 * hi, W);
            if (STATS) {
                const float pmax = rowmax32(p0, p1), mn = fmaxf(m_reg, pmax), alpha = __builtin_amdgcn_exp2f((m_reg - mn) * C2), mnL = -mn * C2;
#pragma unroll
                for (int r = 0; r < 16; ++r) { p0[r] = __builtin_amdgcn_exp2f(fmaf(p0[r], C2, mnL)); p1[r] = __builtin_amdgcn_exp2f(fmaf(p1[r], C2, mnL)); }
                l_reg = l_reg * alpha + rowsum32(p0, p1); m_reg = mn;
            } else {
                const float mnL = -m_reg * C2;
#pragma unroll
                for (int r = 0; r < 16; ++r) { p0[r] = __builtin_amdgcn_exp2f(fmaf(p0[r], C2, mnL)); p1[r] = __builtin_amdgcn_exp2f(fmaf(p1[r], C2, mnL)); }
                if (KIND == 1) {
                    float* imp = (float*)(lds + L_IMP) + qloc * 128 + (kb >> 2);
#pragma unroll
                    for (int half = 0; half < 2; ++half)
#pragma unroll
                        for (int i = 0; i < 4; ++i) {
                            const f32x16& P = half ? p1 : p0;
                            float G = ((P[4 * i] + P[4 * i + 1]) + (P[4 * i + 2] + P[4 * i + 3])) * f_imp, L = P[4 * i + 3] * f_imp;
                            G += __shfl_xor(G, 1); G += __shfl_xor(G, 2); L += __shfl_xor(L, 1); L += __shfl_xor(L, 2);
                            const int jl = half * 8 + 2 * i + hi;
                            if ((r32 & 3) == 0) { atomicAdd(imp + jl, G); if ((kb >> 2) + jl + 1 < 128) atomicAdd(imp + jl + 1, L); }
                        }
                }
#pragma unroll
                for (int r = 0; r < 16; ++r) { p0[r] *= f_o; p1[r] *= f_o; }
                bf16x8 pa0, pa1, pa2, pa3;
                packP(p0, p1, pa0, pa1, pa2, pa3);
                pv_tile(o, vb0, pa0, pa1, pa2, pa3);
            }
        }
    }
#undef NSA_GLOAD
}

__device__ __forceinline__ float bf2f(bf16_t v) { return __builtin_bit_cast(float, (unsigned)v << 16); }
__device__ __forceinline__ float sigm(float x) { return __builtin_amdgcn_rcpf(1.f + __builtin_amdgcn_exp2f(-1.4426950408889634f * x)); }

__device__ __forceinline__ void nsa_unit(int b, int g, int qb, const bf16_t* Q, const bf16_t* KV4, const bf16_t* KCMP, const bf16_t* VCMP, const bf16_t* NSAG, bf16_t* OUT, char* lds, bool do_store) {
    const int tid = threadIdx.x, wid = __builtin_amdgcn_readfirstlane(tid >> 6), lane = tid & 63, r32 = lane & 31, hi = lane >> 5;
    const int ql = wid * 8 + (r32 >> 2), h = r32 & 3, t = qb * 64 + ql;
    const size_t row = (size_t)b * SEQ + t;
    bf16x8 qr[8];
    { const bf16_t* qp = Q + row * 2048 + g * 512 + h * 128 + hi * 8;
#pragma unroll
      for (int d0 = 0; d0 < 8; ++d0) qr[d0] = *(const bf16x8*)(qp + d0 * 16); }
    { f32x4* z = (f32x4*)((float*)(lds + L_IMP) + wid * 8 * 128) + lane;
#pragma unroll
      for (int i = 0; i < 4; ++i) z[64 * i] = (f32x4){0.f, 0.f, 0.f, 0.f}; }
    const float gc = sigm(bf2f(NSAG[row * 256 + 0 * 16 + g * 4 + h])), gs = sigm(bf2f(NSAG[row * 256 + 1 * 16 + g * 4 + h])), gw = sigm(bf2f(NSAG[row * 256 + 2 * 16 + g * 4 + h]));
    const int bg = b * 4 + g;
    const size_t TSTR = (size_t)8 * SEQ * D;
    f32x16 comb[4];
#pragma unroll
    for (int d_ = 0; d_ < 4; ++d_) comb[d_] = f32x16{};
    {
        const bf16_t* kc = KCMP + (size_t)bg * 512 * D; const bf16_t* vc = VCMP + (size_t)bg * 512 * D;
        const int nmax = (t - 31) >> 4, jh = (4 * qb + 3 + 63) >> 6;
        float m1 = -1e30f, l1 = 0.f;
        attend<true, 1>(kc, vc, 0, jh, nmax, 0x7fffffffu, lds, qr, m1, l1, comb, 0.f, 0.f, qb);
        const float inv_l = l1 > 0.f ? 1.f / l1 : 0.f;
        attend<false, 1>(kc, vc, 0, jh, nmax, 0x7fffffffu, lds, qr, m1, l1, comb, inv_l, gc * inv_l, qb);
    }
    {
        asm volatile("s_waitcnt lgkmcnt(0)" ::: "memory");
        unsigned* SELM = (unsigned*)(lds + L_SELM);
        const unsigned* IMPu = (const unsigned*)(lds + L_IMP);
        if (qb >= 16) {
            for (int i = 0; i < 8; ++i) {
                const int q = wid * 8 + i;
                const unsigned vlo = IMPu[q * 128 + lane], vhi = IMPu[q * 128 + 64 + lane];
                const bool clo = (lane >= 1) && (lane <= qb - 2), chi = (64 + lane <= qb - 2);
                unsigned T = 0u;
                for (int bit = 30; bit >= 0; --bit) { const unsigned c = T | (1u << bit);
                    const int cnt = __popcll(__ballot(clo && vlo >= c)) + __popcll(__ballot(chi && vhi >= c));
                    if (cnt >= 13) T = c; }
                unsigned long long sel_lo = __ballot(clo && vlo > T), sel_hi = __ballot(chi && vhi > T);
                unsigned long long eq_lo = __ballot(clo && vlo == T), eq_hi = __ballot(chi && vhi == T);
                int need = 13 - __popcll(sel_lo) - __popcll(sel_hi);
                for (; need > 0; --need) {
                    if (eq_lo) { const unsigned long long lb = eq_lo & (0ull - eq_lo); sel_lo |= lb; eq_lo ^= lb; }
                    else if (eq_hi) { const unsigned long long lb = eq_hi & (0ull - eq_hi); sel_hi |= lb; eq_hi ^= lb; }
                }
                sel_lo |= 1ull;
                if (qb - 1 < 64) sel_lo |= 1ull << (qb - 1); else sel_hi |= 1ull << (qb - 1 - 64);
                if (qb < 64) sel_lo |= 1ull << qb; else sel_hi |= 1ull << (qb - 64);
                if (lane == 0) { SELM[q * 4 + 0] = (unsigned)sel_lo; SELM[q * 4 + 1] = (unsigned)(sel_lo >> 32); SELM[q * 4 + 2] = (unsigned)sel_hi; SELM[q * 4 + 3] = (unsigned)(sel_hi >> 32); }
            }
        } else {
            if (lane < 8) { const int q = wid * 8 + lane; SELM[q * 4 + 0] = (2u << qb) - 1u; SELM[q * 4 + 1] = 0u; SELM[q * 4 + 2] = 0u; SELM[q * 4 + 3] = 0u; }
        }
        asm volatile("s_waitcnt lgkmcnt(0)" ::: "memory");
    }
    {
        const bf16_t* ks = KV4 + 0 * TSTR + (size_t)bg * SEQ * D; const bf16_t* vs = KV4 + 1 * TSTR + (size_t)bg * SEQ * D;
        float m = -1e30f, l = 0.f;
        attend<true, 2>(ks, vs, 0, qb + 1, t, 0x7fffffffu, lds, qr, m, l, comb, 0.f, 0.f, qb);
        attend<false, 2>(ks, vs, 0, qb + 1, t, 0x7fffffffu, lds, qr, m, l, comb, 0.f, l > 0.f ? gs / l : 0.f, qb);
    }
    {
        const bf16_t* kw = KV4 + 2 * TSTR + (size_t)bg * SEQ * D; const bf16_t* vw = KV4 + 3 * TSTR + (size_t)bg * SEQ * D;
        const int jl = qb >= 8 ? qb - 8 : 0;
        float m = -1e30f, l = 0.f;
        attend<true, 0>(kw, vw, jl, qb + 1, t, 512u, lds, qr, m, l, comb, 0.f, 0.f, qb);
        attend<false, 0>(kw, vw, jl, qb + 1, t, 512u, lds, qr, m, l, comb, 0.f, l > 0.f ? gw / l : 0.f, qb);
    }
#pragma unroll
    for (int r = 0; r < 16; ++r) { const int wrow = crow(r, hi), oq = wid * 8 + (wrow >> 2), oh = wrow & 3;
        bf16_t* op = OUT + ((size_t)b * SEQ + qb * 64 + oq) * 2048 + g * 512 + oh * 128;
#pragma unroll
        for (int d0 = 0; d0 < 4; ++d0) { const float v = comb[d0][r], vn = __shfl_xor(v, 1);
            if (do_store && (r32 & 1) == 0) *(unsigned*)(op + d0 * 32 + r32) = cvtpk(v, vn); } }
    __syncthreads();
}
#undef KSWZ
#undef SBAR
}
constexpr int NWAVES = 8;
constexpr int SEQ = 8192, M = 2 * SEQ, DM = 2048, FF = 5632, INW_SRC = 10288, INW = 10496, PW = 1024;
constexpr float RMS_EPS = 1e-6f;
constexpr size_t MiB = 1u << 20;
constexpr size_t WS_WIN = 0, WS_WPU = 42 * MiB, WS_WNU = 46 * MiB, WS_WOUT = 54 * MiB, WS_POOLW = 62 * MiB, WS_CW1 = 63 * MiB, WS_CW2 = 67 * MiB;
constexpr size_t WS_PEBP = 68 * MiB, WS_PEB = 68 * MiB + 512 * 1024, WS_HIDC = 69 * MiB, WS_KVCMP = 73 * MiB;
constexpr size_t WS_WGU = 76 * MiB, WS_WD = 120 * MiB, WS_GNSA = 76 * MiB;
constexpr size_t WS_XN = 142 * MiB, WS_POOLED = 142 * MiB, WS_APOOL = 174 * MiB;
constexpr size_t WS_HID = 206 * MiB, WS_XP = 206 * MiB, WS_Q = 238 * MiB, WS_NSAG = 302 * MiB, WS_KV4 = 310 * MiB;
constexpr size_t WS_GPOOL = 382 * MiB, WS_KCVC = 446 * MiB, WS_END = 480 * MiB;
static_assert(WS_WIN + (size_t)INW * DM * 2 <= WS_WPU && WS_WGU + (size_t)2 * FF * DM * 2 <= WS_WD && WS_WD + (size_t)DM * FF * 2 <= WS_XN && WS_GNSA + (size_t)M * DM * 2 <= WS_XN, "ws map 1");
static_assert(WS_HID + (size_t)M * FF * 2 <= WS_GPOOL && WS_KV4 + (size_t)4 * M * 512 * 2 <= WS_GPOOL && WS_NSAG + (size_t)M * 256 * 2 <= WS_KV4 && WS_KCVC + (size_t)2 * M * 512 * 2 + 8192 <= WS_END, "ws map 2");
constexpr int LDS_BYTES = 147456;
#define GAS __attribute__((address_space(1)))
#define LAS __attribute__((address_space(3)))
typedef unsigned short bf16;
typedef unsigned v4u __attribute__((ext_vector_type(4)));
typedef float f32x4 __attribute__((ext_vector_type(4)));
#define LDS_WAIT() asm volatile("s_waitcnt lgkmcnt(0)" ::: "memory")
__device__ __forceinline__ unsigned f2bf(float f) { unsigned u = __builtin_bit_cast(unsigned, f); return (u + 0x7fffu + ((u >> 16) & 1u)) >> 16; }
__device__ __forceinline__ unsigned pk2(float lo, float hi) { return f2bf(lo) | (f2bf(hi) << 16); }
__device__ __forceinline__ float wave_sum(float v) {
#pragma unroll
    for (int o = 1; o < 64; o <<= 1) v += __shfl_xor(v, o);
    return v;
}
__device__ __forceinline__ void transpose_item(const float* W, int K, int N, int c0, int nvalid, bf16* WT, int drow, int k0, LAS float* scr, int lane) {
    const bool cv = (lane & 31) < nvalid;
#pragma unroll
    for (int i = 0; i < 32; ++i) { const int kk = 2 * i + (lane >> 5); scr[kk * 33 + (lane & 31)] = cv ? W[(size_t)(k0 + kk) * N + c0 + (lane & 31)] : 0.f; }
    LDS_WAIT(); asm volatile("" ::: "memory");
    const int c = lane & 7;
#pragma unroll
    for (int j = 0; j < 4; ++j) { const int n = (lane >> 3) + 8 * j; const LAS float* s = scr + (8 * c) * 33 + n;
        v4u o; o.x = pk2(s[0 * 33], s[1 * 33]); o.y = pk2(s[2 * 33], s[3 * 33]); o.z = pk2(s[4 * 33], s[5 * 33]); o.w = pk2(s[6 * 33], s[7 * 33]);
        if (n < nvalid) *(v4u*)(WT + (size_t)(drow + n) * K + k0 + 8 * c) = o; }
    LDS_WAIT(); asm volatile("" ::: "memory");
}
__device__ __forceinline__ void transpose_seg(const float* W, int K, int N, int src0, int ncols, bf16* WT, int drow0, bool gu, LAS float* scr, int lane, int gw, int NGW, int& base) {
    const int nblk = (ncols + 31) >> 5, nitems = (K >> 6) * nblk;
    int first = (gw - base) % NGW; if (first < 0) first += NGW;
    for (int it = first; it < nitems; it += NGW) {
        const int kb = it / nblk, nb = it - kb * nblk, c0 = nb * 32, nv = (ncols - c0) < 32 ? (ncols - c0) : 32;
        const int drow = gu ? (256 * (c0 >> 7) + (c0 & 127) + drow0) : (drow0 + c0);
        transpose_item(W, K, N, src0 + c0, nv, WT, drow, kb * 64, scr, lane);
    }
    base = (base + nitems) % NGW;
}
__device__ __forceinline__ void rms_row_bf16(const float* xrow, const float* g, bf16* orow, int lane) {
    const f32x4* xr = (const f32x4*)xrow + lane; const f32x4* gr = (const f32x4*)g + lane;
    f32x4 v[8]; float s = 0.f;
#pragma unroll
    for (int j = 0; j < 8; ++j) { v[j] = xr[64 * j]; s += (v[j].x * v[j].x + v[j].y * v[j].y) + (v[j].z * v[j].z + v[j].w * v[j].w); }
    const float rs = 1.f / sqrtf(wave_sum(s) * (1.f / DM) + RMS_EPS);
    unsigned long long* o8 = (unsigned long long*)orow + lane;
#pragma unroll
    for (int j = 0; j < 8; ++j) { const f32x4 gg = gr[64 * j];
        o8[64 * j] = (unsigned long long)pk2(v[j].x * rs * gg.x, v[j].y * rs * gg.y) | ((unsigned long long)pk2(v[j].z * rs * gg.z, v[j].w * rs * gg.w) << 32); }
}
__device__ __forceinline__ void rms_row_f32(float* xrow, const float* g, int lane) {
    f32x4* xr = (f32x4*)xrow + lane; const f32x4* gr = (const f32x4*)g + lane;
    f32x4 v[8]; float s = 0.f;
#pragma unroll
    for (int j = 0; j < 8; ++j) { v[j] = xr[64 * j]; s += (v[j].x * v[j].x + v[j].y * v[j].y) + (v[j].z * v[j].z + v[j].w * v[j].w); }
    const float rs = 1.f / sqrtf(wave_sum(s) * (1.f / DM) + RMS_EPS);
#pragma unroll
    for (int j = 0; j < 8; ++j) { const f32x4 gg = gr[64 * j]; xr[64 * j] = (f32x4){v[j].x * rs * gg.x, v[j].y * rs * gg.y, v[j].z * rs * gg.z, v[j].w * rs * gg.w}; }
}
using pg8::u32x4;
struct FWin {
    bf16 *XP, *Q, *KCVC, *KV4, *GPOOL, *GNSA, *NSAG;
    __device__ __forceinline__ void operator()(int row, int col, int pn, pg8::f32x4 v0, pg8::f32x4 v1) const {
        const u32x4 w = pg8::pack8(v0, v1); bf16* dst;
        if (pn < 4) dst = XP + (size_t)row * 1024 + col;
        else if (pn < 12) dst = Q + (size_t)row * 2048 + (col - 1024);
        else if (pn < 24) { const int c = col - 3072, tensor = c >> 9, g = (c >> 7) & 3, d = c & 127, b = row >> 13, t = row & 8191;
            dst = (tensor < 2 ? KCVC + (size_t)tensor * 8 * SEQ * 128 : KV4 + (size_t)(tensor - 2) * 8 * SEQ * 128) + ((size_t)(b * 4 + g) * SEQ + t) * 128 + d; }
        else if (pn < 32) dst = GPOOL + (size_t)row * 2048 + (col - 6144);
        else if (pn < 40) dst = GNSA + (size_t)row * 2048 + (col - 8192);
        else dst = NSAG + (size_t)row * 256 + (col - 10240);
        *(u32x4*)dst = w;
    }
};
struct FSiluBias { bf16* O; const float* bias;
    __device__ __forceinline__ void operator()(int row, int col, int pn, pg8::f32x4 v0, pg8::f32x4 v1) const {
        const float* bp = bias + ((row >> 12) << 8) + col; const pg8::f32x4 b0 = *(const pg8::f32x4*)bp, b1 = *(const pg8::f32x4*)(bp + 4);
#pragma unroll
        for (int j = 0; j < 4; ++j) { v0[j] = pg8::siluf_(v0[j] + b0[j]); v1[j] = pg8::siluf_(v1[j] + b1[j]); }
        *(u32x4*)(O + (size_t)row * 256 + col) = pg8::pack8(v0, v1);
    }
};
struct FStore128 { bf16* O;
    __device__ __forceinline__ void operator()(int row, int col, int pn, pg8::f32x4 v0, pg8::f32x4 v1) const {
        if (col < 128) *(u32x4*)(O + (size_t)row * 128 + col) = pg8::pack8(v0, v1);
    }
};
struct FPool { bf16* O; const float* scale;
    __device__ __forceinline__ void operator()(int row, int col, int pn, pg8::f32x4 v0, pg8::f32x4 v1) const {
        const pg8::f32x4 s0 = *(const pg8::f32x4*)(scale + col), s1 = *(const pg8::f32x4*)(scale + col + 4);
        *(u32x4*)(O + (size_t)row * PW + col) = pg8::pack8(v0 * s0, v1 * s1);
    }
};
struct FGate { bf16* MG; const bf16* Gt; bool add;
    __device__ __forceinline__ void operator()(int row, int col, int pn, pg8::f32x4 v0, pg8::f32x4 v1) const {
        const size_t off = (size_t)row * DM + col;
        const u32x4 gw = *(const u32x4*)(Gt + off);
        pg8::f32x4 r0, r1;
        r0[0] = pg8::sigmoidf_(pg8::bf_lo(gw.x)) * v0[0]; r0[1] = pg8::sigmoidf_(pg8::bf_hi(gw.x)) * v0[1]; r0[2] = pg8::sigmoidf_(pg8::bf_lo(gw.y)) * v0[2]; r0[3] = pg8::sigmoidf_(pg8::bf_hi(gw.y)) * v0[3];
        r1[0] = pg8::sigmoidf_(pg8::bf_lo(gw.z)) * v1[0]; r1[1] = pg8::sigmoidf_(pg8::bf_hi(gw.z)) * v1[1]; r1[2] = pg8::sigmoidf_(pg8::bf_lo(gw.w)) * v1[2]; r1[3] = pg8::sigmoidf_(pg8::bf_hi(gw.w)) * v1[3];
        if (add) { const u32x4 mw = *(const u32x4*)(MG + off);
            r0[0] += pg8::bf_lo(mw.x); r0[1] += pg8::bf_hi(mw.x); r0[2] += pg8::bf_lo(mw.y); r0[3] += pg8::bf_hi(mw.y);
            r1[0] += pg8::bf_lo(mw.z); r1[1] += pg8::bf_hi(mw.z); r1[2] += pg8::bf_lo(mw.w); r1[3] += pg8::bf_hi(mw.w); }
        *(u32x4*)(MG + off) = pg8::pack8(r0, r1);
    }
};

struct Args { const float* in[23]; float* out; unsigned char* ws; int ph_lo, ph_hi; };
enum { I_X = 0, I_F1N, I_F1G, I_F1U, I_F1D, I_MIXN, I_WIN, I_POOLW, I_POOLS, I_PEK, I_PEV, I_CKW1, I_CKW2, I_CVW1, I_CVW2, I_WPU, I_WNU, I_WOUT, I_F2N, I_F2G, I_F2U, I_F2D, I_FINN };
constexpr int N_PHASES = 14;

template <class Epi> __device__ __forceinline__ void run_gemm(LAS unsigned char* lds, const bf16* A, int lda, const bf16* Bt, int ldb, int Mr, int N, int K, int G, int c, const Epi& E, int apn = 0, int bdiv = 1 << 30, int bbytes = 0) {
    pg8::Gemm g{A, Bt, Mr, N, K, lda, ldb, apn, bdiv, bbytes}; pg8::StaticOrder S; S.init(Mr, N, G, c);
    pg8::gemm_phase<Epi, pg8::StaticOrder, true, true>(lds, g, S, E);
    __syncthreads();
}

__global__ void __launch_bounds__(NWAVES * 64, 2) mk_fwd(Args a) {
    extern __shared__ __attribute__((aligned(16))) unsigned char lds_raw[];
    LAS unsigned char* lds = (LAS unsigned char*)lds_raw;
    const int tid = threadIdx.x, lane = tid & 63, wave = __builtin_amdgcn_readfirstlane(tid >> 6);
    const int G = gridDim.x, bx = blockIdx.x;
    const int vcu = (G % 8 == 0) ? (bx % 8) * (G / 8) + bx / 8 : bx;
    const int gw = vcu * NWAVES + wave, NGW = G * NWAVES;
    unsigned char* ws = a.ws;
    bf16* Win_t = (bf16*)(ws + WS_WIN); bf16* Wpu_t = (bf16*)(ws + WS_WPU); bf16* Wnu_t = (bf16*)(ws + WS_WNU); bf16* Wout_t = (bf16*)(ws + WS_WOUT);
    bf16* Poolw_t = (bf16*)(ws + WS_POOLW); bf16* Cw1_t = (bf16*)(ws + WS_CW1); bf16* Cw2_t = (bf16*)(ws + WS_CW2);
    float* PEBP = (float*)(ws + WS_PEBP); float* PEB = (float*)(ws + WS_PEB);
    bf16* HIDC = (bf16*)(ws + WS_HIDC); bf16* KVCMP = (bf16*)(ws + WS_KVCMP);
    bf16* Wgu_t = (bf16*)(ws + WS_WGU); bf16* Wd_t = (bf16*)(ws + WS_WD); bf16* GNSA = (bf16*)(ws + WS_GNSA);
    bf16* XN = (bf16*)(ws + WS_XN); bf16* POOLED = (bf16*)(ws + WS_POOLED); bf16* APOOL = (bf16*)(ws + WS_APOOL);
    bf16* HID = (bf16*)(ws + WS_HID); bf16* XP = (bf16*)(ws + WS_XP); bf16* Q = (bf16*)(ws + WS_Q); bf16* KV4 = (bf16*)(ws + WS_KV4); bf16* KCVC = (bf16*)(ws + WS_KCVC); bf16* NSAG = (bf16*)(ws + WS_NSAG);
    bf16* GPOOL = (bf16*)(ws + WS_GPOOL);
    float* H = a.out;
    const int lo = a.ph_lo, hi = a.ph_hi;
#ifndef MK_PHASE_MASK
#define MK_PHASE_MASK 0x3fff
#endif
#define IN(k) (((MK_PHASE_MASK >> (k)) & 1) && lo <= (k) && (k) < hi)
#ifndef MK_REP_MASK
#define MK_REP_MASK 0
#endif
#define REP(k) ((MK_REP_MASK >> (k)) & 1)
#define SEAM(k) do { if (IN(k) && IN((k) + 1)) { __syncthreads(); cg::this_grid().sync(); } } while (0)
    LAS float* scr = (LAS float*)(lds + wave * 16384);

    if (IN(0)) for (int rep = 0; rep <= REP(0); ++rep) {
        int base = 0;
        transpose_seg(a.in[I_F1G], DM, FF, 0, FF, Wgu_t, 0, true, scr, lane, gw, NGW, base);
        transpose_seg(a.in[I_F1U], DM, FF, 0, FF, Wgu_t, 128, true, scr, lane, gw, NGW, base);
        transpose_seg(a.in[I_F1D], FF, DM, 0, DM, Wd_t, 0, false, scr, lane, gw, NGW, base);
        transpose_seg(a.in[I_WIN], DM, INW_SRC, 0, 6144, Win_t, 0, false, scr, lane, gw, NGW, base);
        transpose_seg(a.in[I_WIN], DM, INW_SRC, 6192, 2048, Win_t, 6144, false, scr, lane, gw, NGW, base);
        transpose_seg(a.in[I_WIN], DM, INW_SRC, 8240, 2048, Win_t, 8192, false, scr, lane, gw, NGW, base);
        transpose_seg(a.in[I_WIN], DM, INW_SRC, 6144, 48, Win_t, 10240, false, scr, lane, gw, NGW, base);
        transpose_seg(a.in[I_WPU], PW, DM, 0, DM, Wpu_t, 0, false, scr, lane, gw, NGW, base);
        transpose_seg(a.in[I_WNU], DM, DM, 0, DM, Wnu_t, 0, false, scr, lane, gw, NGW, base);
        transpose_seg(a.in[I_WOUT], DM, DM, 0, DM, Wout_t, 0, false, scr, lane, gw, NGW, base);
        for (int gi = 0; gi < 4; ++gi) transpose_seg(a.in[I_POOLW] + (size_t)gi * 65536, 256, 256, 0, 256, Poolw_t + (size_t)gi * 65536, 0, false, scr, lane, gw, NGW, base);
        transpose_seg(a.in[I_CKW1], 4096, 256, 0, 256, Cw1_t, 0, false, scr, lane, gw, NGW, base);
        transpose_seg(a.in[I_CVW1], 4096, 256, 0, 256, Cw1_t + (size_t)256 * 4096, 0, false, scr, lane, gw, NGW, base);
        transpose_seg(a.in[I_CKW2], 256, 128, 0, 128, Cw2_t, 0, false, scr, lane, gw, NGW, base);
        transpose_seg(a.in[I_CVW2], 256, 128, 0, 128, Cw2_t + 65536, 0, false, scr, lane, gw, NGW, base);
        for (int m = gw; m < M; m += NGW) rms_row_bf16(a.in[I_X] + (size_t)m * DM, a.in[I_F1N], XN + (size_t)m * DM, lane);
        for (int task = gw; task < 256; task += NGW) {
            const int tensor = task >> 7, chunk = (task >> 2) & 31, col = (task & 3) * 64 + lane;
            const float* pe = a.in[tensor ? I_PEV : I_PEK] + chunk * 128; const float* w1 = a.in[tensor ? I_CVW1 : I_CKW1] + (size_t)chunk * 128 * 256 + col;
            float acc = 0.f;
#pragma unroll 8
            for (int k = 0; k < 128; ++k) acc += pe[k] * w1[(size_t)k * 256];
            PEBP[(tensor * 32 + chunk) * 256 + col] = acc;
        }
    }
    SEAM(0);
    if (IN(1)) for (int rep = 0; rep <= REP(1); ++rep) { pg8::EpiSwiglu E{HID, FF}; run_gemm(lds, XN, DM, Wgu_t, DM, M, 2 * FF, DM, G, bx, E); }
    SEAM(1);
    if (IN(2)) for (int rep = 0; rep <= REP(2); ++rep) { pg8::EpiResF32 E{a.in[I_X], H, DM, 0.5f}; run_gemm(lds, HID, FF, Wd_t, FF, M, DM, FF, G, bx, E); }
    SEAM(2);
    if (IN(3)) for (int rep = 0; rep <= REP(3); ++rep) {
        for (int m = gw; m < M; m += NGW) rms_row_bf16(H + (size_t)m * DM, a.in[I_MIXN], XN + (size_t)m * DM, lane);
        if (bx == 0) { float s = 0.f; for (int c = 0; c < 32; ++c) s += PEBP[((tid >> 8) * 32 + c) * 256 + (tid & 255)]; PEB[tid] = s; }
    }
    SEAM(3);
    if (IN(4)) for (int rep = 0; rep <= REP(4); ++rep) { pg8::EpiP8<FWin> E{FWin{XP, Q, KCVC, KV4, GPOOL, GNSA, NSAG}}; run_gemm(lds, XN, DM, Win_t, DM, M, INW, DM, G, bx, E); }
    SEAM(4);
    if (IN(5)) for (int rep = 0; rep <= REP(5); ++rep) {
        { pg8::EpiP8<FSiluBias> E{FSiluBias{HIDC, PEB}}; run_gemm(lds, KCVC, 2048, Cw1_t, 4096, 8192, 256, 4096, G, bx, E, 0, 16, 256 * 4096 * 2); }
        const int nthr = G * NWAVES * 64;
        for (int idx = vcu * 512 + tid; idx < M * 128; idx += nthr) {
            const int row = idx >> 7, c8 = (idx & 127) * 8, win = 2 << (c8 >> 8), t = row & (SEQ - 1), n = (t + 1) < win ? (t + 1) : win;
            float acc[8] = {0.f, 0.f, 0.f, 0.f, 0.f, 0.f, 0.f, 0.f}, x0[8];
            for (int j = 0; j < n; ++j) { const v4u w = *(const v4u*)(XP + (size_t)(row - j) * PW + c8);
                const float f[8] = {pg8::bf_lo(w.x), pg8::bf_hi(w.x), pg8::bf_lo(w.y), pg8::bf_hi(w.y), pg8::bf_lo(w.z), pg8::bf_hi(w.z), pg8::bf_lo(w.w), pg8::bf_hi(w.w)};
#pragma unroll
                for (int e = 0; e < 8; ++e) { acc[e] += f[e]; if (j == 0) x0[e] = f[e]; } }
            const float inv = 1.f / (float)n;
            v4u o; o.x = pk2(acc[0] * inv - x0[0], acc[1] * inv - x0[1]); o.y = pk2(acc[2] * inv - x0[2], acc[3] * inv - x0[3]);
            o.z = pk2(acc[4] * inv - x0[4], acc[5] * inv - x0[5]); o.w = pk2(acc[6] * inv - x0[6], acc[7] * inv - x0[7]);
            *(v4u*)(POOLED + (size_t)row * PW + c8) = o;
        }
    }
    SEAM(5);
    if (IN(6)) for (int rep = 0; rep <= REP(6); ++rep) {
        { pg8::EpiP8<FPool> E{FPool{APOOL, a.in[I_POOLS]}}; run_gemm(lds, POOLED, PW, Poolw_t, 256, M, PW, 256, G, bx, E, 256 * 2); }
        { pg8::EpiP8<FStore128> E{FStore128{KVCMP}}; run_gemm(lds, HIDC, 256, Cw2_t, 256, 8192, 256, 256, G, bx, E, 0, 16, 65536 * 2); }
    }
    SEAM(6);
    if (IN(7)) {
        { pg8::EpiP8<FGate> E{FGate{GPOOL, GPOOL, false}}; run_gemm(lds, APOOL, PW, Wpu_t, PW, M, DM, PW, G, bx, E); }
        for (int rep = REP(7) ? 0 : 1; rep < 2; ++rep)
        for (int it = vcu; it < 1024; it += G) {
            const int c = it & 255, k = it >> 8, bg = c >> 5, i = c & 31;
            const int qb = (k == 0) ? i : (k == 1) ? 63 - i : (k == 2) ? 64 + i : 127 - i;
            nsa::nsa_unit(bg >> 2, bg & 3, qb, Q, KV4, KVCMP, KVCMP + (size_t)4096 * 128, NSAG, Q, (char*)lds_raw, rep == 1 || a.ph_lo != 0);
        }
    }
    SEAM(7);
    if (IN(8)) { pg8::EpiP8<FGate> E{FGate{GPOOL, GNSA, true}}; run_gemm(lds, Q, DM, Wnu_t, DM, M, DM, DM, G, bx, E); }
    SEAM(8);
    if (IN(9)) { pg8::EpiResF32 E{H, H, DM, 1.0f}; run_gemm(lds, GPOOL, DM, Wout_t, DM, M, DM, DM, G, bx, E); }
    SEAM(9);
    if (IN(10)) for (int rep = 0; rep <= REP(10); ++rep) {
        int base = 0;
        transpose_seg(a.in[I_F2G], DM, FF, 0, FF, Wgu_t, 0, true, scr, lane, gw, NGW, base);
        transpose_seg(a.in[I_F2U], DM, FF, 0, FF, Wgu_t, 128, true, scr, lane, gw, NGW, base);
        transpose_seg(a.in[I_F2D], FF, DM, 0, DM, Wd_t, 0, false, scr, lane, gw, NGW, base);
        for (int m = gw; m < M; m += NGW) rms_row_bf16(H + (size_t)m * DM, a.in[I_F2N], XN + (size_t)m * DM, lane);
    }
    SEAM(10);
    if (IN(11)) for (int rep = 0; rep <= REP(11); ++rep) { pg8::EpiSwiglu E{HID, FF}; run_gemm(lds, XN, DM, Wgu_t, DM, M, 2 * FF, DM, G, bx, E); }
    SEAM(11);
    if (IN(12)) { pg8::EpiResF32 E{H, H, DM, 0.5f}; run_gemm(lds, HID, FF, Wd_t, FF, M, DM, FF, G, bx, E); }
    SEAM(12);
    if (IN(13)) { for (int m = gw; m < M; m += NGW) rms_row_f32(H + (size_t)m * DM, a.in[I_FINN], lane); }
#undef IN
#undef SEAM
}

#ifndef MK_ONE_LAUNCH
#define MK_ONE_LAUNCH 1
#endif
extern "C" void kernel_launch(void* const* d_in, const int* in_sizes, int n_in, void* d_out, int out_size, void* d_ws, size_t ws_size, hipStream_t stream) {
    static int grid = 0;
    if (grid == 0) {
        if (n_in != 23 || out_size != M * DM || ws_size < WS_END) { fprintf(stderr, "kernel_launch: unexpected shapes (n_in %d out %d ws %zu)\n", n_in, out_size, ws_size); grid = -1; return; }
        int dev = 0, cus = 0, per_cu = 0;
        (void)hipGetDevice(&dev); (void)hipDeviceGetAttribute(&cus, hipDeviceAttributeMultiprocessorCount, dev);
        if (hipFuncSetAttribute((const void*)mk_fwd, hipFuncAttributeMaxDynamicSharedMemorySize, LDS_BYTES) != hipSuccess) { fprintf(stderr, "kernel_launch: hipFuncSetAttribute failed\n"); grid = -1; return; }
        if (hipOccupancyMaxActiveBlocksPerMultiprocessor(&per_cu, (const void*)mk_fwd, NWAVES * 64, LDS_BYTES) != hipSuccess || per_cu < 1) { fprintf(stderr, "kernel_launch: occupancy query says %d\n", per_cu); per_cu = 1; }
        (void)hipGetLastError();
        grid = cus > 0 ? cus : 256;
    }
    if (grid < 0) return;
    Args a{};
    for (int i = 0; i < 23; ++i) a.in[i] = (const float*)d_in[i];
    a.out = (float*)d_out; a.ws = (unsigned char*)d_ws;
#if MK_ONE_LAUNCH
    a.ph_lo = 0; a.ph_hi = N_PHASES;
    void* args[] = {&a};
    hipError_t e = hipLaunchCooperativeKernel((const void*)mk_fwd, dim3(grid), dim3(NWAVES * 64), args, LDS_BYTES, stream);
    if (e != hipSuccess) fprintf(stderr, "kernel_launch: cooperative launch failed: %s (grid %d)\n", hipGetErrorString(e), grid);
#else
    for (int p = 0; p < N_PHASES; ++p) { a.ph_lo = p; a.ph_hi = p + 1; hipLaunchKernelGGL(mk_fwd, dim3(grid), dim3(NWAVES * 64), LDS_BYTES, stream, a); }
#endif
}
```

```cpp
#include <hip/hip_runtime.h>
#include <hip/hip_cooperative_groups.h>
#include <cstdio>
#include <cstdint>
namespace cg = cooperative_groups;
namespace pg8 {
#define PG8_LAS __attribute__((address_space(3)))
typedef unsigned short bf16_t;
typedef short bf16x8 __attribute__((ext_vector_type(8)));
typedef float f32x4 __attribute__((ext_vector_type(4)));
typedef unsigned u32x4 __attribute__((ext_vector_type(4)));
constexpr int BM = 256, BK = 64, HALF = 128, HTB = HALF * BK * 2  , STAGE_BYTES = 8 * HTB, NXCD = 8, WGM = 8;

__host__ __device__ __forceinline__ int lds_byte(int r, int c) { const int st = (r >> 4) * 2 + (c >> 5), rr = r & 15, cc = c & 31, ob = rr * 64 + cc * 2; return st * 1024 + (ob ^ (((ob >> 9) & 1) << 5)); }
__host__ __device__ __forceinline__ void stage_rc(int b, int& R, int& C) { const int st = b / 1024, sb = b % 1024, swz = sb ^ (((sb >> 9) & 1) << 5); R = (st >> 1) * 16 + swz / 64; C = (st & 1) * 32 + (swz % 64) / 2; }
__host__ __device__ __forceinline__ int perm32(int rho) { const int n = rho >> 4, i = rho & 15; return 8 * (i >> 2) + 4 * n + (i & 3); }

struct Unit { int pm, pn; };
struct Gemm { const bf16_t* A; const bf16_t* Bt; int M, N, K, lda, ldb; int apn  , bdiv, bbytes  ; };

struct StaticOrder {
    int nM, nN, nwg, G, c;
    __host__ __device__ void init(int M, int N, int G_, int c_) { nM = M / BM; nN = N / BM; nwg = nM * nN; G = G_; c = c_; }
    __host__ __device__ bool next(int i, Unit& u) const {
        const long L = (long)i * G + c; if (L >= nwg) return false;
        int wgid = (int)L; { const int q = nwg / NXCD, r = nwg % NXCD, xcd = wgid % NXCD, off = wgid / NXCD; wgid = (xcd < r ? xcd * (q + 1) : r * (q + 1) + (xcd - r) * q) + off; }
        const int nig = WGM * nN, gid = wgid / nig, fm = gid * WGM, gsz = (nM - fm) < WGM ? (nM - fm) : WGM;
        u.pm = fm + ((wgid % nig) % gsz); u.pn = (wgid % nig) / gsz; return true;
    }
    __device__ __forceinline__ void a_ready(const Unit&) const {}
    __device__ __forceinline__ void done(const Unit&) const {}
};

__device__ __forceinline__ unsigned cvt_pk_bf16(float lo, float hi) { unsigned r; asm volatile("v_cvt_pk_bf16_f32 %0, %1, %2" : "=v"(r) : "v"(lo), "v"(hi)); return r; }
__device__ __forceinline__ float bf_lo(unsigned w) { return __builtin_bit_cast(float, w << 16); }
__device__ __forceinline__ float bf_hi(unsigned w) { return __builtin_bit_cast(float, w & 0xffff0000u); }
__device__ __forceinline__ float sigmoidf_(float x) { return __builtin_amdgcn_rcpf(1.f + __builtin_amdgcn_exp2f(-1.4426950408889634f * x)); }
__device__ __forceinline__ float siluf_(float x) { return x * sigmoidf_(x); }
__device__ __forceinline__ u32x4 pack8(f32x4 a, f32x4 b) { u32x4 w; w.x = cvt_pk_bf16(a[0], a[1]); w.y = cvt_pk_bf16(a[2], a[3]); w.z = cvt_pk_bf16(b[0], b[1]); w.w = cvt_pk_bf16(b[2], b[3]); return w; }

template <class F> struct EpiP8 {
    static constexpr bool PERM = true, AFTER_DRAIN = false;
    F f;
    __device__ __forceinline__ void operator()(const f32x4 (&acc)[2][2][4][2], const Unit& u, int wr, int wc, int fr, int fq) const {
        const int row0 = u.pm * BM + wr * 64 + fr, col0 = u.pn * BM + wc * 32 + 8 * fq;
#pragma unroll
        for (int ai = 0; ai < 2; ++ai)
#pragma unroll
            for (int m = 0; m < 4; ++m) {
                const int row = row0 + ai * HALF + m * 16;
#pragma unroll
                for (int bj = 0; bj < 2; ++bj) f(row, col0 + bj * HALF, u.pn, acc[ai][bj][m][0], acc[ai][bj][m][1]);
            }
    }
};
struct EpiSwiglu {
    static constexpr bool PERM = true, AFTER_DRAIN = false;
    bf16_t* O; int ldc;
    __device__ __forceinline__ void operator()(const f32x4 (&acc)[2][2][4][2], const Unit& u, int wr, int wc, int fr, int fq) const {
        const int row0 = u.pm * BM + wr * 64 + fr, col0 = u.pn * HALF + wc * 32 + 8 * fq;
#pragma unroll
        for (int ai = 0; ai < 2; ++ai)
#pragma unroll
            for (int m = 0; m < 4; ++m) {
                const int row = row0 + ai * HALF + m * 16;
                f32x4 h0, h1;
#pragma unroll
                for (int j = 0; j < 4; ++j) { h0[j] = siluf_(acc[ai][0][m][0][j]) * acc[ai][1][m][0][j]; h1[j] = siluf_(acc[ai][0][m][1][j]) * acc[ai][1][m][1][j]; }
                *(u32x4*)(O + (size_t)row * ldc + col0) = pack8(h0, h1);
            }
    }
};
struct EpiResF32 {
    static constexpr bool PERM = false, AFTER_DRAIN = false;
    const float* base; float* out; int ldc; float coef;
    __device__ __forceinline__ void operator()(const f32x4 (&acc)[2][2][4][2], const Unit& u, int wr, int wc, int fr, int fq) const {
        const int row0 = u.pm * BM + wr * 64 + fr, col0 = u.pn * BM + wc * 32 + 4 * fq;
#pragma unroll
        for (int ai = 0; ai < 2; ++ai)
#pragma unroll
            for (int m = 0; m < 4; ++m) {
                const size_t off = (size_t)(row0 + ai * HALF + m * 16) * ldc + col0;
#pragma unroll
                for (int bj = 0; bj < 2; ++bj)
#pragma unroll
                    for (int n = 0; n < 2; ++n) { const f32x4 b = *(const f32x4*)(base + off + bj * HALF + n * 16); *(f32x4*)(out + off + bj * HALF + n * 16) = b + acc[ai][bj][m][n] * coef; }
            }
    }
};
template <class Epi, class Sched, bool ALIGN_EPI = false, bool SP2 = false>
__device__ __forceinline__ void gemm_phase(PG8_LAS unsigned char* lds, const Gemm g, const Sched& S, const Epi& E) {
    const int tid = threadIdx.x, wid = __builtin_amdgcn_readfirstlane(tid >> 6), lane = tid & 63, wr = wid >> 2, wc = wid & 3, fr = lane & 15, fq = lane >> 4;
    const int K = g.K, nt = K / BK;
    unsigned voffA[2], voffB[2];
#pragma unroll
    for (int i = 0; i < 2; ++i) { int R, C; stage_rc(tid * 16 + i * 8192, R, C); const int Rb = Epi::PERM ? ((R & ~31) + perm32(R & 31)) : R;
        voffA[i] = (unsigned)(R * g.lda + C) * 2u; voffB[i] = (unsigned)(Rb * g.ldb + C) * 2u; }
    const size_t kstep = (size_t)(BK * 2);
    const size_t hstepA = (size_t)HALF * g.lda * 2, hstepB = (size_t)HALF * g.ldb * 2;
    const size_t tstepA = 2 * hstepA, tstepB = 2 * hstepB;
    const unsigned ldsw = (unsigned)wid * 1024u;
    const int aoff = lds_byte(wr * 64 + fr, fq * 8), boff = lds_byte(wc * 32 + fr, fq * 8);
#define PG8_SA(b, h) (((b) * 2 + (h)) * HTB)
#define PG8_SB(b, h) ((4 + (b) * 2 + (h)) * HTB)
#define PG8_STAGE(bufoff, gbase, voff) do { _Pragma("unroll") for (int _i = 0; _i < 2; ++_i) \
        __builtin_amdgcn_global_load_lds((const unsigned*)((const char*)(gbase) + (voff)[_i]), (PG8_LAS unsigned*)(lds + (bufoff) + ldsw + _i * 8192), 16, 0, 0); } while (0)
#define PG8_LDA(dst, b, h) do { _Pragma("unroll") for (int m = 0; m < 4; ++m) _Pragma("unroll") for (int k = 0; k < 2; ++k) dst[m][k] = *(const PG8_LAS bf16x8*)(lds + PG8_SA(b, h) + aoff + m * 2048 + k * 1024); } while (0)
#define PG8_LDB(dst, b, h) do { _Pragma("unroll") for (int n = 0; n < 2; ++n) _Pragma("unroll") for (int k = 0; k < 2; ++k) dst[n][k] = *(const PG8_LAS bf16x8*)(lds + PG8_SB(b, h) + boff + n * 2048 + k * 1024); } while (0)
#define PG8_MMA(ai, bj, At, Bt) do { __builtin_amdgcn_s_setprio(1); _Pragma("unroll") for (int m = 0; m < 4; ++m) _Pragma("unroll") for (int n = 0; n < 2; ++n) _Pragma("unroll") for (int k = 0; k < 2; ++k) \
        acc[ai][bj][m][n] = __builtin_amdgcn_mfma_f32_16x16x32_bf16(Bt[n][k], At[m][k], acc[ai][bj][m][n], 0, 0, 0); __builtin_amdgcn_s_setprio(0); } while (0)
#define PG8_WAIT_V(n) asm volatile("s_waitcnt vmcnt(" #n ")" ::: "memory")
#define PG8_WAIT_L(n) asm volatile("s_waitcnt lgkmcnt(" #n ")" ::: "memory")
#define PG8_BAR __builtin_amdgcn_s_barrier()
#define PG8_SCHED __builtin_amdgcn_sched_barrier(0)
    Unit cur, nxt; int ui = 0;
    if (!S.next(0, cur)) return;
    f32x4 acc[2][2][4][2];
#pragma unroll
    for (int a = 0; a < 2; ++a)
#pragma unroll
        for (int b = 0; b < 2; ++b)
#pragma unroll
            for (int m = 0; m < 4; ++m)
#pragma unroll
                for (int n = 0; n < 2; ++n) acc[a][b][m][n] = (f32x4){0.f, 0.f, 0.f, 0.f};
    bf16x8 At[4][2], B0[2][2], B1[2][2];
    const char* cA = (const char*)g.A + (size_t)cur.pm * tstepA + (size_t)cur.pn * g.apn; const char* cB = (const char*)g.Bt + (size_t)cur.pn * tstepB + (size_t)(cur.pm / g.bdiv) * g.bbytes;
    S.a_ready(cur);
    if constexpr (SP2) {
        PG8_STAGE(PG8_SB(0, 0), cB, voffB); PG8_STAGE(PG8_SB(0, 1), cB + hstepB, voffB); PG8_STAGE(PG8_SA(0, 0), cA, voffA); PG8_STAGE(PG8_SA(0, 1), cA + hstepA, voffA);
        if (wr == 1) PG8_BAR;
        PG8_WAIT_V(2); PG8_BAR;
        PG8_STAGE(PG8_SB(1, 0), cB + kstep, voffB); PG8_STAGE(PG8_SA(1, 0), cA + kstep, voffA); PG8_STAGE(PG8_SB(1, 1), cB + hstepB + kstep, voffB);
        PG8_WAIT_V(6); PG8_BAR;
    } else {
        PG8_STAGE(PG8_SB(0, 0), cB, voffB); PG8_STAGE(PG8_SA(0, 0), cA, voffA); PG8_STAGE(PG8_SB(0, 1), cB + hstepB, voffB); PG8_STAGE(PG8_SA(0, 1), cA + hstepA, voffA);
        if (wr == 1) PG8_BAR;
        PG8_WAIT_V(4); PG8_BAR;
        PG8_STAGE(PG8_SB(1, 0), cB + kstep, voffB); PG8_STAGE(PG8_SA(1, 0), cA + kstep, voffA); PG8_STAGE(PG8_SB(1, 1), cB + hstepB + kstep, voffB);
        PG8_WAIT_V(6); PG8_BAR;
    }
    for (;;) {
        const bool has_next = S.next(ui + 1, nxt);
        const char* nA = has_next ? (const char*)g.A + (size_t)nxt.pm * tstepA + (size_t)nxt.pn * g.apn : cA; const char* nB = has_next ? (const char*)g.Bt + (size_t)nxt.pn * tstepB + (size_t)(nxt.pm / g.bdiv) * g.bbytes : cB;
#pragma nounroll
        for (int t = 0; t < nt; t += 2) {
            const bool last = (t == nt - 2);
            const char* a1 = cA + (size_t)(t + 1) * kstep;
            const char* a2 = last ? nA : cA + (size_t)(t + 2) * kstep; const char* b2 = last ? nB : cB + (size_t)(t + 2) * kstep;
            const char* a3 = a2 + kstep; const char* b3 = b2 + kstep;
            if (last && has_next) S.a_ready(nxt);
            if constexpr (SP2) {
            PG8_LDB(B0, 0, 0); PG8_LDB(B1, 0, 1); PG8_SCHED; PG8_LDA(At, 0, 0); PG8_STAGE(PG8_SA(1, 1), a1 + hstepA, voffA);
            PG8_WAIT_V(8); PG8_WAIT_L(0); PG8_BAR; PG8_MMA(0, 0, At, B0); PG8_MMA(0, 1, At, B1); PG8_BAR; PG8_SCHED;
            PG8_LDA(At, 0, 1); PG8_STAGE(PG8_SB(0, 0), b2, voffB); PG8_STAGE(PG8_SB(0, 1), b2 + hstepB, voffB); PG8_STAGE(PG8_SA(0, 0), a2, voffA);
            PG8_WAIT_V(8); PG8_WAIT_L(0); PG8_BAR; PG8_MMA(1, 0, At, B0); PG8_MMA(1, 1, At, B1); PG8_BAR; PG8_SCHED;
            PG8_LDB(B0, 1, 0); PG8_LDB(B1, 1, 1); PG8_SCHED; PG8_LDA(At, 1, 0); PG8_STAGE(PG8_SA(0, 1), a2 + hstepA, voffA);
            PG8_WAIT_V(8); PG8_WAIT_L(0); PG8_BAR; PG8_MMA(0, 0, At, B0); PG8_MMA(0, 1, At, B1); PG8_BAR; PG8_SCHED;
            PG8_LDA(At, 1, 1); PG8_STAGE(PG8_SB(1, 0), b3, voffB); PG8_STAGE(PG8_SB(1, 1), b3 + hstepB, voffB); PG8_STAGE(PG8_SA(1, 0), a3, voffA);
            PG8_WAIT_V(8); PG8_WAIT_L(0); PG8_BAR; PG8_MMA(1, 0, At, B0); PG8_MMA(1, 1, At, B1); PG8_BAR; PG8_SCHED;
            } else {
            PG8_LDB(B0, 0, 0); PG8_SCHED; PG8_LDA(At, 0, 0); PG8_STAGE(PG8_SA(1, 1), a1 + hstepA, voffA);
            PG8_WAIT_L(8); PG8_BAR; PG8_WAIT_L(0); PG8_MMA(0, 0, At, B0); PG8_BAR; PG8_SCHED;
            PG8_LDB(B1, 0, 1); PG8_STAGE(PG8_SB(0, 0), b2, voffB);
            PG8_BAR; PG8_WAIT_L(0); PG8_MMA(0, 1, At, B1); PG8_BAR;
            PG8_LDA(At, 0, 1); PG8_STAGE(PG8_SA(0, 0), a2, voffA);
            PG8_BAR; PG8_WAIT_L(0); PG8_MMA(1, 0, At, B0); PG8_BAR; PG8_SCHED;
            PG8_STAGE(PG8_SB(0, 1), b2 + hstepB, voffB);
            PG8_WAIT_V(6); PG8_BAR; PG8_MMA(1, 1, At, B1); PG8_BAR;
            PG8_LDB(B0, 1, 0); PG8_SCHED; PG8_LDA(At, 1, 0); PG8_STAGE(PG8_SA(0, 1), a2 + hstepA, voffA);
            PG8_WAIT_L(8); PG8_BAR; PG8_WAIT_L(0); PG8_MMA(0, 0, At, B0); PG8_BAR; PG8_SCHED;
            PG8_LDB(B1, 1, 1); PG8_STAGE(PG8_SB(1, 0), b3, voffB);
            PG8_BAR; PG8_WAIT_L(0); PG8_MMA(0, 1, At, B1); PG8_BAR;
            PG8_LDA(At, 1, 1); PG8_STAGE(PG8_SA(1, 0), a3, voffA);
            PG8_BAR; PG8_WAIT_L(0); PG8_MMA(1, 0, At, B0); PG8_BAR; PG8_SCHED;
            PG8_STAGE(PG8_SB(1, 1), b3 + hstepB, voffB);
            PG8_WAIT_V(6); PG8_BAR; PG8_MMA(1, 1, At, B1); PG8_BAR;
            }
        }
        if constexpr (ALIGN_EPI) { if (wr == 0) PG8_BAR; }
        if constexpr (!Epi::AFTER_DRAIN) { E(acc, cur, wr, wc, fr, fq); S.done(cur); }
        if (!has_next) break;
#pragma unroll
        for (int a = 0; a < 2; ++a)
#pragma unroll
            for (int b = 0; b < 2; ++b)
#pragma unroll
                for (int m = 0; m < 4; ++m)
#pragma unroll
                    for (int n = 0; n < 2; ++n) acc[a][b][m][n] = (f32x4){0.f, 0.f, 0.f, 0.f};
        cur = nxt; cA = nA; cB = nB; ++ui;
        if constexpr (ALIGN_EPI) { if (wr == 1) PG8_BAR; }
    }
    PG8_WAIT_V(0);
    if constexpr (!ALIGN_EPI) { if (wr == 0) PG8_BAR; }
    PG8_BAR;
    if constexpr (Epi::AFTER_DRAIN) { E.fused(acc, cur, wr, wc, fr, fq, lds, wid, lane); S.done(cur); }
#undef PG8_SA
#undef PG8_SB
#undef PG8_STAGE
#undef PG8_LDA
#undef PG8_LDB
#undef PG8_MMA
#undef PG8_WAIT_V
#undef PG8_WAIT_L
#undef PG8_BAR
#undef PG8_SCHED
}
}
namespace nsa {
typedef unsigned short bf16_t;
typedef short bf16x8 __attribute__((ext_vector_type(8)));
typedef short s16x4 __attribute__((ext_vector_type(4)));
typedef float f32x16 __attribute__((ext_vector_type(16)));
typedef float f32x4 __attribute__((ext_vector_type(4)));
typedef unsigned u32x4 __attribute__((ext_vector_type(4)));
constexpr int D = 128, KVBLK = 64, SHM_K = 16384, SHM_V = 16384, SEQ = 8192;
constexpr float SCALE = 0.08838834764831845f, C2 = 1.4426950408889634f * SCALE, THR = 8.f;
constexpr int L_KV = 0  , L_WS = 65536, L_SELM = 67584, L_PARK = 69632  , L_IMP = L_PARK  , L_END = L_PARK + 65536;
#define KSWZ(row, colB) ((row) * 256 + ((colB) ^ (((row) & 7) << 4)))
#define SBAR() __builtin_amdgcn_sched_barrier(0)
__device__ __forceinline__ int v_st(int k, int c) { const int kk = (k & ~0xC) | ((k & 4) << 1) | ((k & 8) >> 1); return ((kk >> 3) * 4 + (c >> 5)) * 512 + ((kk & 7) * 32 + (c & 31)) * 2; }
__device__ __forceinline__ int v_rd_base(int lane) { return ((lane & 3) << 3) | (((lane >> 2) & 3) << 6) | (((lane >> 4) & 1) << 5) | (((lane >> 5) & 1) << 8); }
constexpr int v_rd_off(int d0, int ks, int half) { return d0 * 512 + ks * 4096 + half * 2048; }
__device__ __forceinline__ int crow(int r, int hi) { return (r & 3) + 8 * (r >> 2) + 4 * hi; }
__device__ __forceinline__ unsigned cvtpk(float lo, float hi) { unsigned r; asm volatile("v_cvt_pk_bf16_f32 %0, %1, %2" : "=v"(r) : "v"(lo), "v"(hi)); return r; }
__device__ __forceinline__ void mask_tile(f32x16& p0, f32x16& p1, int dq, unsigned W) {
    const float NEG = -__builtin_inff();
#pragma unroll
    for (int r = 0; r < 16; ++r) {
        const int c = (r & 3) + 8 * (r >> 2);
        if ((unsigned)(dq - c) >= W) p0[r] = NEG;
        if ((unsigned)(dq - c - 32) >= W) p1[r] = NEG;
    }
}
__device__ __forceinline__ float rowmax32(const f32x16& p0, const f32x16& p1) {
    float pmax = p0[0];
#pragma unroll
    for (int r = 1; r < 16; ++r) pmax = fmaxf(pmax, p0[r]);
#pragma unroll
    for (int r = 0; r < 16; ++r) pmax = fmaxf(pmax, p1[r]);
    auto rr = __builtin_amdgcn_permlane32_swap(__float_as_uint(pmax), __float_as_uint(pmax), false, false);
    return fmaxf(__uint_as_float(rr[0]), __uint_as_float(rr[1]));
}
__device__ __forceinline__ float rowsum32(const f32x16& p0, const f32x16& p1) {
    float ps = 0.f;
#pragma unroll
    for (int r = 0; r < 16; ++r) ps += p0[r];
#pragma unroll
    for (int r = 0; r < 16; ++r) ps += p1[r];
    auto rr = __builtin_amdgcn_permlane32_swap(__float_as_uint(ps), __float_as_uint(ps), false, false);
    return __uint_as_float(rr[0]) + __uint_as_float(rr[1]);
}
__device__ __forceinline__ void packP(const f32x16& p0, const f32x16& p1, bf16x8& pa0, bf16x8& pa1, bf16x8& pa2, bf16x8& pa3) {
#define PK4(P, B_, OUT) do { unsigned a0 = cvtpk(P[B_+0], P[B_+1]), a1 = cvtpk(P[B_+2], P[B_+3]);                          \
        unsigned b0 = cvtpk(P[B_+4], P[B_+5]), b1 = cvtpk(P[B_+6], P[B_+7]);                                             \
        auto r0 = __builtin_amdgcn_permlane32_swap(a0, b0, false, false); auto r1 = __builtin_amdgcn_permlane32_swap(a1, b1, false, false); \
        u32x4 w = {r0[0], r1[0], r0[1], r1[1]}; OUT = *reinterpret_cast<bf16x8*>(&w); } while (0)
    PK4(p0, 0, pa0); PK4(p0, 8, pa1); PK4(p1, 0, pa2); PK4(p1, 8, pa3);
#undef PK4
}
__device__ __forceinline__ void qkt(f32x16& p0, f32x16& p1, const char* K_lds, int r32, int hi, const bf16x8* qr) {
    p0 = f32x16{}; p1 = f32x16{};
    const char* kb[4];
#pragma unroll
    for (int dd = 0; dd < 4; ++dd) kb[dd] = K_lds + KSWZ(r32, (dd * 16 + hi * 8) * 2);
#pragma unroll
    for (int d0 = 0; d0 < 8; ++d0) { const char* a = kb[d0 & 3] + (d0 >> 2) * 128;
        bf16x8 b0 = *reinterpret_cast<const bf16x8*>(a);
        bf16x8 b1 = *reinterpret_cast<const bf16x8*>(a + 32 * 256);
        p0 = __builtin_amdgcn_mfma_f32_32x32x16_bf16(b0, qr[d0], p0, 0, 0, 0);
        p1 = __builtin_amdgcn_mfma_f32_32x32x16_bf16(b1, qr[d0], p1, 0, 0, 0); }
}
__device__ __forceinline__ void pv_tile(f32x16* o, int vb0, bf16x8 pa0, bf16x8 pa1, bf16x8 pa2, bf16x8 pa3) {
#define TRRD(dst, off) asm volatile("ds_read_b64_tr_b16 %0, %1 offset:%2" : "=&v"(dst) : "v"(vb0), "i"(off) : "memory")
#define PV_D0(d0) do { s16x4 l0, l1, l2, l3, h0, h1, h2, h3; constexpr int b_ = v_rd_off(d0, 0, 0); \
        TRRD(l0, b_); TRRD(h0, b_ + 2048); TRRD(l1, b_ + 4096); TRRD(h1, b_ + 6144); TRRD(l2, b_ + 8192); TRRD(h2, b_ + 10240); TRRD(l3, b_ + 12288); TRRD(h3, b_ + 14336); \
        asm volatile("s_waitcnt lgkmcnt(0)" ::: "memory"); SBAR();   \
        o[d0] = __builtin_amdgcn_mfma_f32_32x32x16_bf16(pa0, (bf16x8){l0[0], l0[1], l0[2], l0[3], h0[0], h0[1], h0[2], h0[3]}, o[d0], 0, 0, 0);   \
        o[d0] = __builtin_amdgcn_mfma_f32_32x32x16_bf16(pa1, (bf16x8){l1[0], l1[1], l1[2], l1[3], h1[0], h1[1], h1[2], h1[3]}, o[d0], 0, 0, 0);   \
        o[d0] = __builtin_amdgcn_mfma_f32_32x32x16_bf16(pa2, (bf16x8){l2[0], l2[1], l2[2], l2[3], h2[0], h2[1], h2[2], h2[3]}, o[d0], 0, 0, 0);   \
        o[d0] = __builtin_amdgcn_mfma_f32_32x32x16_bf16(pa3, (bf16x8){l3[0], l3[1], l3[2], l3[3], h3[0], h3[1], h3[2], h3[3]}, o[d0], 0, 0, 0); } while (0)
    PV_D0(0); PV_D0(1); PV_D0(2); PV_D0(3);
#undef PV_D0
#undef TRRD
}

template <int MODE, int KIND>
__device__ __forceinline__ void attend(const bf16_t* __restrict__ Kg, const bf16_t* __restrict__ Vg, int j_lo, int j_hi, int pos, unsigned W,
                                       char* lds, const bf16x8* qr, float& m_reg, float& l_reg, f32x16* o, float f_imp, float f_o, int qb) {
    constexpr bool NEEDV = MODE != 0;
    const int tid = threadIdx.x, wid = __builtin_amdgcn_readfirstlane(tid >> 6), lane = tid & 63, r32 = lane & 31, hi = lane >> 5;
    float* al_l = (float*)(lds + L_WS) + wid * 64 + 32;
    const int sr = tid >> 4, sc = (tid & 15) * 8, vst0 = v_st(sr, sc), vst1 = v_st(32 + sr, sc), kws = KSWZ(sr, sc * 2);
    const int vbase = (int)(uintptr_t)(lds + L_KV + 16384) + v_rd_base(lane);
    const int qloc = wid * 8 + (r32 >> 2);
    bf16x8 sk0, sk1, sv0, sv1;
#define NSA_GLOAD(j) do { const bf16_t* kp_ = Kg + (size_t)((j) * KVBLK + sr) * D + sc; sk0 = *(const bf16x8*)kp_; sk1 = *(const bf16x8*)(kp_ + 32 * D); \
        if (NEEDV) { const bf16_t* vp_ = Vg + (size_t)((j) * KVBLK + sr) * D + sc; sv0 = *(const bf16x8*)vp_; sv1 = *(const bf16x8*)(vp_ + 32 * D); } } while (0)
#define NSA_SWRITE(b) do { char* kl_ = lds + L_KV + (b) * 32768; *(bf16x8*)(kl_ + kws) = sk0; *(bf16x8*)(kl_ + kws + 32 * 256) = sk1; \
        if (NEEDV) { *(bf16x8*)(kl_ + 16384 + vst0) = sv0; *(bf16x8*)(kl_ + 16384 + vst1) = sv1; } } while (0)
    if (j_lo >= j_hi) return;
    NSA_GLOAD(j_lo); NSA_SWRITE(0);
    __syncthreads();
    for (int j = j_lo; j < j_hi; ++j) {
        const int cur = (j - j_lo) & 1;
        if (j + 1 < j_hi) NSA_GLOAD(j + 1);
        const char* K_lds = lds + L_KV + cur * 32768;
        const int kb = j * KVBLK;
        bool rowsel = true, act = true;
        if (KIND == 2) { const unsigned wsel = ((const unsigned*)(lds + L_SELM))[qloc * 4 + (j >> 5)]; rowsel = ((wsel >> (j & 31)) & 1u) != 0u; act = __any(rowsel); }
        if (act) {
            f32x16 p0, p1;
            qkt(p0, p1, K_lds, r32, hi, qr);
            if (KIND == 2) {
                if (j == qb) mask_tile(p0, p1, pos - kb - 4 * hi, W);
                if (!rowsel) { const float NEG = -__builtin_inff();
#pragma unroll
                    for (int r = 0; r < 16; ++r) { p0[r] = NEG; p1[r] = NEG; } }
            } else if (KIND == 0) { if (j == qb || j + 8 == qb) mask_tile(p0, p1, pos - kb - 4 * hi, W); }
            else { if (kb + 63 > 4 * qb - 2) mask_tile(p0, p1, pos - kb - 4 * hi, W); }
            if (MODE == 0) {
                const float pmax = rowmax32(p0, p1), mn = fmaxf(m_reg, pmax), alpha = __builtin_amdgcn_exp2f((m_reg - mn) * C2), mnL = -mn * C2;
#pragma unroll
                for (int r = 0; r < 16; ++r) { p0[r] = __builtin_amdgcn_exp2f(fmaf(p0[r], C2, mnL)); p1[r] = __builtin_amdgcn_exp2f(fmaf(p1[r], C2, mnL)); }
                l_reg = l_reg * alpha + rowsum32(p0, p1); m_reg = mn;
            } else {
                if (MODE == 1) {
                    const float mnL = -m_reg * C2;
#pragma unroll
                    for (int r = 0; r < 16; ++r) { p0[r] = __builtin_amdgcn_exp2f(fmaf(p0[r], C2, mnL)); p1[r] = __builtin_amdgcn_exp2f(fmaf(p1[r], C2, mnL)); }
                    float* imp = (float*)(lds + L_IMP) + qloc * 128 + (kb >> 2);
#pragma unroll
                    for (int half = 0; half < 2; ++half)
#pragma unroll
                        for (int i = 0; i < 4; ++i) {
                            const f32x16& P = half ? p1 : p0;
                            float G = ((P[4 * i] + P[4 * i + 1]) + (P[4 * i + 2] + P[4 * i + 3])) * f_imp, L = P[4 * i + 3] * f_imp;
                            G += __shfl_xor(G, 1); G += __shfl_xor(G, 2); L += __shfl_xor(L, 1); L += __shfl_xor(L, 2);
                            const int jl = half * 8 + 2 * i + hi;
                            if ((r32 & 3) == 0) { atomicAdd(imp + jl, G); if ((kb >> 2) + jl + 1 < 128) atomicAdd(imp + jl + 1, L); }
                        }
#pragma unroll
                    for (int r = 0; r < 16; ++r) { p0[r] *= f_o; p1[r] *= f_o; }
                } else {
                    const float pmax = rowmax32(p0, p1); float mn, alpha;
                    if (__all((pmax - m_reg) * SCALE <= THR)) { mn = m_reg; alpha = 1.f; }
                    else { mn = fmaxf(m_reg, pmax); alpha = __builtin_amdgcn_exp2f((m_reg - mn) * C2); m_reg = mn; }
                    const float mnL = -mn * C2;
#pragma unroll
                    for (int r = 0; r < 16; ++r) { p0[r] = __builtin_amdgcn_exp2f(fmaf(p0[r], C2, mnL)); p1[r] = __builtin_amdgcn_exp2f(fmaf(p1[r], C2, mnL)); }
                    l_reg = l_reg * alpha + rowsum32(p0, p1);
                    if (__any(alpha < 1.f)) { asm volatile("s_waitcnt lgkmcnt(0)" ::: "memory"); if (hi == 0) al_l[r32] = alpha; asm volatile("s_waitcnt lgkmcnt(0)" ::: "memory");
#pragma unroll
                        for (int r = 0; r < 16; ++r) { const float a = al_l[crow(r, hi)];
#pragma unroll
                            for (int d_ = 0; d_ < 4; ++d_) o[d_][r] *= a; }
                        asm volatile("s_waitcnt lgkmcnt(0)" ::: "memory"); }
                }
                bf16x8 pa0, pa1, pa2, pa3;
                packP(p0, p1, pa0, pa1, pa2, pa3);
                pv_tile(o, vbase + cur * 32768, pa0, pa1, pa2, pa3);
            }
        }
        if (j + 1 < j_hi) NSA_SWRITE(cur ^ 1);
        __syncthreads();
    }
#undef NSA_GLOAD
#undef NSA_SWRITE
}
template <int STEP>
__device__ __forceinline__ void fold(const f32x16* o, float f, char* lds, int wid, int r32, int hi, bf16_t* orow0  , bool do_store) {
    float* li_l = (float*)(lds + L_WS) + wid * 64;
    unsigned* park = (unsigned*)(lds + L_PARK + wid * 8192);
    asm volatile("s_waitcnt lgkmcnt(0)" ::: "memory");
    if (hi == 0) li_l[r32] = f;
    asm volatile("s_waitcnt lgkmcnt(0)" ::: "memory");
#pragma unroll
    for (int r = 0; r < 16; ++r) { const int wrow = crow(r, hi); const float a = li_l[wrow];
#pragma unroll
        for (int d0 = 0; d0 < 4; ++d0) { float v = o[d0][r] * a, vn = __shfl_xor(v, 1);
            if ((r32 & 1) == 0) { const int idx = wrow * 64 + d0 * 16 + (r32 >> 1);
                if (STEP > 0) { const unsigned u = park[idx]; v += __builtin_bit_cast(float, u << 16); vn += __builtin_bit_cast(float, u & 0xffff0000u); }
                if (STEP < 2) park[idx] = cvtpk(v, vn);
                else if (do_store) *(unsigned*)(orow0 + (size_t)(wid * 8 + (wrow >> 2)) * 2048 + (wrow & 3) * 128 + d0 * 32 + r32) = cvtpk(v, vn); } } }
    asm volatile("s_waitcnt lgkmcnt(0)" ::: "memory");
}

__device__ __forceinline__ float bf2f(bf16_t v) { return __builtin_bit_cast(float, (unsigned)v << 16); }
__device__ __forceinline__ float sigm(float x) { return __builtin_amdgcn_rcpf(1.f + __builtin_amdgcn_exp2f(-1.4426950408889634f * x)); }

__device__ __forceinline__ void nsa_unit(int b, int g, int qb, const bf16_t* Q, const bf16_t* KV4, const bf16_t* KCMP, const bf16_t* VCMP, const bf16_t* NSAG, bf16_t* OUT, char* lds, bool do_store) {
    const int tid = threadIdx.x, wid = __builtin_amdgcn_readfirstlane(tid >> 6), lane = tid & 63, r32 = lane & 31, hi = lane >> 5;
    const int ql = wid * 8 + (r32 >> 2), h = r32 & 3, t = qb * 64 + ql;
    const size_t row = (size_t)b * SEQ + t;
    bf16x8 qr[8];
    { const bf16_t* qp = Q + row * 2048 + g * 512 + h * 128 + hi * 8;
#pragma unroll
      for (int d0 = 0; d0 < 8; ++d0) qr[d0] = *(const bf16x8*)(qp + d0 * 16); }
    { f32x4* z = (f32x4*)((float*)(lds + L_IMP) + wid * 8 * 128) + lane;
#pragma unroll
      for (int i = 0; i < 4; ++i) z[64 * i] = (f32x4){0.f, 0.f, 0.f, 0.f}; }
    const float gc = sigm(bf2f(NSAG[row * 256 + 0 * 16 + g * 4 + h])), gs = sigm(bf2f(NSAG[row * 256 + 1 * 16 + g * 4 + h])), gw = sigm(bf2f(NSAG[row * 256 + 2 * 16 + g * 4 + h]));
    const int bg = b * 4 + g;
    const size_t TSTR = (size_t)8 * SEQ * D;
    f32x16 o[4];
#pragma unroll
    for (int d_ = 0; d_ < 4; ++d_) o[d_] = f32x16{};
    {
        const bf16_t* kc = KCMP + (size_t)bg * 512 * D; const bf16_t* vc = VCMP + (size_t)bg * 512 * D;
        const int nmax = (t - 31) >> 4, jh = (4 * qb + 3 + 63) >> 6;
        float m1 = -1e30f, l1 = 0.f;
        attend<0, 1>(kc, vc, 0, jh, nmax, 0x7fffffffu, lds, qr, m1, l1, o, 0.f, 0.f, qb);
        const float inv_l = l1 > 0.f ? 1.f / l1 : 0.f;
        attend<1, 1>(kc, vc, 0, jh, nmax, 0x7fffffffu, lds, qr, m1, l1, o, inv_l, gc * inv_l, qb);
    }
    {
        asm volatile("s_waitcnt lgkmcnt(0)" ::: "memory");
        unsigned* SELM = (unsigned*)(lds + L_SELM);
        const unsigned* IMPu = (const unsigned*)(lds + L_IMP);
        if (qb >= 16) {
            for (int i = 0; i < 8; ++i) {
                const int q = wid * 8 + i;
                const unsigned vlo = IMPu[q * 128 + lane], vhi = IMPu[q * 128 + 64 + lane];
                const bool clo = (lane >= 1) && (lane <= qb - 2), chi = (64 + lane <= qb - 2);
                unsigned T = 0u;
                for (int bit = 30; bit >= 0; --bit) { const unsigned c = T | (1u << bit);
                    const int cnt = __popcll(__ballot(clo && vlo >= c)) + __popcll(__ballot(chi && vhi >= c));
                    if (cnt >= 13) T = c; }
                unsigned long long sel_lo = __ballot(clo && vlo > T), sel_hi = __ballot(chi && vhi > T);
                unsigned long long eq_lo = __ballot(clo && vlo == T), eq_hi = __ballot(chi && vhi == T);
                int need = 13 - __popcll(sel_lo) - __popcll(sel_hi);
                for (; need > 0; --need) {
                    if (eq_lo) { const unsigned long long lb = eq_lo & (0ull - eq_lo); sel_lo |= lb; eq_lo ^= lb; }
                    else if (eq_hi) { const unsigned long long lb = eq_hi & (0ull - eq_hi); sel_hi |= lb; eq_hi ^= lb; }
                }
                sel_lo |= 1ull;
                if (qb - 1 < 64) sel_lo |= 1ull << (qb - 1); else sel_hi |= 1ull << (qb - 1 - 64);
                if (qb < 64) sel_lo |= 1ull << qb; else sel_hi |= 1ull << (qb - 64);
                if (lane == 0) { SELM[q * 4 + 0] = (unsigned)sel_lo; SELM[q * 4 + 1] = (unsigned)(sel_lo >> 32); SELM[q * 4 + 2] = (unsigned)sel_hi; SELM[q * 4 + 3] = (unsigned)(sel_hi >> 32); }
            }
        } else {
            if (lane < 8) { const int q = wid * 8 + lane; SELM[q * 4 + 0] = (2u << qb) - 1u; SELM[q * 4 + 1] = 0u; SELM[q * 4 + 2] = 0u; SELM[q * 4 + 3] = 0u; }
        }
        asm volatile("s_waitcnt lgkmcnt(0)" ::: "memory");
    }
    __syncthreads();
    fold<0>(o, 1.f, lds, wid, r32, hi, nullptr, false);
    {
        const bf16_t* ks = KV4 + 0 * TSTR + (size_t)bg * SEQ * D; const bf16_t* vs = KV4 + 1 * TSTR + (size_t)bg * SEQ * D;
#pragma unroll
        for (int d_ = 0; d_ < 4; ++d_) o[d_] = f32x16{};
        float m = -1e30f, l = 0.f;
        attend<2, 2>(ks, vs, 0, qb + 1, t, 0x7fffffffu, lds, qr, m, l, o, 0.f, 0.f, qb);
        fold<1>(o, l > 0.f ? gs / l : 0.f, lds, wid, r32, hi, nullptr, false);
    }
    {
        const bf16_t* kw = KV4 + 2 * TSTR + (size_t)bg * SEQ * D; const bf16_t* vw = KV4 + 3 * TSTR + (size_t)bg * SEQ * D;
#pragma unroll
        for (int d_ = 0; d_ < 4; ++d_) o[d_] = f32x16{};
        float m = -1e30f, l = 0.f;
        attend<2, 0>(kw, vw, qb >= 8 ? qb - 8 : 0, qb + 1, t, 512u, lds, qr, m, l, o, 0.f, 0.f, qb);
        fold<2>(o, l > 0.f ? gw / l : 0.f, lds, wid, r32, hi, OUT + ((size_t)b * SEQ + qb * 64) * 2048 + g * 512, do_store);
    }
    __syncthreads();
}
#undef KSWZ
#undef SBAR
}
constexpr int NWAVES = 8;
constexpr int SEQ = 8192, M = 2 * SEQ, DM = 2048, FF = 5632, INW_SRC = 10288, INW = 10496, PW = 1024;
constexpr float RMS_EPS = 1e-6f;
constexpr size_t MiB = 1u << 20;
constexpr size_t WS_WIN = 0, WS_WPU = 42 * MiB, WS_WNU = 46 * MiB, WS_WOUT = 54 * MiB, WS_POOLW = 62 * MiB, WS_CW1 = 63 * MiB, WS_CW2 = 67 * MiB;
constexpr size_t WS_PEBP = 68 * MiB, WS_PEB = 68 * MiB + 512 * 1024, WS_HIDC = 69 * MiB, WS_KVCMP = 73 * MiB;
constexpr size_t WS_WGU = 76 * MiB, WS_WD = 120 * MiB, WS_GNSA = 76 * MiB;
constexpr size_t WS_XN = 142 * MiB, WS_POOLED = 142 * MiB, WS_APOOL = 174 * MiB;
constexpr size_t WS_HID = 206 * MiB, WS_XP = 206 * MiB, WS_Q = 238 * MiB, WS_NSAG = 302 * MiB, WS_KV4 = 310 * MiB;
constexpr size_t WS_GPOOL = 382 * MiB, WS_KCVC = 446 * MiB, WS_END = 480 * MiB;
static_assert(WS_WIN + (size_t)INW * DM * 2 <= WS_WPU && WS_WGU + (size_t)2 * FF * DM * 2 <= WS_WD && WS_WD + (size_t)DM * FF * 2 <= WS_XN && WS_GNSA + (size_t)M * DM * 2 <= WS_XN, "ws map 1");
static_assert(WS_HID + (size_t)M * FF * 2 <= WS_GPOOL && WS_KV4 + (size_t)4 * M * 512 * 2 <= WS_GPOOL && WS_NSAG + (size_t)M * 256 * 2 <= WS_KV4 && WS_KCVC + (size_t)2 * M * 512 * 2 + 8192 <= WS_END, "ws map 2");
constexpr int LDS_BYTES = 147456;
#define GAS __attribute__((address_space(1)))
#define LAS __attribute__((address_space(3)))
typedef unsigned short bf16;
typedef unsigned v4u __attribute__((ext_vector_type(4)));
typedef float f32x4 __attribute__((ext_vector_type(4)));
#define LDS_WAIT() asm volatile("s_waitcnt lgkmcnt(0)" ::: "memory")
__device__ __forceinline__ unsigned f2bf(float f) { unsigned u = __builtin_bit_cast(unsigned, f); return (u + 0x7fffu + ((u >> 16) & 1u)) >> 16; }
__device__ __forceinline__ unsigned pk2(float lo, float hi) { return f2bf(lo) | (f2bf(hi) << 16); }
__device__ __forceinline__ float wave_sum(float v) {
#pragma unroll
    for (int o = 1; o < 64; o <<= 1) v += __shfl_xor(v, o);
    return v;
}
__device__ __forceinline__ void transpose_item(const float* W, int K, int N, int c0, int nvalid, bf16* WT, int drow, int k0, LAS float* scr, int lane) {
    const bool cv = (lane & 31) < nvalid;
#pragma unroll
    for (int i = 0; i < 32; ++i) { const int kk = 2 * i + (lane >> 5); scr[kk * 33 + (lane & 31)] = cv ? W[(size_t)(k0 + kk) * N + c0 + (lane & 31)] : 0.f; }
    LDS_WAIT(); asm volatile("" ::: "memory");
    const int c = lane & 7;
#pragma unroll
    for (int j = 0; j < 4; ++j) { const int n = (lane >> 3) + 8 * j; const LAS float* s = scr + (8 * c) * 33 + n;
        v4u o; o.x = pk2(s[0 * 33], s[1 * 33]); o.y = pk2(s[2 * 33], s[3 * 33]); o.z = pk2(s[4 * 33], s[5 * 33]); o.w = pk2(s[6 * 33], s[7 * 33]);
        if (n < nvalid) *(v4u*)(WT + (size_t)(drow + n) * K + k0 + 8 * c) = o; }
    LDS_WAIT(); asm volatile("" ::: "memory");
}
__device__ __forceinline__ void transpose_seg(const float* W, int K, int N, int src0, int ncols, bf16* WT, int drow0, bool gu, LAS float* scr, int lane, int gw, int NGW, int& base) {
    const int nblk = (ncols + 31) >> 5, nitems = (K >> 6) * nblk;
    int first = (gw - base) % NGW; if (first < 0) first += NGW;
    for (int it = first; it < nitems; it += NGW) {
        const int kb = it / nblk, nb = it - kb * nblk, c0 = nb * 32, nv = (ncols - c0) < 32 ? (ncols - c0) : 32;
        const int drow = gu ? (256 * (c0 >> 7) + (c0 & 127) + drow0) : (drow0 + c0);
        transpose_item(W, K, N, src0 + c0, nv, WT, drow, kb * 64, scr, lane);
    }
    base = (base + nitems) % NGW;
}
__device__ __forceinline__ void rms_row_bf16(const float* xrow, const float* g, bf16* orow, int lane) {
    const f32x4* xr = (const f32x4*)xrow + lane; const f32x4* gr = (const f32x4*)g + lane;
    f32x4 v[8]; float s = 0.f;
#pragma unroll
    for (int j = 0; j < 8; ++j) { v[j] = xr[64 * j]; s += (v[j].x * v[j].x + v[j].y * v[j].y) + (v[j].z * v[j].z + v[j].w * v[j].w); }
    const float rs = 1.f / sqrtf(wave_sum(s) * (1.f / DM) + RMS_EPS);
    unsigned long long* o8 = (unsigned long long*)orow + lane;
#pragma unroll
    for (int j = 0; j < 8; ++j) { const f32x4 gg = gr[64 * j];
        o8[64 * j] = (unsigned long long)pk2(v[j].x * rs * gg.x, v[j].y * rs * gg.y) | ((unsigned long long)pk2(v[j].z * rs * gg.z, v[j].w * rs * gg.w) << 32); }
}
__device__ __forceinline__ void rms_row_f32(float* xrow, const float* g, int lane) {
    f32x4* xr = (f32x4*)xrow + lane; const f32x4* gr = (const f32x4*)g + lane;
    f32x4 v[8]; float s = 0.f;
#pragma unroll
    for (int j = 0; j < 8; ++j) { v[j] = xr[64 * j]; s += (v[j].x * v[j].x + v[j].y * v[j].y) + (v[j].z * v[j].z + v[j].w * v[j].w); }
    const float rs = 1.f / sqrtf(wave_sum(s) * (1.f / DM) + RMS_EPS);
#pragma unroll
    for (int j = 0; j < 8; ++j) { const f32x4 gg = gr[64 * j]; xr[64 * j] = (f32x4){v[j].x * rs * gg.x, v[j].y * rs * gg.y, v[j].z * rs * gg.z, v[j].w * rs * gg.w}; }
}
using pg8::u32x4;
struct FWin {
    bf16 *XP, *Q, *KCVC, *KV4, *GPOOL, *GNSA, *NSAG;
    __device__ __forceinline__ void operator()(int row, int col, int pn, pg8::f32x4 v0, pg8::f32x4 v1) const {
        const u32x4 w = pg8::pack8(v0, v1); bf16* dst;
        if (pn < 4) dst = XP + (size_t)row * 1024 + col;
        else if (pn < 12) dst = Q + (size_t)row * 2048 + (col - 1024);
        else if (pn < 24) { const int c = col - 3072, tensor = c >> 9, g = (c >> 7) & 3, d = c & 127, b = row >> 13, t = row & 8191;
            dst = (tensor < 2 ? KCVC + (size_t)tensor * 8 * SEQ * 128 : KV4 + (size_t)(tensor - 2) * 8 * SEQ * 128) + ((size_t)(b * 4 + g) * SEQ + t) * 128 + d; }
        else if (pn < 32) dst = GPOOL + (size_t)row * 2048 + (col - 6144);
        else if (pn < 40) dst = GNSA + (size_t)row * 2048 + (col - 8192);
        else dst = NSAG + (size_t)row * 256 + (col - 10240);
        *(u32x4*)dst = w;
    }
};
struct FSiluBias { bf16* O; const float* bias;
    __device__ __forceinline__ void operator()(int row, int col, int pn, pg8::f32x4 v0, pg8::f32x4 v1) const {
        const float* bp = bias + ((row >> 12) << 8) + col; const pg8::f32x4 b0 = *(const pg8::f32x4*)bp, b1 = *(const pg8::f32x4*)(bp + 4);
#pragma unroll
        for (int j = 0; j < 4; ++j) { v0[j] = pg8::siluf_(v0[j] + b0[j]); v1[j] = pg8::siluf_(v1[j] + b1[j]); }
        *(u32x4*)(O + (size_t)row * 256 + col) = pg8::pack8(v0, v1);
    }
};
struct FStore128 { bf16* O;
    __device__ __forceinline__ void operator()(int row, int col, int pn, pg8::f32x4 v0, pg8::f32x4 v1) const {
        if (col < 128) *(u32x4*)(O + (size_t)row * 128 + col) = pg8::pack8(v0, v1);
    }
};
struct FPool { bf16* O; const float* scale;
    __device__ __forceinline__ void operator()(int row, int col, int pn, pg8::f32x4 v0, pg8::f32x4 v1) const {
        const pg8::f32x4 s0 = *(const pg8::f32x4*)(scale + col), s1 = *(const pg8::f32x4*)(scale + col + 4);
        *(u32x4*)(O + (size_t)row * PW + col) = pg8::pack8(v0 * s0, v1 * s1);
    }
};
struct FGate { bf16* MG; const bf16* Gt; bool add;
    __device__ __forceinline__ void operator()(int row, int col, int pn, pg8::f32x4 v0, pg8::f32x4 v1) const {
        const size_t off = (size_t)row * DM + col;
        const u32x4 gw = *(const u32x4*)(Gt + off);
        pg8::f32x4 r0, r1;
        r0[0] = pg8::sigmoidf_(pg8::bf_lo(gw.x)) * v0[0]; r0[1] = pg8::sigmoidf_(pg8::bf_hi(gw.x)) * v0[1]; r0[2] = pg8::sigmoidf_(pg8::bf_lo(gw.y)) * v0[2]; r0[3] = pg8::sigmoidf_(pg8::bf_hi(gw.y)) * v0[3];
        r1[0] = pg8::sigmoidf_(pg8::bf_lo(gw.z)) * v1[0]; r1[1] = pg8::sigmoidf_(pg8::bf_hi(gw.z)) * v1[1]; r1[2] = pg8::sigmoidf_(pg8::bf_lo(gw.w)) * v1[2]; r1[3] = pg8::sigmoidf_(pg8::bf_hi(gw.w)) * v1[3];
        if (add) { const u32x4 mw = *(const u32x4*)(MG + off);
            r0[0] += pg8::bf_lo(mw.x); r0[1] += pg8::bf_hi(mw.x); r0[2] += pg8::bf_lo(mw.y); r0[3] += pg8::bf_hi(mw.y);
            r1[0] += pg8::bf_lo(mw.z); r1[1] += pg8::bf_hi(mw.z); r1[2] += pg8::bf_lo(mw.w); r1[3] += pg8::bf_hi(mw.w); }
        *(u32x4*)(MG + off) = pg8::pack8(r0, r1);
    }
};

struct Args { const float* in[23]; float* out; unsigned char* ws; int ph_lo, ph_hi; };
enum { I_X = 0, I_F1N, I_F1G, I_F1U, I_F1D, I_MIXN, I_WIN, I_POOLW, I_POOLS, I_PEK, I_PEV, I_CKW1, I_CKW2, I_CVW1, I_CVW2, I_WPU, I_WNU, I_WOUT, I_F2N, I_F2G, I_F2U, I_F2D, I_FINN };
constexpr int N_PHASES = 14;

template <class Epi> __device__ __forceinline__ void run_gemm(LAS unsigned char* lds, const bf16* A, int lda, const bf16* Bt, int ldb, int Mr, int N, int K, int G, int c, const Epi& E, int apn = 0, int bdiv = 1 << 30, int bbytes = 0) {
    pg8::Gemm g{A, Bt, Mr, N, K, lda, ldb, apn, bdiv, bbytes}; pg8::StaticOrder S; S.init(Mr, N, G, c);
    pg8::gemm_phase<Epi, pg8::StaticOrder, true, true>(lds, g, S, E);
    __syncthreads();
}

__global__ void __launch_bounds__(NWAVES * 64, 2) mk_fwd(Args a) {
    extern __shared__ __attribute__((aligned(16))) unsigned char lds_raw[];
    LAS unsigned char* lds = (LAS unsigned char*)lds_raw;
    const int tid = threadIdx.x, lane = tid & 63, wave = __builtin_amdgcn_readfirstlane(tid >> 6);
    const int G = gridDim.x, bx = blockIdx.x;
    const int vcu = (G % 8 == 0) ? (bx % 8) * (G / 8) + bx / 8 : bx;
    const int gw = vcu * NWAVES + wave, NGW = G * NWAVES;
    unsigned char* ws = a.ws;
    bf16* Win_t = (bf16*)(ws + WS_WIN); bf16* Wpu_t = (bf16*)(ws + WS_WPU); bf16* Wnu_t = (bf16*)(ws + WS_WNU); bf16* Wout_t = (bf16*)(ws + WS_WOUT);
    bf16* Poolw_t = (bf16*)(ws + WS_POOLW); bf16* Cw1_t = (bf16*)(ws + WS_CW1); bf16* Cw2_t = (bf16*)(ws + WS_CW2);
    float* PEBP = (float*)(ws + WS_PEBP); float* PEB = (float*)(ws + WS_PEB);
    bf16* HIDC = (bf16*)(ws + WS_HIDC); bf16* KVCMP = (bf16*)(ws + WS_KVCMP);
    bf16* Wgu_t = (bf16*)(ws + WS_WGU); bf16* Wd_t = (bf16*)(ws + WS_WD); bf16* GNSA = (bf16*)(ws + WS_GNSA);
    bf16* XN = (bf16*)(ws + WS_XN); bf16* POOLED = (bf16*)(ws + WS_POOLED); bf16* APOOL = (bf16*)(ws + WS_APOOL);
    bf16* HID = (bf16*)(ws + WS_HID); bf16* XP = (bf16*)(ws + WS_XP); bf16* Q = (bf16*)(ws + WS_Q); bf16* KV4 = (bf16*)(ws + WS_KV4); bf16* KCVC = (bf16*)(ws + WS_KCVC); bf16* NSAG = (bf16*)(ws + WS_NSAG);
    bf16* GPOOL = (bf16*)(ws + WS_GPOOL);
    float* H = a.out;
    const int lo = a.ph_lo, hi = a.ph_hi;
#ifndef MK_PHASE_MASK
#define MK_PHASE_MASK 0x3fff
#endif
#define IN(k) (((MK_PHASE_MASK >> (k)) & 1) && lo <= (k) && (k) < hi)
#ifndef MK_REP_MASK
#define MK_REP_MASK 0
#endif
#define REP(k) ((MK_REP_MASK >> (k)) & 1)
#define SEAM(k) do { if (IN(k) && IN((k) + 1)) { __syncthreads(); cg::this_grid().sync(); } } while (0)
    LAS float* scr = (LAS float*)(lds + wave * 16384);

    if (IN(0)) for (int rep = 0; rep <= REP(0); ++rep) {
        int base = 0;
        transpose_seg(a.in[I_F1G], DM, FF, 0, FF, Wgu_t, 0, true, scr, lane, gw, NGW, base);
        transpose_seg(a.in[I_F1U], DM, FF, 0, FF, Wgu_t, 128, true, scr, lane, gw, NGW, base);
        transpose_seg(a.in[I_F1D], FF, DM, 0, DM, Wd_t, 0, false, scr, lane, gw, NGW, base);
        transpose_seg(a.in[I_WIN], DM, INW_SRC, 0, 6144, Win_t, 0, false, scr, lane, gw, NGW, base);
        transpose_seg(a.in[I_WIN], DM, INW_SRC, 6192, 2048, Win_t, 6144, false, scr, lane, gw, NGW, base);
        transpose_seg(a.in[I_WIN], DM, INW_SRC, 8240, 2048, Win_t, 8192, false, scr, lane, gw, NGW, base);
        transpose_seg(a.in[I_WIN], DM, INW_SRC, 6144, 48, Win_t, 10240, false, scr, lane, gw, NGW, base);
        transpose_seg(a.in[I_WPU], PW, DM, 0, DM, Wpu_t, 0, false, scr, lane, gw, NGW, base);
        transpose_seg(a.in[I_WNU], DM, DM, 0, DM, Wnu_t, 0, false, scr, lane, gw, NGW, base);
        transpose_seg(a.in[I_WOUT], DM, DM, 0, DM, Wout_t, 0, false, scr, lane, gw, NGW, base);
        for (int gi = 0; gi < 4; ++gi) transpose_seg(a.in[I_POOLW] + (size_t)gi * 65536, 256, 256, 0, 256, Poolw_t + (size_t)gi * 65536, 0, false, scr, lane, gw, NGW, base);
        transpose_seg(a.in[I_CKW1], 4096, 256, 0, 256, Cw1_t, 0, false, scr, lane, gw, NGW, base);
        transpose_seg(a.in[I_CVW1], 4096, 256, 0, 256, Cw1_t + (size_t)256 * 4096, 0, false, scr, lane, gw, NGW, base);
        transpose_seg(a.in[I_CKW2], 256, 128, 0, 128, Cw2_t, 0, false, scr, lane, gw, NGW, base);
        transpose_seg(a.in[I_CVW2], 256, 128, 0, 128, Cw2_t + 65536, 0, false, scr, lane, gw, NGW, base);
        for (int m = gw; m < M; m += NGW) rms_row_bf16(a.in[I_X] + (size_t)m * DM, a.in[I_F1N], XN + (size_t)m * DM, lane);
        for (int task = gw; task < 256; task += NGW) {
            const int tensor = task >> 7, chunk = (task >> 2) & 31, col = (task & 3) * 64 + lane;
            const float* pe = a.in[tensor ? I_PEV : I_PEK] + chunk * 128; const float* w1 = a.in[tensor ? I_CVW1 : I_CKW1] + (size_t)chunk * 128 * 256 + col;
            float acc = 0.f;
#pragma unroll 8
            for (int k = 0; k < 128; ++k) acc += pe[k] * w1[(size_t)k * 256];
            PEBP[(tensor * 32 + chunk) * 256 + col] = acc;
        }
    }
    SEAM(0);
    if (IN(1)) for (int rep = 0; rep <= REP(1); ++rep) { pg8::EpiSwiglu E{HID, FF}; run_gemm(lds, XN, DM, Wgu_t, DM, M, 2 * FF, DM, G, bx, E); }
    SEAM(1);
    if (IN(2)) for (int rep = 0; rep <= REP(2); ++rep) { pg8::EpiResF32 E{a.in[I_X], H, DM, 0.5f}; run_gemm(lds, HID, FF, Wd_t, FF, M, DM, FF, G, bx, E); }
    SEAM(2);
    if (IN(3)) for (int rep = 0; rep <= REP(3); ++rep) {
        for (int m = gw; m < M; m += NGW) rms_row_bf16(H + (size_t)m * DM, a.in[I_MIXN], XN + (size_t)m * DM, lane);
        if (bx == 0) { float s = 0.f; for (int c = 0; c < 32; ++c) s += PEBP[((tid >> 8) * 32 + c) * 256 + (tid & 255)]; PEB[tid] = s; }
    }
    SEAM(3);
    if (IN(4)) for (int rep = 0; rep <= REP(4); ++rep) { pg8::EpiP8<FWin> E{FWin{XP, Q, KCVC, KV4, GPOOL, GNSA, NSAG}}; run_gemm(lds, XN, DM, Win_t, DM, M, INW, DM, G, bx, E); }
    SEAM(4);
    if (IN(5)) for (int rep = 0; rep <= REP(5); ++rep) {
        { pg8::EpiP8<FSiluBias> E{FSiluBias{HIDC, PEB}}; run_gemm(lds, KCVC, 2048, Cw1_t, 4096, 8192, 256, 4096, G, bx, E, 0, 16, 256 * 4096 * 2); }
        const int nthr = G * NWAVES * 64;
        for (int idx = vcu * 512 + tid; idx < M * 128; idx += nthr) {
            const int row = idx >> 7, c8 = (idx & 127) * 8, win = 2 << (c8 >> 8), t = row & (SEQ - 1), n = (t + 1) < win ? (t + 1) : win;
            float acc[8] = {0.f, 0.f, 0.f, 0.f, 0.f, 0.f, 0.f, 0.f}, x0[8];
            for (int j = 0; j < n; ++j) { const v4u w = *(const v4u*)(XP + (size_t)(row - j) * PW + c8);
                const float f[8] = {pg8::bf_lo(w.x), pg8::bf_hi(w.x), pg8::bf_lo(w.y), pg8::bf_hi(w.y), pg8::bf_lo(w.z), pg8::bf_hi(w.z), pg8::bf_lo(w.w), pg8::bf_hi(w.w)};
#pragma unroll
                for (int e = 0; e < 8; ++e) { acc[e] += f[e]; if (j == 0) x0[e] = f[e]; } }
            const float inv = 1.f / (float)n;
            v4u o; o.x = pk2(acc[0] * inv - x0[0], acc[1] * inv - x0[1]); o.y = pk2(acc[2] * inv - x0[2], acc[3] * inv - x0[3]);
            o.z = pk2(acc[4] * inv - x0[4], acc[5] * inv - x0[5]); o.w = pk2(acc[6] * inv - x0[6], acc[7] * inv - x0[7]);
            *(v4u*)(POOLED + (size_t)row * PW + c8) = o;
        }
    }
    SEAM(5);
    if (IN(6)) for (int rep = 0; rep <= REP(6); ++rep) {
        { pg8::EpiP8<FPool> E{FPool{APOOL, a.in[I_POOLS]}}; run_gemm(lds, POOLED, PW, Poolw_t, 256, M, PW, 256, G, bx, E, 256 * 2); }
        { pg8::EpiP8<FStore128> E{FStore128{KVCMP}}; run_gemm(lds, HIDC, 256, Cw2_t, 256, 8192, 256, 256, G, bx, E, 0, 16, 65536 * 2); }
    }
    SEAM(6);
    if (IN(7)) {
        { pg8::EpiP8<FGate> E{FGate{GPOOL, GPOOL, false}}; run_gemm(lds, APOOL, PW, Wpu_t, PW, M, DM, PW, G, bx, E); }
        for (int rep = REP(7) ? 0 : 1; rep < 2; ++rep)
        for (int it = vcu; it < 1024; it += G) {
            const int c = it & 255, k = it >> 8, bg = c >> 5, i = c & 31;
            const int qb = (k == 0) ? i : (k == 1) ? 63 - i : (k == 2) ? 64 + i : 127 - i;
            nsa::nsa_unit(bg >> 2, bg & 3, qb, Q, KV4, KVCMP, KVCMP + (size_t)4096 * 128, NSAG, Q, (char*)lds_raw, rep == 1 || a.ph_lo != 0);
        }
    }
    SEAM(7);
    if (IN(8)) { pg8::EpiP8<FGate> E{FGate{GPOOL, GNSA, true}}; run_gemm(lds, Q, DM, Wnu_t, DM, M, DM, DM, G, bx, E); }
    SEAM(8);
    if (IN(9)) { pg8::EpiResF32 E{H, H, DM, 1.0f}; run_gemm(lds, GPOOL, DM, Wout_t, DM, M, DM, DM, G, bx, E); }
    SEAM(9);
    if (IN(10)) for (int rep = 0; rep <= REP(10); ++rep) {
        int base = 0;
        transpose_seg(a.in[I_F2G], DM, FF, 0, FF, Wgu_t, 0, true, scr, lane, gw, NGW, base);
        transpose_seg(a.in[I_F2U], DM, FF, 0, FF, Wgu_t, 128, true, scr, lane, gw, NGW, base);
        transpose_seg(a.in[I_F2D], FF, DM, 0, DM, Wd_t, 0, false, scr, lane, gw, NGW, base);
        for (int m = gw; m < M; m += NGW) rms_row_bf16(H + (size_t)m * DM, a.in[I_F2N], XN + (size_t)m * DM, lane);
    }
    SEAM(10);
    if (IN(11)) for (int rep = 0; rep <= REP(11); ++rep) { pg8::EpiSwiglu E{HID, FF}; run_gemm(lds, XN, DM, Wgu_t, DM, M, 2 * FF, DM, G, bx, E); }
    SEAM(11);
    if (IN(12)) { pg8::EpiResF32 E{H, H, DM, 0.5f}; run_gemm(lds, HID, FF, Wd_t, FF, M, DM, FF, G, bx, E); }
    SEAM(12);
    if (IN(13)) { for (int m = gw; m < M; m += NGW) rms_row_f32(H + (size_t)m * DM, a.in[I_FINN], lane); }
#undef IN
#undef SEAM
}

#ifndef MK_ONE_LAUNCH
#define MK_ONE_LAUNCH 1
#endif
extern "C" void kernel_launch(void* const* d_in, const int* in_sizes, int n_in, void* d_out, int out_size, void* d_ws, size_t ws_size, hipStream_t stream) {
    static int grid = 0;
    if (grid == 0) {
        if (n_in != 23 || out_size != M * DM || ws_size < WS_END) { fprintf(stderr, "kernel_launch: unexpected shapes (n_in %d out %d ws %zu)\n", n_in, out_size, ws_size); grid = -1; return; }
        int dev = 0, cus = 0, per_cu = 0;
        (void)hipGetDevice(&dev); (void)hipDeviceGetAttribute(&cus, hipDeviceAttributeMultiprocessorCount, dev);
        if (hipFuncSetAttribute((const void*)mk_fwd, hipFuncAttributeMaxDynamicSharedMemorySize, LDS_BYTES) != hipSuccess) { fprintf(stderr, "kernel_launch: hipFuncSetAttribute failed\n"); grid = -1; return; }
        if (hipOccupancyMaxActiveBlocksPerMultiprocessor(&per_cu, (const void*)mk_fwd, NWAVES * 64, LDS_BYTES) != hipSuccess || per_cu < 1) { fprintf(stderr, "kernel_launch: occupancy query says %d\n", per_cu); per_cu = 1; }
        (void)hipGetLastError();
        grid = cus > 0 ? cus : 256;
    }
    if (grid < 0) return;
    Args a{};
    for (int i = 0; i < 23; ++i) a.in[i] = (const float*)d_in[i];
    a.out = (float*)d_out; a.ws = (unsigned char*)d_ws;
#if MK_ONE_LAUNCH
    a.ph_lo = 0; a.ph_hi = N_PHASES;
    void* args[] = {&a};
    hipError_t e = hipLaunchCooperativeKernel((const void*)mk_fwd, dim3(grid), dim3(NWAVES * 64), args, LDS_BYTES, stream);
    if (e != hipSuccess) fprintf(stderr, "kernel_launch: cooperative launch failed: %s (grid %d)\n", hipGetErrorString(e), grid);
#else
    for (int p = 0; p < N_PHASES; ++p) { a.ph_lo = p; a.ph_hi = p + 1; hipLaunchKernelGGL(mk_fwd, dim3(grid), dim3(NWAVES * 64), LDS_BYTES, stream, a); }
#endif
}
```

```cpp
#include <hip/hip_runtime.h>
#include <hip/hip_cooperative_groups.h>
#include <cstdio>
#include <cstdint>
namespace cg = cooperative_groups;
namespace pg8 {
#define PG8_LAS __attribute__((address_space(3)))
typedef unsigned short bf16_t;
typedef short bf16x8 __attribute__((ext_vector_type(8)));
typedef float f32x4 __attribute__((ext_vector_type(4)));
typedef unsigned u32x4 __attribute__((ext_vector_type(4)));
constexpr int BM = 256, BK = 64, HALF = 128, HTB = HALF * BK * 2  , STAGE_BYTES = 8 * HTB, NXCD = 8, WGM = 8;

__host__ __device__ __forceinline__ int lds_byte(int r, int c) { const int st = (r >> 4) * 2 + (c >> 5), rr = r & 15, cc = c & 31, ob = rr * 64 + cc * 2; return st * 1024 + (ob ^ (((ob >> 9) & 1) << 5)); }
__host__ __device__ __forceinline__ void stage_rc(int b, int& R, int& C) { const int st = b / 1024, sb = b % 1024, swz = sb ^ (((sb >> 9) & 1) << 5); R = (st >> 1) * 16 + swz / 64; C = (st & 1) * 32 + (swz % 64) / 2; }
__host__ __device__ __forceinline__ int perm32(int rho) { const int n = rho >> 4, i = rho & 15; return 8 * (i >> 2) + 4 * n + (i & 3); }

struct Unit { int pm, pn; };
struct Gemm { const bf16_t* A; const bf16_t* Bt; int M, N, K, lda, ldb; int apn  , bdiv, bbytes  ; };

struct StaticOrder {
    int nM, nN, nwg, G, c;
    __host__ __device__ void init(int M, int N, int G_, int c_) { nM = M / BM; nN = N / BM; nwg = nM * nN; G = G_; c = c_; }
    __host__ __device__ bool next(int i, Unit& u) const {
        const long L = (long)i * G + c; if (L >= nwg) return false;
        int wgid = (int)L; { const int q = nwg / NXCD, r = nwg % NXCD, xcd = wgid % NXCD, off = wgid / NXCD; wgid = (xcd < r ? xcd * (q + 1) : r * (q + 1) + (xcd - r) * q) + off; }
        const int nig = WGM * nN, gid = wgid / nig, fm = gid * WGM, gsz = (nM - fm) < WGM ? (nM - fm) : WGM;
        u.pm = fm + ((wgid % nig) % gsz); u.pn = (wgid % nig) / gsz; return true;
    }
    __device__ __forceinline__ void a_ready(const Unit&) const {}
    __device__ __forceinline__ void done(const Unit&) const {}
};

__device__ __forceinline__ unsigned cvt_pk_bf16(float lo, float hi) { unsigned r; asm volatile("v_cvt_pk_bf16_f32 %0, %1, %2" : "=v"(r) : "v"(lo), "v"(hi)); return r; }
__device__ __forceinline__ float bf_lo(unsigned w) { return __builtin_bit_cast(float, w << 16); }
__device__ __forceinline__ float bf_hi(unsigned w) { return __builtin_bit_cast(float, w & 0xffff0000u); }
__device__ __forceinline__ float sigmoidf_(float x) { return __builtin_amdgcn_rcpf(1.f + __builtin_amdgcn_exp2f(-1.4426950408889634f * x)); }
__device__ __forceinline__ float siluf_(float x) { return x * sigmoidf_(x); }
__device__ __forceinline__ u32x4 pack8(f32x4 a, f32x4 b) { u32x4 w; w.x = cvt_pk_bf16(a[0], a[1]); w.y = cvt_pk_bf16(a[2], a[3]); w.z = cvt_pk_bf16(b[0], b[1]); w.w = cvt_pk_bf16(b[2], b[3]); return w; }

template <class F> struct EpiP8 {
    static constexpr bool PERM = true, AFTER_DRAIN = false;
    F f; const float* ss;
    __device__ __forceinline__ void operator()(const f32x4 (&acc)[2][2][4][2], const Unit& u, int wr, int wc, int fr, int fq) const {
        const int row0 = u.pm * BM + wr * 64 + fr, col0 = u.pn * BM + wc * 32 + 8 * fq;
#pragma unroll
        for (int ai = 0; ai < 2; ++ai)
#pragma unroll
            for (int m = 0; m < 4; ++m) {
                const int row = row0 + ai * HALF + m * 16;
                const float rs = ss ? __builtin_amdgcn_rsqf(ss[row] * (1.f / 2048.f) + 1e-6f) : 1.f;
#pragma unroll
                for (int bj = 0; bj < 2; ++bj) f(row, col0 + bj * HALF, u.pn, acc[ai][bj][m][0] * rs, acc[ai][bj][m][1] * rs);
            }
    }
};
struct EpiSwiglu {
    static constexpr bool PERM = true, AFTER_DRAIN = false;
    bf16_t* O; int ldc; const float* ss;
    __device__ __forceinline__ void operator()(const f32x4 (&acc)[2][2][4][2], const Unit& u, int wr, int wc, int fr, int fq) const {
        const int row0 = u.pm * BM + wr * 64 + fr, col0 = u.pn * HALF + wc * 32 + 8 * fq;
#pragma unroll
        for (int ai = 0; ai < 2; ++ai)
#pragma unroll
            for (int m = 0; m < 4; ++m) {
                const int row = row0 + ai * HALF + m * 16;
                const float rs = __builtin_amdgcn_rsqf(ss[row] * (1.f / 2048.f) + 1e-6f);
                f32x4 h0, h1;
#pragma unroll
                for (int j = 0; j < 4; ++j) { h0[j] = siluf_(acc[ai][0][m][0][j] * rs) * (acc[ai][1][m][0][j] * rs); h1[j] = siluf_(acc[ai][0][m][1][j] * rs) * (acc[ai][1][m][1][j] * rs); }
                *(u32x4*)(O + (size_t)row * ldc + col0) = pack8(h0, h1);
            }
    }
};
struct EpiResF32 {
    static constexpr bool PERM = false, AFTER_DRAIN = false;
    const float* base; float* out; int ldc; float coef;
    __device__ __forceinline__ void operator()(const f32x4 (&acc)[2][2][4][2], const Unit& u, int wr, int wc, int fr, int fq) const {
        const int row0 = u.pm * BM + wr * 64 + fr, col0 = u.pn * BM + wc * 32 + 4 * fq;
#pragma unroll
        for (int ai = 0; ai < 2; ++ai)
#pragma unroll
            for (int m = 0; m < 4; ++m) {
                const size_t off = (size_t)(row0 + ai * HALF + m * 16) * ldc + col0;
#pragma unroll
                for (int bj = 0; bj < 2; ++bj)
#pragma unroll
                    for (int n = 0; n < 2; ++n) { const f32x4 b = *(const f32x4*)(base + off + bj * HALF + n * 16); *(f32x4*)(out + off + bj * HALF + n * 16) = b + acc[ai][bj][m][n] * coef; }
            }
    }
};
struct EpiResNorm {
    static constexpr bool PERM = false, AFTER_DRAIN = false;
    const float* base; float* out; bf16_t* xn; const float* gain; float* ss; int ldc; float coef;
    __device__ __forceinline__ void operator()(const f32x4 (&acc)[2][2][4][2], const Unit& u, int wr, int wc, int fr, int fq) const {
        const int row0 = u.pm * BM + wr * 64 + fr, col0 = u.pn * BM + wc * 32 + 4 * fq;
        f32x4 gg[2][2];
#pragma unroll
        for (int bj = 0; bj < 2; ++bj)
#pragma unroll
            for (int n = 0; n < 2; ++n) gg[bj][n] = *(const f32x4*)(gain + col0 + bj * HALF + n * 16);
#pragma unroll
        for (int ai = 0; ai < 2; ++ai)
#pragma unroll
            for (int m = 0; m < 4; ++m) {
                const int row = row0 + ai * HALF + m * 16; const size_t off = (size_t)row * ldc + col0; float s = 0.f;
#pragma unroll
                for (int bj = 0; bj < 2; ++bj)
#pragma unroll
                    for (int n = 0; n < 2; ++n) { const f32x4 h = *(const f32x4*)(base + off + bj * HALF + n * 16) + acc[ai][bj][m][n] * coef;
                        *(f32x4*)(out + off + bj * HALF + n * 16) = h; s += (h[0] * h[0] + h[1] * h[1]) + (h[2] * h[2] + h[3] * h[3]);
                        const f32x4 y = h * gg[bj][n]; typedef unsigned u32x2 __attribute__((ext_vector_type(2))); u32x2 w; w.x = cvt_pk_bf16(y[0], y[1]); w.y = cvt_pk_bf16(y[2], y[3]);
                        *(u32x2*)(xn + off + bj * HALF + n * 16) = w; }
                s += __shfl_xor(s, 16); s += __shfl_xor(s, 32);
                if (fq == 0) atomicAdd(ss + row, s);
            }
    }
};
template <class Epi, class Sched, bool ALIGN_EPI = false, bool SP2 = false>
__device__ __forceinline__ void gemm_phase(PG8_LAS unsigned char* lds, const Gemm g, const Sched& S, const Epi& E) {
    const int tid = threadIdx.x, wid = __builtin_amdgcn_readfirstlane(tid >> 6), lane = tid & 63, wr = wid >> 2, wc = wid & 3, fr = lane & 15, fq = lane >> 4;
    const int K = g.K, nt = K / BK;
    unsigned voffA[2], voffB[2];
#pragma unroll
    for (int i = 0; i < 2; ++i) { int R, C; stage_rc(tid * 16 + i * 8192, R, C); const int Rb = Epi::PERM ? ((R & ~31) + perm32(R & 31)) : R;
        voffA[i] = (unsigned)(R * g.lda + C) * 2u; voffB[i] = (unsigned)(Rb * g.ldb + C) * 2u; }
    const size_t kstep = (size_t)(BK * 2);
    const size_t hstepA = (size_t)HALF * g.lda * 2, hstepB = (size_t)HALF * g.ldb * 2;
    const size_t tstepA = 2 * hstepA, tstepB = 2 * hstepB;
    const unsigned ldsw = (unsigned)wid * 1024u;
    const int aoff = lds_byte(wr * 64 + fr, fq * 8), boff = lds_byte(wc * 32 + fr, fq * 8);
#define PG8_SA(b, h) (((b) * 2 + (h)) * HTB)
#define PG8_SB(b, h) ((4 + (b) * 2 + (h)) * HTB)
#define PG8_STAGE(bufoff, gbase, voff) do { _Pragma("unroll") for (int _i = 0; _i < 2; ++_i) \
        __builtin_amdgcn_global_load_lds((const unsigned*)((const char*)(gbase) + (voff)[_i]), (PG8_LAS unsigned*)(lds + (bufoff) + ldsw + _i * 8192), 16, 0, 0); } while (0)
#define PG8_LDA(dst, b, h) do { _Pragma("unroll") for (int m = 0; m < 4; ++m) _Pragma("unroll") for (int k = 0; k < 2; ++k) dst[m][k] = *(const PG8_LAS bf16x8*)(lds + PG8_SA(b, h) + aoff + m * 2048 + k * 1024); } while (0)
#define PG8_LDB(dst, b, h) do { _Pragma("unroll") for (int n = 0; n < 2; ++n) _Pragma("unroll") for (int k = 0; k < 2; ++k) dst[n][k] = *(const PG8_LAS bf16x8*)(lds + PG8_SB(b, h) + boff + n * 2048 + k * 1024); } while (0)
#define PG8_MMA(ai, bj, At, Bt) do { __builtin_amdgcn_s_setprio(1); _Pragma("unroll") for (int m = 0; m < 4; ++m) _Pragma("unroll") for (int n = 0; n < 2; ++n) _Pragma("unroll") for (int k = 0; k < 2; ++k) \
        acc[ai][bj][m][n] = __builtin_amdgcn_mfma_f32_16x16x32_bf16(Bt[n][k], At[m][k], acc[ai][bj][m][n], 0, 0, 0); __builtin_amdgcn_s_setprio(0); } while (0)
#define PG8_WAIT_V(n) asm volatile("s_waitcnt vmcnt(" #n ")" ::: "memory")
#define PG8_WAIT_L(n) asm volatile("s_waitcnt lgkmcnt(" #n ")" ::: "memory")
#define PG8_BAR __builtin_amdgcn_s_barrier()
#define PG8_SCHED __builtin_amdgcn_sched_barrier(0)
    Unit cur, nxt; int ui = 0;
    if (!S.next(0, cur)) return;
    f32x4 acc[2][2][4][2];
#pragma unroll
    for (int a = 0; a < 2; ++a)
#pragma unroll
        for (int b = 0; b < 2; ++b)
#pragma unroll
            for (int m = 0; m < 4; ++m)
#pragma unroll
                for (int n = 0; n < 2; ++n) acc[a][b][m][n] = (f32x4){0.f, 0.f, 0.f, 0.f};
    bf16x8 At[4][2], B0[2][2], B1[2][2];
    const char* cA = (const char*)g.A + (size_t)cur.pm * tstepA + (size_t)cur.pn * g.apn; const char* cB = (const char*)g.Bt + (size_t)cur.pn * tstepB + (size_t)(cur.pm / g.bdiv) * g.bbytes;
    S.a_ready(cur);
    if constexpr (SP2) {
        PG8_STAGE(PG8_SB(0, 0), cB, voffB); PG8_STAGE(PG8_SB(0, 1), cB + hstepB, voffB); PG8_STAGE(PG8_SA(0, 0), cA, voffA); PG8_STAGE(PG8_SA(0, 1), cA + hstepA, voffA);
        if (wr == 1) PG8_BAR;
        PG8_WAIT_V(2); PG8_BAR;
        PG8_STAGE(PG8_SB(1, 0), cB + kstep, voffB); PG8_STAGE(PG8_SA(1, 0), cA + kstep, voffA); PG8_STAGE(PG8_SB(1, 1), cB + hstepB + kstep, voffB);
        PG8_WAIT_V(6); PG8_BAR;
    } else {
        PG8_STAGE(PG8_SB(0, 0), cB, voffB); PG8_STAGE(PG8_SA(0, 0), cA, voffA); PG8_STAGE(PG8_SB(0, 1), cB + hstepB, voffB); PG8_STAGE(PG8_SA(0, 1), cA + hstepA, voffA);
        if (wr == 1) PG8_BAR;
        PG8_WAIT_V(4); PG8_BAR;
        PG8_STAGE(PG8_SB(1, 0), cB + kstep, voffB); PG8_STAGE(PG8_SA(1, 0), cA + kstep, voffA); PG8_STAGE(PG8_SB(1, 1), cB + hstepB + kstep, voffB);
        PG8_WAIT_V(6); PG8_BAR;
    }
    for (;;) {
        const bool has_next = S.next(ui + 1, nxt);
        const char* nA = has_next ? (const char*)g.A + (size_t)nxt.pm * tstepA + (size_t)nxt.pn * g.apn : cA; const char* nB = has_next ? (const char*)g.Bt + (size_t)nxt.pn * tstepB + (size_t)(nxt.pm / g.bdiv) * g.bbytes : cB;
#pragma nounroll
        for (int t = 0; t < nt; t += 2) {
            const bool last = (t == nt - 2);
            const char* a1 = cA + (size_t)(t + 1) * kstep;
            const char* a2 = last ? nA : cA + (size_t)(t + 2) * kstep; const char* b2 = last ? nB : cB + (size_t)(t + 2) * kstep;
            const char* a3 = a2 + kstep; const char* b3 = b2 + kstep;
            if (last && has_next) S.a_ready(nxt);
            if constexpr (SP2) {
            PG8_LDB(B0, 0, 0); PG8_LDB(B1, 0, 1); PG8_SCHED; PG8_LDA(At, 0, 0); PG8_STAGE(PG8_SA(1, 1), a1 + hstepA, voffA);
            PG8_WAIT_V(8); PG8_WAIT_L(0); PG8_BAR; PG8_MMA(0, 0, At, B0); PG8_MMA(0, 1, At, B1); PG8_BAR; PG8_SCHED;
            PG8_LDA(At, 0, 1); PG8_STAGE(PG8_SB(0, 0), b2, voffB); PG8_STAGE(PG8_SB(0, 1), b2 + hstepB, voffB); PG8_STAGE(PG8_SA(0, 0), a2, voffA);
            PG8_WAIT_V(8); PG8_WAIT_L(0); PG8_BAR; PG8_MMA(1, 0, At, B0); PG8_MMA(1, 1, At, B1); PG8_BAR; PG8_SCHED;
            PG8_LDB(B0, 1, 0); PG8_LDB(B1, 1, 1); PG8_SCHED; PG8_LDA(At, 1, 0); PG8_STAGE(PG8_SA(0, 1), a2 + hstepA, voffA);
            PG8_WAIT_V(8); PG8_WAIT_L(0); PG8_BAR; PG8_MMA(0, 0, At, B0); PG8_MMA(0, 1, At, B1); PG8_BAR; PG8_SCHED;
            PG8_LDA(At, 1, 1); PG8_STAGE(PG8_SB(1, 0), b3, voffB); PG8_STAGE(PG8_SB(1, 1), b3 + hstepB, voffB); PG8_STAGE(PG8_SA(1, 0), a3, voffA);
            PG8_WAIT_V(8); PG8_WAIT_L(0); PG8_BAR; PG8_MMA(1, 0, At, B0); PG8_MMA(1, 1, At, B1); PG8_BAR; PG8_SCHED;
            } else {
            PG8_LDB(B0, 0, 0); PG8_SCHED; PG8_LDA(At, 0, 0); PG8_STAGE(PG8_SA(1, 1), a1 + hstepA, voffA);
            PG8_WAIT_L(8); PG8_BAR; PG8_WAIT_L(0); PG8_MMA(0, 0, At, B0); PG8_BAR; PG8_SCHED;
            PG8_LDB(B1, 0, 1); PG8_STAGE(PG8_SB(0, 0), b2, voffB);
            PG8_BAR; PG8_WAIT_L(0); PG8_MMA(0, 1, At, B1); PG8_BAR;
            PG8_LDA(At, 0, 1); PG8_STAGE(PG8_SA(0, 0), a2, voffA);
            PG8_BAR; PG8_WAIT_L(0); PG8_MMA(1, 0, At, B0); PG8_BAR; PG8_SCHED;
            PG8_STAGE(PG8_SB(0, 1), b2 + hstepB, voffB);
            PG8_WAIT_V(6); PG8_BAR; PG8_MMA(1, 1, At, B1); PG8_BAR;
            PG8_LDB(B0, 1, 0); PG8_SCHED; PG8_LDA(At, 1, 0); PG8_STAGE(PG8_SA(0, 1), a2 + hstepA, voffA);
            PG8_WAIT_L(8); PG8_BAR; PG8_WAIT_L(0); PG8_MMA(0, 0, At, B0); PG8_BAR; PG8_SCHED;
            PG8_LDB(B1, 1, 1); PG8_STAGE(PG8_SB(1, 0), b3, voffB);
            PG8_BAR; PG8_WAIT_L(0); PG8_MMA(0, 1, At, B1); PG8_BAR;
            PG8_LDA(At, 1, 1); PG8_STAGE(PG8_SA(1, 0), a3, voffA);
            PG8_BAR; PG8_WAIT_L(0); PG8_MMA(1, 0, At, B0); PG8_BAR; PG8_SCHED;
            PG8_STAGE(PG8_SB(1, 1), b3 + hstepB, voffB);
            PG8_WAIT_V(6); PG8_BAR; PG8_MMA(1, 1, At, B1); PG8_BAR;
            }
        }
        if constexpr (ALIGN_EPI) { if (wr == 0) PG8_BAR; }
        if constexpr (!Epi::AFTER_DRAIN) { E(acc, cur, wr, wc, fr, fq); S.done(cur); }
        if (!has_next) break;
#pragma unroll
        for (int a = 0; a < 2; ++a)
#pragma unroll
            for (int b = 0; b < 2; ++b)
#pragma unroll
                for (int m = 0; m < 4; ++m)
#pragma unroll
                    for (int n = 0; n < 2; ++n) acc[a][b][m][n] = (f32x4){0.f, 0.f, 0.f, 0.f};
        cur = nxt; cA = nA; cB = nB; ++ui;
        if constexpr (ALIGN_EPI) { if (wr == 1) PG8_BAR; }
    }
    PG8_WAIT_V(0);
    if constexpr (!ALIGN_EPI) { if (wr == 0) PG8_BAR; }
    PG8_BAR;
    if constexpr (Epi::AFTER_DRAIN) { E.fused(acc, cur, wr, wc, fr, fq, lds, wid, lane); S.done(cur); }
#undef PG8_SA
#undef PG8_SB
#undef PG8_STAGE
#undef PG8_LDA
#undef PG8_LDB
#undef PG8_MMA
#undef PG8_WAIT_V
#undef PG8_WAIT_L
#undef PG8_BAR
#undef PG8_SCHED
}
}
namespace nsa {
typedef unsigned short bf16_t;
typedef short bf16x8 __attribute__((ext_vector_type(8)));
typedef short s16x4 __attribute__((ext_vector_type(4)));
typedef float f32x16 __attribute__((ext_vector_type(16)));
typedef float f32x4 __attribute__((ext_vector_type(4)));
typedef unsigned u32x4 __attribute__((ext_vector_type(4)));
constexpr int D = 128, KVBLK = 64, SHM_K = 16384, SHM_V = 16384, SEQ = 8192;
constexpr float SCALE = 0.08838834764831845f, C2 = 1.4426950408889634f * SCALE, THR = 8.f;
constexpr int L_KV = 0  , L_WS = 65536, L_SELM = 67584, L_PARK = 69632  , L_IMP = L_PARK  , L_END = L_PARK + 65536;
#define KSWZ(row, colB) ((row) * 256 + ((colB) ^ (((row) & 7) << 4)))
#define SBAR() __builtin_amdgcn_sched_barrier(0)
__device__ __forceinline__ int v_st(int k, int c) { const int kk = (k & ~0xC) | ((k & 4) << 1) | ((k & 8) >> 1); return ((kk >> 3) * 4 + (c >> 5)) * 512 + ((kk & 7) * 32 + (c & 31)) * 2; }
__device__ __forceinline__ int v_rd_base(int lane) { return ((lane & 3) << 3) | (((lane >> 2) & 3) << 6) | (((lane >> 4) & 1) << 5) | (((lane >> 5) & 1) << 8); }
constexpr int v_rd_off(int d0, int ks, int half) { return d0 * 512 + ks * 4096 + half * 2048; }
__device__ __forceinline__ int crow(int r, int hi) { return (r & 3) + 8 * (r >> 2) + 4 * hi; }
__device__ __forceinline__ unsigned cvtpk(float lo, float hi) { unsigned r; asm volatile("v_cvt_pk_bf16_f32 %0, %1, %2" : "=v"(r) : "v"(lo), "v"(hi)); return r; }
__device__ __forceinline__ void mask_tile(f32x16& p0, f32x16& p1, int dq, unsigned W) {
    const float NEG = -__builtin_inff();
#pragma unroll
    for (int r = 0; r < 16; ++r) {
        const int c = (r & 3) + 8 * (r >> 2);
        if ((unsigned)(dq - c) >= W) p0[r] = NEG;
        if ((unsigned)(dq - c - 32) >= W) p1[r] = NEG;
    }
}
__device__ __forceinline__ float rowmax32(const f32x16& p0, const f32x16& p1) {
    float pmax = p0[0];
#pragma unroll
    for (int r = 1; r < 16; ++r) pmax = fmaxf(pmax, p0[r]);
#pragma unroll
    for (int r = 0; r < 16; ++r) pmax = fmaxf(pmax, p1[r]);
    auto rr = __builtin_amdgcn_permlane32_swap(__float_as_uint(pmax), __float_as_uint(pmax), false, false);
    return fmaxf(__uint_as_float(rr[0]), __uint_as_float(rr[1]));
}
__device__ __forceinline__ float rowsum32(const f32x16& p0, const f32x16& p1) {
    float ps = 0.f;
#pragma unroll
    for (int r = 0; r < 16; ++r) ps += p0[r];
#pragma unroll
    for (int r = 0; r < 16; ++r) ps += p1[r];
    auto rr = __builtin_amdgcn_permlane32_swap(__float_as_uint(ps), __float_as_uint(ps), false, false);
    return __uint_as_float(rr[0]) + __uint_as_float(rr[1]);
}
__device__ __forceinline__ void packP(const f32x16& p0, const f32x16& p1, bf16x8& pa0, bf16x8& pa1, bf16x8& pa2, bf16x8& pa3) {
#define PK4(P, B_, OUT) do { unsigned a0 = cvtpk(P[B_+0], P[B_+1]), a1 = cvtpk(P[B_+2], P[B_+3]);                          \
        unsigned b0 = cvtpk(P[B_+4], P[B_+5]), b1 = cvtpk(P[B_+6], P[B_+7]);                                             \
        auto r0 = __builtin_amdgcn_permlane32_swap(a0, b0, false, false); auto r1 = __builtin_amdgcn_permlane32_swap(a1, b1, false, false); \
        u32x4 w = {r0[0], r1[0], r0[1], r1[1]}; OUT = *reinterpret_cast<bf16x8*>(&w); } while (0)
    PK4(p0, 0, pa0); PK4(p0, 8, pa1); PK4(p1, 0, pa2); PK4(p1, 8, pa3);
#undef PK4
}
__device__ __forceinline__ void qkt(f32x16& p0, f32x16& p1, const char* K_lds, int r32, int hi, const bf16x8* qr) {
    p0 = f32x16{}; p1 = f32x16{};
    const char* kb[4];
#pragma unroll
    for (int dd = 0; dd < 4; ++dd) kb[dd] = K_lds + KSWZ(r32, (dd * 16 + hi * 8) * 2);
#pragma unroll
    for (int d0 = 0; d0 < 8; ++d0) { const char* a = kb[d0 & 3] + (d0 >> 2) * 128;
        bf16x8 b0 = *reinterpret_cast<const bf16x8*>(a);
        bf16x8 b1 = *reinterpret_cast<const bf16x8*>(a + 32 * 256);
        p0 = __builtin_amdgcn_mfma_f32_32x32x16_bf16(b0, qr[d0], p0, 0, 0, 0);
        p1 = __builtin_amdgcn_mfma_f32_32x32x16_bf16(b1, qr[d0], p1, 0, 0, 0); }
}
__device__ __forceinline__ void pv_tile(f32x16* o, int vb0, bf16x8 pa0, bf16x8 pa1, bf16x8 pa2, bf16x8 pa3) {
#define TRRD(dst, off) asm volatile("ds_read_b64_tr_b16 %0, %1 offset:%2" : "=&v"(dst) : "v"(vb0), "i"(off) : "memory")
#define PV_D0(d0) do { s16x4 l0, l1, l2, l3, h0, h1, h2, h3; constexpr int b_ = v_rd_off(d0, 0, 0); \
        TRRD(l0, b_); TRRD(h0, b_ + 2048); TRRD(l1, b_ + 4096); TRRD(h1, b_ + 6144); TRRD(l2, b_ + 8192); TRRD(h2, b_ + 10240); TRRD(l3, b_ + 12288); TRRD(h3, b_ + 14336); \
        asm volatile("s_waitcnt lgkmcnt(0)" ::: "memory"); SBAR();   \
        o[d0] = __builtin_amdgcn_mfma_f32_32x32x16_bf16(pa0, (bf16x8){l0[0], l0[1], l0[2], l0[3], h0[0], h0[1], h0[2], h0[3]}, o[d0], 0, 0, 0);   \
        o[d0] = __builtin_amdgcn_mfma_f32_32x32x16_bf16(pa1, (bf16x8){l1[0], l1[1], l1[2], l1[3], h1[0], h1[1], h1[2], h1[3]}, o[d0], 0, 0, 0);   \
        o[d0] = __builtin_amdgcn_mfma_f32_32x32x16_bf16(pa2, (bf16x8){l2[0], l2[1], l2[2], l2[3], h2[0], h2[1], h2[2], h2[3]}, o[d0], 0, 0, 0);   \
        o[d0] = __builtin_amdgcn_mfma_f32_32x32x16_bf16(pa3, (bf16x8){l3[0], l3[1], l3[2], l3[3], h3[0], h3[1], h3[2], h3[3]}, o[d0], 0, 0, 0); } while (0)
    PV_D0(0); PV_D0(1); PV_D0(2); PV_D0(3);
#undef PV_D0
#undef TRRD
}

template <int MODE, int KIND>
__device__ __forceinline__ void attend(const bf16_t* __restrict__ Kg, const bf16_t* __restrict__ Vg, int j_lo, int j_hi, int pos, unsigned W,
                                       char* lds, const bf16x8* qr, float& m_reg, float& l_reg, f32x16* o, float f_imp, float f_o, int qb) {
    constexpr bool NEEDV = MODE != 0;
    const int tid = threadIdx.x, wid = __builtin_amdgcn_readfirstlane(tid >> 6), lane = tid & 63, r32 = lane & 31, hi = lane >> 5;
    float* al_l = (float*)(lds + L_WS) + wid * 64 + 32;
    const int sr = tid >> 4, sc = (tid & 15) * 8, vst0 = v_st(sr, sc), vst1 = v_st(32 + sr, sc), kws = KSWZ(sr, sc * 2);
    const int vbase = (int)(uintptr_t)(lds + L_KV + 16384) + v_rd_base(lane);
    const int qloc = wid * 8 + (r32 >> 2);
    bf16x8 sk0, sk1, sv0, sv1;
#define NSA_GLOAD(j) do { const bf16_t* kp_ = Kg + (size_t)((j) * KVBLK + sr) * D + sc; sk0 = *(const bf16x8*)kp_; sk1 = *(const bf16x8*)(kp_ + 32 * D); \
        if (NEEDV) { const bf16_t* vp_ = Vg + (size_t)((j) * KVBLK + sr) * D + sc; sv0 = *(const bf16x8*)vp_; sv1 = *(const bf16x8*)(vp_ + 32 * D); } } while (0)
#define NSA_SWRITE(b) do { char* kl_ = lds + L_KV + (b) * 32768; *(bf16x8*)(kl_ + kws) = sk0; *(bf16x8*)(kl_ + kws + 32 * 256) = sk1; \
        if (NEEDV) { *(bf16x8*)(kl_ + 16384 + vst0) = sv0; *(bf16x8*)(kl_ + 16384 + vst1) = sv1; } } while (0)
    if (j_lo >= j_hi) return;
    NSA_GLOAD(j_lo); NSA_SWRITE(0);
    __syncthreads();
    for (int j = j_lo; j < j_hi; ++j) {
        const int cur = (j - j_lo) & 1;
        if (j + 1 < j_hi) NSA_GLOAD(j + 1);
        const char* K_lds = lds + L_KV + cur * 32768;
        const int kb = j * KVBLK;
        bool rowsel = true, act = true;
        if (KIND == 2) { const unsigned wsel = ((const unsigned*)(lds + L_SELM))[qloc * 4 + (j >> 5)]; rowsel = ((wsel >> (j & 31)) & 1u) != 0u; act = __any(rowsel); }
        if (act) {
            f32x16 p0, p1;
            qkt(p0, p1, K_lds, r32, hi, qr);
            if (KIND == 2) {
                if (j == qb) mask_tile(p0, p1, pos - kb - 4 * hi, W);
                if (!rowsel) { const float NEG = -__builtin_inff();
#pragma unroll
                    for (int r = 0; r < 16; ++r) { p0[r] = NEG; p1[r] = NEG; } }
            } else if (KIND == 0) { if (j == qb || j + 8 == qb) mask_tile(p0, p1, pos - kb - 4 * hi, W); }
            else { if (kb + 63 > 4 * qb - 2) mask_tile(p0, p1, pos - kb - 4 * hi, W); }
            if (MODE == 0) {
                const float pmax = rowmax32(p0, p1), mn = fmaxf(m_reg, pmax), alpha = __builtin_amdgcn_exp2f((m_reg - mn) * C2), mnL = -mn * C2;
#pragma unroll
                for (int r = 0; r < 16; ++r) { p0[r] = __builtin_amdgcn_exp2f(fmaf(p0[r], C2, mnL)); p1[r] = __builtin_amdgcn_exp2f(fmaf(p1[r], C2, mnL)); }
                l_reg = l_reg * alpha + rowsum32(p0, p1); m_reg = mn;
            } else {
                if (MODE == 1) {
                    const float mnL = -m_reg * C2;
#pragma unroll
                    for (int r = 0; r < 16; ++r) { p0[r] = __builtin_amdgcn_exp2f(fmaf(p0[r], C2, mnL)); p1[r] = __builtin_amdgcn_exp2f(fmaf(p1[r], C2, mnL)); }
                    float* imp = (float*)(lds + L_IMP) + qloc * 128 + (kb >> 2);
#pragma unroll
                    for (int half = 0; half < 2; ++half)
#pragma unroll
                        for (int i = 0; i < 4; ++i) {
                            const f32x16& P = half ? p1 : p0;
                            float G = ((P[4 * i] + P[4 * i + 1]) + (P[4 * i + 2] + P[4 * i + 3])) * f_imp, L = P[4 * i + 3] * f_imp;
                            G += __shfl_xor(G, 1); G += __shfl_xor(G, 2); L += __shfl_xor(L, 1); L += __shfl_xor(L, 2);
                            const int jl = half * 8 + 2 * i + hi;
                            if ((r32 & 3) == 0) { atomicAdd(imp + jl, G); if ((kb >> 2) + jl + 1 < 128) atomicAdd(imp + jl + 1, L); }
                        }
#pragma unroll
                    for (int r = 0; r < 16; ++r) { p0[r] *= f_o; p1[r] *= f_o; }
                } else {
                    const float pmax = rowmax32(p0, p1); float mn, alpha;
                    if (__all((pmax - m_reg) * SCALE <= THR)) { mn = m_reg; alpha = 1.f; }
                    else { mn = fmaxf(m_reg, pmax); alpha = __builtin_amdgcn_exp2f((m_reg - mn) * C2); m_reg = mn; }
                    const float mnL = -mn * C2;
#pragma unroll
                    for (int r = 0; r < 16; ++r) { p0[r] = __builtin_amdgcn_exp2f(fmaf(p0[r], C2, mnL)); p1[r] = __builtin_amdgcn_exp2f(fmaf(p1[r], C2, mnL)); }
                    l_reg = l_reg * alpha + rowsum32(p0, p1);
                    if (__any(alpha < 1.f)) { asm volatile("s_waitcnt lgkmcnt(0)" ::: "memory"); if (hi == 0) al_l[r32] = alpha; asm volatile("s_waitcnt lgkmcnt(0)" ::: "memory");
#pragma unroll
                        for (int r = 0; r < 16; ++r) { const float a = al_l[crow(r, hi)];
#pragma unroll
                            for (int d_ = 0; d_ < 4; ++d_) o[d_][r] *= a; }
                        asm volatile("s_waitcnt lgkmcnt(0)" ::: "memory"); }
                }
                bf16x8 pa0, pa1, pa2, pa3;
                packP(p0, p1, pa0, pa1, pa2, pa3);
                pv_tile(o, vbase + cur * 32768, pa0, pa1, pa2, pa3);
            }
        }
        if (j + 1 < j_hi) NSA_SWRITE(cur ^ 1);
        __syncthreads();
    }
#undef NSA_GLOAD
#undef NSA_SWRITE
}
template <int STEP>
__device__ __forceinline__ void fold(const f32x16* o, float f, char* lds, int wid, int r32, int hi, bf16_t* orow0  , bool do_store) {
    float* li_l = (float*)(lds + L_WS) + wid * 64;
    unsigned* park = (unsigned*)(lds + L_PARK + wid * 8192);
    asm volatile("s_waitcnt lgkmcnt(0)" ::: "memory");
    if (hi == 0) li_l[r32] = f;
    asm volatile("s_waitcnt lgkmcnt(0)" ::: "memory");
#pragma unroll
    for (int r = 0; r < 16; ++r) { const int wrow = crow(r, hi); const float a = li_l[wrow];
#pragma unroll
        for (int d0 = 0; d0 < 4; ++d0) { float v = o[d0][r] * a, vn = __shfl_xor(v, 1);
            if ((r32 & 1) == 0) { const int idx = wrow * 64 + d0 * 16 + (r32 >> 1);
                if (STEP > 0) { const unsigned u = park[idx]; v += __builtin_bit_cast(float, u << 16); vn += __builtin_bit_cast(float, u & 0xffff0000u); }
                if (STEP < 2) park[idx] = cvtpk(v, vn);
                else if (do_store) *(unsigned*)(orow0 + (size_t)(wid * 8 + (wrow >> 2)) * 2048 + (wrow & 3) * 128 + d0 * 32 + r32) = cvtpk(v, vn); } } }
    asm volatile("s_waitcnt lgkmcnt(0)" ::: "memory");
}

__device__ __forceinline__ float bf2f(bf16_t v) { return __builtin_bit_cast(float, (unsigned)v << 16); }
__device__ __forceinline__ float sigm(float x) { return __builtin_amdgcn_rcpf(1.f + __builtin_amdgcn_exp2f(-1.4426950408889634f * x)); }

__device__ __forceinline__ void nsa_unit(int b, int g, int qb, const bf16_t* Q, const bf16_t* KV4, const bf16_t* KCMP, const bf16_t* VCMP, const bf16_t* NSAG, bf16_t* OUT, char* lds, bool do_store) {
    const int tid = threadIdx.x, wid = __builtin_amdgcn_readfirstlane(tid >> 6), lane = tid & 63, r32 = lane & 31, hi = lane >> 5;
    const int ql = wid * 8 + (r32 >> 2), h = r32 & 3, t = qb * 64 + ql;
    const size_t row = (size_t)b * SEQ + t;
    bf16x8 qr[8];
    { const bf16_t* qp = Q + row * 2048 + g * 512 + h * 128 + hi * 8;
#pragma unroll
      for (int d0 = 0; d0 < 8; ++d0) qr[d0] = *(const bf16x8*)(qp + d0 * 16); }
    { f32x4* z = (f32x4*)((float*)(lds + L_IMP) + wid * 8 * 128) + lane;
#pragma unroll
      for (int i = 0; i < 4; ++i) z[64 * i] = (f32x4){0.f, 0.f, 0.f, 0.f}; }
    const float gc = sigm(bf2f(NSAG[row * 256 + 0 * 16 + g * 4 + h])), gs = sigm(bf2f(NSAG[row * 256 + 1 * 16 + g * 4 + h])), gw = sigm(bf2f(NSAG[row * 256 + 2 * 16 + g * 4 + h]));
    const int bg = b * 4 + g;
    const size_t TSTR = (size_t)8 * SEQ * D;
    f32x16 o[4];
#pragma unroll
    for (int d_ = 0; d_ < 4; ++d_) o[d_] = f32x16{};
    {
        const bf16_t* kc = KCMP + (size_t)bg * 512 * D; const bf16_t* vc = VCMP + (size_t)bg * 512 * D;
        const int nmax = (t - 31) >> 4, jh = (4 * qb + 3 + 63) >> 6;
        float m1 = -1e30f, l1 = 0.f;
        attend<0, 1>(kc, vc, 0, jh, nmax, 0x7fffffffu, lds, qr, m1, l1, o, 0.f, 0.f, qb);
        const float inv_l = l1 > 0.f ? 1.f / l1 : 0.f;
        attend<1, 1>(kc, vc, 0, jh, nmax, 0x7fffffffu, lds, qr, m1, l1, o, inv_l, gc * inv_l, qb);
    }
    {
        asm volatile("s_waitcnt lgkmcnt(0)" ::: "memory");
        unsigned* SELM = (unsigned*)(lds + L_SELM);
        const unsigned* IMPu = (const unsigned*)(lds + L_IMP);
        if (qb >= 16) {
            for (int i = 0; i < 8; ++i) {
                const int q = wid * 8 + i;
                const unsigned vlo = IMPu[q * 128 + lane], vhi = IMPu[q * 128 + 64 + lane];
                const bool clo = (lane >= 1) && (lane <= qb - 2), chi = (64 + lane <= qb - 2);
                unsigned T = 0u;
                for (int bit = 30; bit >= 0; --bit) { const unsigned c = T | (1u << bit);
                    const int cnt = __popcll(__ballot(clo && vlo >= c)) + __popcll(__ballot(chi && vhi >= c));
                    if (cnt >= 13) T = c; }
                unsigned long long sel_lo = __ballot(clo && vlo > T), sel_hi = __ballot(chi && vhi > T);
                unsigned long long eq_lo = __ballot(clo && vlo == T), eq_hi = __ballot(chi && vhi == T);
                int need = 13 - __popcll(sel_lo) - __popcll(sel_hi);
                for (; need > 0; --need) {
                    if (eq_lo) { const unsigned long long lb = eq_lo & (0ull - eq_lo); sel_lo |= lb; eq_lo ^= lb; }
                    else if (eq_hi) { const unsigned long long lb = eq_hi & (0ull - eq_hi); sel_hi |= lb; eq_hi ^= lb; }
                }
                sel_lo |= 1ull;
                if (qb - 1 < 64) sel_lo |= 1ull << (qb - 1); else sel_hi |= 1ull << (qb - 1 - 64);
                if (qb < 64) sel_lo |= 1ull << qb; else sel_hi |= 1ull << (qb - 64);
                if (lane == 0) { SELM[q * 4 + 0] = (unsigned)sel_lo; SELM[q * 4 + 1] = (unsigned)(sel_lo >> 32); SELM[q * 4 + 2] = (unsigned)sel_hi; SELM[q * 4 + 3] = (unsigned)(sel_hi >> 32); }
            }
        } else {
            if (lane < 8) { const int q = wid * 8 + lane; SELM[q * 4 + 0] = (2u << qb) - 1u; SELM[q * 4 + 1] = 0u; SELM[q * 4 + 2] = 0u; SELM[q * 4 + 3] = 0u; }
        }
        asm volatile("s_waitcnt lgkmcnt(0)" ::: "memory");
    }
    __syncthreads();
    fold<0>(o, 1.f, lds, wid, r32, hi, nullptr, false);
    {
        const bf16_t* ks = KV4 + 0 * TSTR + (size_t)bg * SEQ * D; const bf16_t* vs = KV4 + 1 * TSTR + (size_t)bg * SEQ * D;
#pragma unroll
        for (int d_ = 0; d_ < 4; ++d_) o[d_] = f32x16{};
        float m = -1e30f, l = 0.f;
        attend<2, 2>(ks, vs, 0, qb + 1, t, 0x7fffffffu, lds, qr, m, l, o, 0.f, 0.f, qb);
        fold<1>(o, l > 0.f ? gs / l : 0.f, lds, wid, r32, hi, nullptr, false);
    }
    {
        const bf16_t* kw = KV4 + 2 * TSTR + (size_t)bg * SEQ * D; const bf16_t* vw = KV4 + 3 * TSTR + (size_t)bg * SEQ * D;
#pragma unroll
        for (int d_ = 0; d_ < 4; ++d_) o[d_] = f32x16{};
        float m = -1e30f, l = 0.f;
        attend<2, 0>(kw, vw, qb >= 8 ? qb - 8 : 0, qb + 1, t, 512u, lds, qr, m, l, o, 0.f, 0.f, qb);
        fold<2>(o, l > 0.f ? gw / l : 0.f, lds, wid, r32, hi, OUT + ((size_t)b * SEQ + qb * 64) * 2048 + g * 512, do_store);
    }
    __syncthreads();
}
#undef KSWZ
#undef SBAR
}
constexpr int NWAVES = 8;
constexpr int SEQ = 8192, M = 2 * SEQ, DM = 2048, FF = 5632, INW_SRC = 10288, INW = 10496, PW = 1024;
constexpr float RMS_EPS = 1e-6f;
constexpr size_t MiB = 1u << 20;
constexpr size_t WS_WIN = 0, WS_WPU = 42 * MiB, WS_WNU = 46 * MiB, WS_WOUT = 54 * MiB, WS_POOLW = 62 * MiB, WS_CW1 = 63 * MiB, WS_CW2 = 67 * MiB;
constexpr size_t WS_PEBP = 68 * MiB, WS_PEB = 68 * MiB + 512 * 1024, WS_SS = 68 * MiB + 768 * 1024  , WS_HIDC = 69 * MiB, WS_KVCMP = 73 * MiB;
constexpr size_t WS_WGU = 76 * MiB, WS_WD = 120 * MiB, WS_GNSA = 76 * MiB;
constexpr size_t WS_XN = 142 * MiB, WS_POOLED = 142 * MiB, WS_APOOL = 174 * MiB;
constexpr size_t WS_HID = 206 * MiB, WS_XP = 206 * MiB, WS_Q = 238 * MiB, WS_NSAG = 302 * MiB, WS_KV4 = 310 * MiB;
constexpr size_t WS_GPOOL = 382 * MiB, WS_KCVC = 446 * MiB, WS_END = 480 * MiB;
static_assert(WS_WIN + (size_t)INW * DM * 2 <= WS_WPU && WS_WGU + (size_t)2 * FF * DM * 2 <= WS_WD && WS_WD + (size_t)DM * FF * 2 <= WS_XN && WS_GNSA + (size_t)M * DM * 2 <= WS_XN, "ws map 1");
static_assert(WS_HID + (size_t)M * FF * 2 <= WS_GPOOL && WS_KV4 + (size_t)4 * M * 512 * 2 <= WS_GPOOL && WS_NSAG + (size_t)M * 256 * 2 <= WS_KV4 && WS_KCVC + (size_t)2 * M * 512 * 2 + 8192 <= WS_END, "ws map 2");
constexpr int LDS_BYTES = 147456;
#define GAS __attribute__((address_space(1)))
#define LAS __attribute__((address_space(3)))
typedef unsigned short bf16;
typedef unsigned v4u __attribute__((ext_vector_type(4)));
typedef float f32x4 __attribute__((ext_vector_type(4)));
#define LDS_WAIT() asm volatile("s_waitcnt lgkmcnt(0)" ::: "memory")
__device__ __forceinline__ unsigned f2bf(float f) { unsigned u = __builtin_bit_cast(unsigned, f); return (u + 0x7fffu + ((u >> 16) & 1u)) >> 16; }
__device__ __forceinline__ unsigned pk2(float lo, float hi) { return f2bf(lo) | (f2bf(hi) << 16); }
__device__ __forceinline__ float wave_sum(float v) {
#pragma unroll
    for (int o = 1; o < 64; o <<= 1) v += __shfl_xor(v, o);
    return v;
}
__device__ __forceinline__ void transpose_item(const float* W, int K, int N, int c0, int nvalid, bf16* WT, int drow, int k0, LAS float* scr, int lane) {
    const bool cv = (lane & 31) < nvalid;
#pragma unroll
    for (int i = 0; i < 32; ++i) { const int kk = 2 * i + (lane >> 5); scr[kk * 33 + (lane & 31)] = cv ? W[(size_t)(k0 + kk) * N + c0 + (lane & 31)] : 0.f; }
    LDS_WAIT(); asm volatile("" ::: "memory");
    const int c = lane & 7;
#pragma unroll
    for (int j = 0; j < 4; ++j) { const int n = (lane >> 3) + 8 * j; const LAS float* s = scr + (8 * c) * 33 + n;
        v4u o; o.x = pk2(s[0 * 33], s[1 * 33]); o.y = pk2(s[2 * 33], s[3 * 33]); o.z = pk2(s[4 * 33], s[5 * 33]); o.w = pk2(s[6 * 33], s[7 * 33]);
        if (n < nvalid) *(v4u*)(WT + (size_t)(drow + n) * K + k0 + 8 * c) = o; }
    LDS_WAIT(); asm volatile("" ::: "memory");
}
__device__ __forceinline__ void transpose_seg(const float* W, int K, int N, int src0, int ncols, bf16* WT, int drow0, bool gu, LAS float* scr, int lane, int gw, int NGW, int& base) {
    const int nblk = (ncols + 31) >> 5, nitems = (K >> 6) * nblk;
    int first = (gw - base) % NGW; if (first < 0) first += NGW;
    for (int it = first; it < nitems; it += NGW) {
        const int kb = it / nblk, nb = it - kb * nblk, c0 = nb * 32, nv = (ncols - c0) < 32 ? (ncols - c0) : 32;
        const int drow = gu ? (256 * (c0 >> 7) + (c0 & 127) + drow0) : (drow0 + c0);
        transpose_item(W, K, N, src0 + c0, nv, WT, drow, kb * 64, scr, lane);
    }
    base = (base + nitems) % NGW;
}
__device__ __forceinline__ void rms_row_bf16(const float* xrow, const float* g, bf16* orow, int lane) {
    const f32x4* xr = (const f32x4*)xrow + lane; const f32x4* gr = (const f32x4*)g + lane;
    f32x4 v[8]; float s = 0.f;
#pragma unroll
    for (int j = 0; j < 8; ++j) { v[j] = xr[64 * j]; s += (v[j].x * v[j].x + v[j].y * v[j].y) + (v[j].z * v[j].z + v[j].w * v[j].w); }
    const float rs = 1.f / sqrtf(wave_sum(s) * (1.f / DM) + RMS_EPS);
    unsigned long long* o8 = (unsigned long long*)orow + lane;
#pragma unroll
    for (int j = 0; j < 8; ++j) { const f32x4 gg = gr[64 * j];
        o8[64 * j] = (unsigned long long)pk2(v[j].x * rs * gg.x, v[j].y * rs * gg.y) | ((unsigned long long)pk2(v[j].z * rs * gg.z, v[j].w * rs * gg.w) << 32); }
}
__device__ __forceinline__ void xg_row_bf16(const float* xrow, const float* g, bf16* orow, float* ssp, int lane) {
    const f32x4* xr = (const f32x4*)xrow + lane; const f32x4* gr = (const f32x4*)g + lane;
    f32x4 v[8]; float s = 0.f;
#pragma unroll
    for (int j = 0; j < 8; ++j) { v[j] = xr[64 * j]; s += (v[j].x * v[j].x + v[j].y * v[j].y) + (v[j].z * v[j].z + v[j].w * v[j].w); }
    s = wave_sum(s); if (lane == 0) *ssp = s;
    unsigned long long* o8 = (unsigned long long*)orow + lane;
#pragma unroll
    for (int j = 0; j < 8; ++j) { const f32x4 gg = gr[64 * j];
        o8[64 * j] = (unsigned long long)pk2(v[j].x * gg.x, v[j].y * gg.y) | ((unsigned long long)pk2(v[j].z * gg.z, v[j].w * gg.w) << 32); }
}
__device__ __forceinline__ void rms_row_f32(float* xrow, const float* g, int lane) {
    f32x4* xr = (f32x4*)xrow + lane; const f32x4* gr = (const f32x4*)g + lane;
    f32x4 v[8]; float s = 0.f;
#pragma unroll
    for (int j = 0; j < 8; ++j) { v[j] = xr[64 * j]; s += (v[j].x * v[j].x + v[j].y * v[j].y) + (v[j].z * v[j].z + v[j].w * v[j].w); }
    const float rs = 1.f / sqrtf(wave_sum(s) * (1.f / DM) + RMS_EPS);
#pragma unroll
    for (int j = 0; j < 8; ++j) { const f32x4 gg = gr[64 * j]; xr[64 * j] = (f32x4){v[j].x * rs * gg.x, v[j].y * rs * gg.y, v[j].z * rs * gg.z, v[j].w * rs * gg.w}; }
}
using pg8::u32x4;
struct FWin {
    bf16 *XP, *Q, *KCVC, *KV4, *GPOOL, *GNSA, *NSAG;
    __device__ __forceinline__ void operator()(int row, int col, int pn, pg8::f32x4 v0, pg8::f32x4 v1) const {
        const u32x4 w = pg8::pack8(v0, v1); bf16* dst;
        if (pn < 4) dst = XP + (size_t)row * 1024 + col;
        else if (pn < 12) dst = Q + (size_t)row * 2048 + (col - 1024);
        else if (pn < 24) { const int c = col - 3072, tensor = c >> 9, g = (c >> 7) & 3, d = c & 127, b = row >> 13, t = row & 8191;
            dst = (tensor < 2 ? KCVC + (size_t)tensor * 8 * SEQ * 128 : KV4 + (size_t)(tensor - 2) * 8 * SEQ * 128) + ((size_t)(b * 4 + g) * SEQ + t) * 128 + d; }
        else if (pn < 32) dst = GPOOL + (size_t)row * 2048 + (col - 6144);
        else if (pn < 40) dst = GNSA + (size_t)row * 2048 + (col - 8192);
        else dst = NSAG + (size_t)row * 256 + (col - 10240);
        *(u32x4*)dst = w;
    }
};
struct FSiluBias { bf16* O; const float* bias;
    __device__ __forceinline__ void operator()(int row, int col, int pn, pg8::f32x4 v0, pg8::f32x4 v1) const {
        const float* bp = bias + ((row >> 12) << 8) + col; const pg8::f32x4 b0 = *(const pg8::f32x4*)bp, b1 = *(const pg8::f32x4*)(bp + 4);
#pragma unroll
        for (int j = 0; j < 4; ++j) { v0[j] = pg8::siluf_(v0[j] + b0[j]); v1[j] = pg8::siluf_(v1[j] + b1[j]); }
        *(u32x4*)(O + (size_t)row * 256 + col) = pg8::pack8(v0, v1);
    }
};
struct FStore128 { bf16* O;
    __device__ __forceinline__ void operator()(int row, int col, int pn, pg8::f32x4 v0, pg8::f32x4 v1) const {
        if (col < 128) *(u32x4*)(O + (size_t)row * 128 + col) = pg8::pack8(v0, v1);
    }
};
struct FPool { bf16* O; const float* scale;
    __device__ __forceinline__ void operator()(int row, int col, int pn, pg8::f32x4 v0, pg8::f32x4 v1) const {
        const pg8::f32x4 s0 = *(const pg8::f32x4*)(scale + col), s1 = *(const pg8::f32x4*)(scale + col + 4);
        *(u32x4*)(O + (size_t)row * PW + col) = pg8::pack8(v0 * s0, v1 * s1);
    }
};
struct FGate { bf16* MG; const bf16* Gt; bool add;
    __device__ __forceinline__ void operator()(int row, int col, int pn, pg8::f32x4 v0, pg8::f32x4 v1) const {
        const size_t off = (size_t)row * DM + col;
        const u32x4 gw = *(const u32x4*)(Gt + off);
        pg8::f32x4 r0, r1;
        r0[0] = pg8::sigmoidf_(pg8::bf_lo(gw.x)) * v0[0]; r0[1] = pg8::sigmoidf_(pg8::bf_hi(gw.x)) * v0[1]; r0[2] = pg8::sigmoidf_(pg8::bf_lo(gw.y)) * v0[2]; r0[3] = pg8::sigmoidf_(pg8::bf_hi(gw.y)) * v0[3];
        r1[0] = pg8::sigmoidf_(pg8::bf_lo(gw.z)) * v1[0]; r1[1] = pg8::sigmoidf_(pg8::bf_hi(gw.z)) * v1[1]; r1[2] = pg8::sigmoidf_(pg8::bf_lo(gw.w)) * v1[2]; r1[3] = pg8::sigmoidf_(pg8::bf_hi(gw.w)) * v1[3];
        if (add) { const u32x4 mw = *(const u32x4*)(MG + off);
            r0[0] += pg8::bf_lo(mw.x); r0[1] += pg8::bf_hi(mw.x); r0[2] += pg8::bf_lo(mw.y); r0[3] += pg8::bf_hi(mw.y);
            r1[0] += pg8::bf_lo(mw.z); r1[1] += pg8::bf_hi(mw.z); r1[2] += pg8::bf_lo(mw.w); r1[3] += pg8::bf_hi(mw.w); }
        *(u32x4*)(MG + off) = pg8::pack8(r0, r1);
    }
};

struct Args { const float* in[23]; float* out; unsigned char* ws; int ph_lo, ph_hi; };
enum { I_X = 0, I_F1N, I_F1G, I_F1U, I_F1D, I_MIXN, I_WIN, I_POOLW, I_POOLS, I_PEK, I_PEV, I_CKW1, I_CKW2, I_CVW1, I_CVW2, I_WPU, I_WNU, I_WOUT, I_F2N, I_F2G, I_F2U, I_F2D, I_FINN };
constexpr int N_PHASES = 12;

template <class Epi> __device__ __forceinline__ void run_gemm(LAS unsigned char* lds, const bf16* A, int lda, const bf16* Bt, int ldb, int Mr, int N, int K, int G, int c, const Epi& E, int apn = 0, int bdiv = 1 << 30, int bbytes = 0) {
    pg8::Gemm g{A, Bt, Mr, N, K, lda, ldb, apn, bdiv, bbytes}; pg8::StaticOrder S; S.init(Mr, N, G, c);
    pg8::gemm_phase<Epi, pg8::StaticOrder, true, true>(lds, g, S, E);
    __syncthreads();
}

__global__ void __launch_bounds__(NWAVES * 64, 2) mk_fwd(Args a) {
    extern __shared__ __attribute__((aligned(16))) unsigned char lds_raw[];
    LAS unsigned char* lds = (LAS unsigned char*)lds_raw;
    const int tid = threadIdx.x, lane = tid & 63, wave = __builtin_amdgcn_readfirstlane(tid >> 6);
    const int G = gridDim.x, bx = blockIdx.x;
    const int vcu = (G % 8 == 0) ? (bx % 8) * (G / 8) + bx / 8 : bx;
    const int gw = vcu * NWAVES + wave, NGW = G * NWAVES;
    unsigned char* ws = a.ws;
    bf16* Win_t = (bf16*)(ws + WS_WIN); bf16* Wpu_t = (bf16*)(ws + WS_WPU); bf16* Wnu_t = (bf16*)(ws + WS_WNU); bf16* Wout_t = (bf16*)(ws + WS_WOUT);
    bf16* Poolw_t = (bf16*)(ws + WS_POOLW); bf16* Cw1_t = (bf16*)(ws + WS_CW1); bf16* Cw2_t = (bf16*)(ws + WS_CW2);
    float* PEBP = (float*)(ws + WS_PEBP); float* PEB = (float*)(ws + WS_PEB); float* SS0 = (float*)(ws + WS_SS); float* SS1 = SS0 + M; float* SS2 = SS1 + M;
    bf16* HIDC = (bf16*)(ws + WS_HIDC); bf16* KVCMP = (bf16*)(ws + WS_KVCMP);
    bf16* Wgu_t = (bf16*)(ws + WS_WGU); bf16* Wd_t = (bf16*)(ws + WS_WD); bf16* GNSA = (bf16*)(ws + WS_GNSA);
    bf16* XN = (bf16*)(ws + WS_XN); bf16* POOLED = (bf16*)(ws + WS_POOLED); bf16* APOOL = (bf16*)(ws + WS_APOOL);
    bf16* HID = (bf16*)(ws + WS_HID); bf16* XP = (bf16*)(ws + WS_XP); bf16* Q = (bf16*)(ws + WS_Q); bf16* KV4 = (bf16*)(ws + WS_KV4); bf16* KCVC = (bf16*)(ws + WS_KCVC); bf16* NSAG = (bf16*)(ws + WS_NSAG);
    bf16* GPOOL = (bf16*)(ws + WS_GPOOL);
    float* H = a.out;
    const int lo = a.ph_lo, hi = a.ph_hi;
#ifndef MK_PHASE_MASK
#define MK_PHASE_MASK 0xfff
#endif
#define IN(k) (((MK_PHASE_MASK >> (k)) & 1) && lo <= (k) && (k) < hi)
#ifndef MK_REP_MASK
#define MK_REP_MASK 0
#endif
#define REP(k) ((MK_REP_MASK >> (k)) & 1)
#define SEAM(k) do { if (IN(k) && IN((k) + 1)) { __syncthreads(); cg::this_grid().sync(); } } while (0)
    LAS float* scr = (LAS float*)(lds + wave * 16384);

    if (IN(0)) for (int rep = 0; rep <= REP(0); ++rep) {
        int base = 0;
        transpose_seg(a.in[I_F1G], DM, FF, 0, FF, Wgu_t, 0, true, scr, lane, gw, NGW, base);
        transpose_seg(a.in[I_F1U], DM, FF, 0, FF, Wgu_t, 128, true, scr, lane, gw, NGW, base);
        transpose_seg(a.in[I_F1D], FF, DM, 0, DM, Wd_t, 0, false, scr, lane, gw, NGW, base);
        transpose_seg(a.in[I_WIN], DM, INW_SRC, 0, 6144, Win_t, 0, false, scr, lane, gw, NGW, base);
        transpose_seg(a.in[I_WIN], DM, INW_SRC, 6192, 2048, Win_t, 6144, false, scr, lane, gw, NGW, base);
        transpose_seg(a.in[I_WIN], DM, INW_SRC, 8240, 2048, Win_t, 8192, false, scr, lane, gw, NGW, base);
        transpose_seg(a.in[I_WIN], DM, INW_SRC, 6144, 48, Win_t, 10240, false, scr, lane, gw, NGW, base);
        transpose_seg(a.in[I_WPU], PW, DM, 0, DM, Wpu_t, 0, false, scr, lane, gw, NGW, base);
        transpose_seg(a.in[I_WNU], DM, DM, 0, DM, Wnu_t, 0, false, scr, lane, gw, NGW, base);
        transpose_seg(a.in[I_WOUT], DM, DM, 0, DM, Wout_t, 0, false, scr, lane, gw, NGW, base);
        for (int gi = 0; gi < 4; ++gi) transpose_seg(a.in[I_POOLW] + (size_t)gi * 65536, 256, 256, 0, 256, Poolw_t + (size_t)gi * 65536, 0, false, scr, lane, gw, NGW, base);
        transpose_seg(a.in[I_CKW1], 4096, 256, 0, 256, Cw1_t, 0, false, scr, lane, gw, NGW, base);
        transpose_seg(a.in[I_CVW1], 4096, 256, 0, 256, Cw1_t + (size_t)256 * 4096, 0, false, scr, lane, gw, NGW, base);
        transpose_seg(a.in[I_CKW2], 256, 128, 0, 128, Cw2_t, 0, false, scr, lane, gw, NGW, base);
        transpose_seg(a.in[I_CVW2], 256, 128, 0, 128, Cw2_t + 65536, 0, false, scr, lane, gw, NGW, base);
        for (int m = gw; m < M; m += NGW) xg_row_bf16(a.in[I_X] + (size_t)m * DM, a.in[I_F1N], XN + (size_t)m * DM, SS0 + m, lane);
        for (int i = vcu * 512 + tid; i < 2 * M; i += G * 512) SS1[i] = 0.f;
        for (int task = gw; task < 256; task += NGW) {
            const int tensor = task >> 7, chunk = (task >> 2) & 31, col = (task & 3) * 64 + lane;
            const float* pe = a.in[tensor ? I_PEV : I_PEK] + chunk * 128; const float* w1 = a.in[tensor ? I_CVW1 : I_CKW1] + (size_t)chunk * 128 * 256 + col;
            float acc = 0.f;
#pragma unroll 8
            for (int k = 0; k < 128; ++k) acc += pe[k] * w1[(size_t)k * 256];
            PEBP[(tensor * 32 + chunk) * 256 + col] = acc;
        }
    }
    SEAM(0);
    if (IN(1)) for (int rep = 0; rep <= REP(1); ++rep) { pg8::EpiSwiglu E{HID, FF, SS0}; run_gemm(lds, XN, DM, Wgu_t, DM, M, 2 * FF, DM, G, bx, E); }
    SEAM(1);
    if (IN(2)) { pg8::EpiResNorm E{a.in[I_X], H, XN, a.in[I_MIXN], SS1, DM, 0.5f}; run_gemm(lds, HID, FF, Wd_t, FF, M, DM, FF, G, bx, E); }
    SEAM(2);
    if (IN(3)) for (int rep = 0; rep <= REP(3); ++rep) {
        if (bx == G - 1) { float s = 0.f; for (int c = 0; c < 32; ++c) s += PEBP[((tid >> 8) * 32 + c) * 256 + (tid & 255)]; PEB[tid] = s; }
        pg8::EpiP8<FWin> E{FWin{XP, Q, KCVC, KV4, GPOOL, GNSA, NSAG}, SS1}; run_gemm(lds, XN, DM, Win_t, DM, M, INW, DM, G, bx, E); }
    SEAM(3);
    if (IN(4)) for (int rep = 0; rep <= REP(4); ++rep) {
        { pg8::EpiP8<FSiluBias> E{FSiluBias{HIDC, PEB}, nullptr}; run_gemm(lds, KCVC, 2048, Cw1_t, 4096, 8192, 256, 4096, G, bx, E, 0, 16, 256 * 4096 * 2); }
        const int nthr = G * NWAVES * 64;
        for (int idx = vcu * 512 + tid; idx < M * 128; idx += nthr) {
            const int row = idx >> 7, c8 = (idx & 127) * 8, win = 2 << (c8 >> 8), t = row & (SEQ - 1), n = (t + 1) < win ? (t + 1) : win;
            float acc[8] = {0.f, 0.f, 0.f, 0.f, 0.f, 0.f, 0.f, 0.f}, x0[8];
            for (int j = 0; j < n; ++j) { const v4u w = *(const v4u*)(XP + (size_t)(row - j) * PW + c8);
                const float f[8] = {pg8::bf_lo(w.x), pg8::bf_hi(w.x), pg8::bf_lo(w.y), pg8::bf_hi(w.y), pg8::bf_lo(w.z), pg8::bf_hi(w.z), pg8::bf_lo(w.w), pg8::bf_hi(w.w)};
#pragma unroll
                for (int e = 0; e < 8; ++e) { acc[e] += f[e]; if (j == 0) x0[e] = f[e]; } }
            const float inv = 1.f / (float)n;
            v4u o; o.x = pk2(acc[0] * inv - x0[0], acc[1] * inv - x0[1]); o.y = pk2(acc[2] * inv - x0[2], acc[3] * inv - x0[3]);
            o.z = pk2(acc[4] * inv - x0[4], acc[5] * inv - x0[5]); o.w = pk2(acc[6] * inv - x0[6], acc[7] * inv - x0[7]);
            *(v4u*)(POOLED + (size_t)row * PW + c8) = o;
        }
    }
    SEAM(4);
    if (IN(5)) for (int rep = 0; rep <= REP(5); ++rep) {
        { pg8::EpiP8<FPool> E{FPool{APOOL, a.in[I_POOLS]}, nullptr}; run_gemm(lds, POOLED, PW, Poolw_t, 256, M, PW, 256, G, bx, E, 256 * 2); }
        { pg8::EpiP8<FStore128> E{FStore128{KVCMP}, nullptr}; run_gemm(lds, HIDC, 256, Cw2_t, 256, 8192, 256, 256, G, bx, E, 0, 16, 65536 * 2); }
    }
    SEAM(5);
    if (IN(6)) {
        { pg8::EpiP8<FGate> E{FGate{GPOOL, GPOOL, false}, nullptr}; run_gemm(lds, APOOL, PW, Wpu_t, PW, M, DM, PW, G, bx, E); }
        for (int rep = REP(6) ? 0 : 1; rep < 2; ++rep)
        for (int it = vcu; it < 1024; it += G) {
            const int c = it & 255, k = it >> 8, bg = c >> 5, i = c & 31;
            const int qb = (k == 0) ? i : (k == 1) ? 63 - i : (k == 2) ? 64 + i : 127 - i;
            nsa::nsa_unit(bg >> 2, bg & 3, qb, Q, KV4, KVCMP, KVCMP + (size_t)4096 * 128, NSAG, Q, (char*)lds_raw, rep == 1 || a.ph_lo != 0);
        }
    }
    SEAM(6);
    if (IN(7)) { pg8::EpiP8<FGate> E{FGate{GPOOL, GNSA, true}, nullptr}; run_gemm(lds, Q, DM, Wnu_t, DM, M, DM, DM, G, bx, E); }
    SEAM(7);
    if (IN(8)) {
        int base = 0;
        transpose_seg(a.in[I_F2G], DM, FF, 0, FF, Wgu_t, 0, true, scr, lane, gw, NGW, base);
        transpose_seg(a.in[I_F2U], DM, FF, 0, FF, Wgu_t, 128, true, scr, lane, gw, NGW, base);
        transpose_seg(a.in[I_F2D], FF, DM, 0, DM, Wd_t, 0, false, scr, lane, gw, NGW, base);
        __syncthreads();
        pg8::EpiResNorm E{H, H, XN, a.in[I_F2N], SS2, DM, 1.0f}; run_gemm(lds, GPOOL, DM, Wout_t, DM, M, DM, DM, G, bx, E);
    }
    SEAM(8);
    if (IN(9)) for (int rep = 0; rep <= REP(9); ++rep) { pg8::EpiSwiglu E{HID, FF, SS2}; run_gemm(lds, XN, DM, Wgu_t, DM, M, 2 * FF, DM, G, bx, E); }
    SEAM(9);
    if (IN(10)) { pg8::EpiResF32 E{H, H, DM, 0.5f}; run_gemm(lds, HID, FF, Wd_t, FF, M, DM, FF, G, bx, E); }
    SEAM(10);
    if (IN(11)) { for (int m = gw; m < M; m += NGW) rms_row_f32(H + (size_t)m * DM, a.in[I_FINN], lane); }
#undef IN
#undef SEAM
}

#ifndef MK_ONE_LAUNCH
#define MK_ONE_LAUNCH 1
#endif
extern "C" void kernel_launch(void* const* d_in, const int* in_sizes, int n_in, void* d_out, int out_size, void* d_ws, size_t ws_size, hipStream_t stream) {
    static int grid = 0;
    if (grid == 0) {
        if (n_in != 23 || out_size != M * DM || ws_size < WS_END) { fprintf(stderr, "kernel_launch: unexpected shapes (n_in %d out %d ws %zu)\n", n_in, out_size, ws_size); grid = -1; return; }
        int dev = 0, cus = 0, per_cu = 0;
        (void)hipGetDevice(&dev); (void)hipDeviceGetAttribute(&cus, hipDeviceAttributeMultiprocessorCount, dev);
        if (hipFuncSetAttribute((const void*)mk_fwd, hipFuncAttributeMaxDynamicSharedMemorySize, LDS_BYTES) != hipSuccess) { fprintf(stderr, "kernel_launch: hipFuncSetAttribute failed\n"); grid = -1; return; }
        if (hipOccupancyMaxActiveBlocksPerMultiprocessor(&per_cu, (const void*)mk_fwd, NWAVES * 64, LDS_BYTES) != hipSuccess || per_cu < 1) { fprintf(stderr, "kernel_launch: occupancy query says %d\n", per_cu); per_cu = 1; }
        (void)hipGetLastError();
        grid = cus > 0 ? cus : 256;
    }
    if (grid < 0) return;
    Args a{};
    for (int i = 0; i < 23; ++i) a.in[i] = (const float*)d_in[i];
    a.out = (float*)d_out; a.ws = (unsigned char*)d_ws;
#if MK_ONE_LAUNCH
    a.ph_lo = 0; a.ph_hi = N_PHASES;
    void* args[] = {&a};
    hipError_t e = hipLaunchCooperativeKernel((const void*)mk_fwd, dim3(grid), dim3(NWAVES * 64), args, LDS_BYTES, stream);
    if (e != hipSuccess) fprintf(stderr, "kernel_launch: cooperative launch failed: %s (grid %d)\n", hipGetErrorString(e), grid);
#else
    for (int p = 0; p < N_PHASES; ++p) { a.ph_lo = p; a.ph_hi = p + 1; hipLaunchKernelGGL(mk_fwd, dim3(grid), dim3(NWAVES * 64), LDS_BYTES, stream, a); }
#endif
}
```

```cpp
#include <hip/hip_runtime.h>
#include <hip/hip_cooperative_groups.h>
#include <cstdio>
#include <cstdint>
namespace cg = cooperative_groups;
namespace pg8 {
#define PG8_LAS __attribute__((address_space(3)))
typedef unsigned short bf16_t;
typedef short bf16x8 __attribute__((ext_vector_type(8)));
typedef float f32x4 __attribute__((ext_vector_type(4)));
typedef unsigned u32x4 __attribute__((ext_vector_type(4)));
constexpr int BM = 256, BK = 64, HALF = 128, HTB = HALF * BK * 2  , STAGE_BYTES = 8 * HTB, NXCD = 8, WGM = 4;

__host__ __device__ __forceinline__ int lds_byte(int r, int c) { const int st = (r >> 4) * 2 + (c >> 5), rr = r & 15, cc = c & 31, ob = rr * 64 + cc * 2; return st * 1024 + (ob ^ (((ob >> 9) & 1) << 5)); }
__host__ __device__ __forceinline__ void stage_rc(int b, int& R, int& C) { const int st = b / 1024, sb = b % 1024, swz = sb ^ (((sb >> 9) & 1) << 5); R = (st >> 1) * 16 + swz / 64; C = (st & 1) * 32 + (swz % 64) / 2; }
__host__ __device__ __forceinline__ int perm32(int rho) { const int n = rho >> 4, i = rho & 15; return 8 * (i >> 2) + 4 * n + (i & 3); }

struct Unit { int pm, pn; };
struct Gemm { const bf16_t* A; const bf16_t* Bt; int M, N, K, lda, ldb; int apn  , bpn  , bdiv, bbytes  ; };

struct StaticOrder {
    int nM, nN, nwg, G, c;
    __host__ __device__ __forceinline__ void init(int M, int N, int G_, int c_) { nM = M / BM; nN = N / BM; nwg = nM * nN; G = G_; c = c_; }
    __host__ __device__ __forceinline__ bool next(int i, Unit& u) const {
        const long L = (long)i * G + c; if (L >= nwg) return false;
        int wgid = (int)L; { const int q = nwg / NXCD, r = nwg % NXCD, xcd = wgid % NXCD, off = wgid / NXCD; wgid = (xcd < r ? xcd * (q + 1) : r * (q + 1) + (xcd - r) * q) + off; }
        const int nig = WGM * nN, gid = wgid / nig, fm = gid * WGM, gsz = (nM - fm) < WGM ? (nM - fm) : WGM;
        u.pm = fm + ((wgid % nig) % gsz); u.pn = (wgid % nig) / gsz; return true;
    }
    __device__ __forceinline__ void a_ready(const Unit&) const {}
    __device__ __forceinline__ void done(const Unit&) const {}
};

__device__ __forceinline__ unsigned cvt_pk_bf16(float lo, float hi) { unsigned r; asm volatile("v_cvt_pk_bf16_f32 %0, %1, %2" : "=v"(r) : "v"(lo), "v"(hi)); return r; }
__device__ __forceinline__ float bf_lo(unsigned w) { return __builtin_bit_cast(float, w << 16); }
__device__ __forceinline__ float bf_hi(unsigned w) { return __builtin_bit_cast(float, w & 0xffff0000u); }
__device__ __forceinline__ float sigmoidf_(float x) { return __builtin_amdgcn_rcpf(1.f + __builtin_amdgcn_exp2f(-1.4426950408889634f * x)); }
__device__ __forceinline__ float siluf_(float x) { return x * sigmoidf_(x); }
__device__ __forceinline__ u32x4 pack8(f32x4 a, f32x4 b) { u32x4 w; w.x = cvt_pk_bf16(a[0], a[1]); w.y = cvt_pk_bf16(a[2], a[3]); w.z = cvt_pk_bf16(b[0], b[1]); w.w = cvt_pk_bf16(b[2], b[3]); return w; }

template <class F> struct EpiP8 {
    static constexpr bool PERM = true, AFTER_DRAIN = false;
    F f; const float* ss;
    __device__ __forceinline__ void operator()(const f32x4 (&acc)[2][2][4][2], const Unit& u, int wr, int wc, int fr, int fq) const {
        const int row0 = u.pm * BM + wr * 64 + fr, col0 = u.pn * BM + wc * 32 + 8 * fq;
        typename F::Pre pre[2][2]; float rsv[2];
#define EP8_LD(s_, i_) do { const int r_ = row0 + ((i_) >> 2) * HALF + ((i_) & 3) * 16; f.load(pre[s_][0], r_, col0); f.load(pre[s_][1], r_, col0 + HALF); rsv[s_] = ss ? ss[r_] : 0.f; } while (0)
        EP8_LD(0, 0);
#pragma unroll
        for (int i = 0; i < 8; ++i) {
            if (i + 1 < 8) EP8_LD((i + 1) & 1, i + 1);
            const int ai = i >> 2, mm = i & 3, row = row0 + ai * HALF + mm * 16;
            const float rs = ss ? __builtin_amdgcn_rsqf(rsv[i & 1] * (1.f / 2048.f) + 1e-6f) : 1.f;
#pragma unroll
            for (int bj = 0; bj < 2; ++bj) f(row, col0 + bj * HALF, u.pn, acc[ai][bj][mm][0] * rs, acc[ai][bj][mm][1] * rs, pre[i & 1][bj]);
        }
#undef EP8_LD
    }
};
struct EpiSwiglu {
    static constexpr bool PERM = true, AFTER_DRAIN = false;
    bf16_t* O; int ldc; const float* ss;
    __device__ __forceinline__ void operator()(const f32x4 (&acc)[2][2][4][2], const Unit& u, int wr, int wc, int fr, int fq) const {
        const int row0 = u.pm * BM + wr * 64 + fr, col0 = u.pn * HALF + wc * 32 + 8 * fq;
#pragma unroll
        for (int ai = 0; ai < 2; ++ai)
#pragma unroll
            for (int m = 0; m < 4; ++m) {
                const int row = row0 + ai * HALF + m * 16;
                const float rs = __builtin_amdgcn_rsqf(ss[row] * (1.f / 2048.f) + 1e-6f);
                f32x4 h0, h1;
#pragma unroll
                for (int j = 0; j < 4; ++j) { h0[j] = siluf_(acc[ai][0][m][0][j] * rs) * (acc[ai][1][m][0][j] * rs); h1[j] = siluf_(acc[ai][0][m][1][j] * rs) * (acc[ai][1][m][1][j] * rs); }
                *(u32x4*)(O + (size_t)row * ldc + col0) = pack8(h0, h1);
            }
    }
};
struct EpiResF32 {
    static constexpr bool PERM = false, AFTER_DRAIN = false;
    const float* base; float* out; int ldc; float coef;
    __device__ __forceinline__ void operator()(const f32x4 (&acc)[2][2][4][2], const Unit& u, int wr, int wc, int fr, int fq) const {
        const int row0 = u.pm * BM + wr * 64 + fr, col0 = u.pn * BM + wc * 32 + 4 * fq;
        f32x4 pre[2][2][2];
#define ERF_LD(s_, i_) do { const size_t off_ = (size_t)(row0 + ((i_) >> 2) * HALF + ((i_) & 3) * 16) * ldc + col0; \
        pre[s_][0][0] = *(const f32x4*)(base + off_); pre[s_][0][1] = *(const f32x4*)(base + off_ + 16); pre[s_][1][0] = *(const f32x4*)(base + off_ + HALF); pre[s_][1][1] = *(const f32x4*)(base + off_ + HALF + 16); } while (0)
        ERF_LD(0, 0);
#pragma unroll
        for (int i = 0; i < 8; ++i) {
            if (i + 1 < 8) ERF_LD((i + 1) & 1, i + 1);
            const int ai = i >> 2, mm = i & 3; const size_t off = (size_t)(row0 + ai * HALF + mm * 16) * ldc + col0;
#pragma unroll
            for (int bj = 0; bj < 2; ++bj)
#pragma unroll
                for (int n = 0; n < 2; ++n) *(f32x4*)(out + off + bj * HALF + n * 16) = pre[i & 1][bj][n] + acc[ai][bj][mm][n] * coef;
        }
#undef ERF_LD
    }
};
struct EpiResNorm {
    static constexpr bool PERM = false, AFTER_DRAIN = false;
    const float* base; float* out; bf16_t* xn; const float* gain; float* ss; int ldc; float coef;
    __device__ __forceinline__ void operator()(const f32x4 (&acc)[2][2][4][2], const Unit& u, int wr, int wc, int fr, int fq) const {
        const int row0 = u.pm * BM + wr * 64 + fr, col0 = u.pn * BM + wc * 32 + 4 * fq;
        f32x4 gg[2][2];
#pragma unroll
        for (int bj = 0; bj < 2; ++bj)
#pragma unroll
            for (int n = 0; n < 2; ++n) gg[bj][n] = *(const f32x4*)(gain + col0 + bj * HALF + n * 16);
        f32x4 pre[2][2][2];
#define ERN_LD(s_, i_) do { const size_t off_ = (size_t)(row0 + ((i_) >> 2) * HALF + ((i_) & 3) * 16) * ldc + col0; \
        pre[s_][0][0] = *(const f32x4*)(base + off_); pre[s_][0][1] = *(const f32x4*)(base + off_ + 16); pre[s_][1][0] = *(const f32x4*)(base + off_ + HALF); pre[s_][1][1] = *(const f32x4*)(base + off_ + HALF + 16); } while (0)
        ERN_LD(0, 0);
#pragma unroll
        for (int i = 0; i < 8; ++i) {
            if (i + 1 < 8) ERN_LD((i + 1) & 1, i + 1);
            const int ai = i >> 2, mm = i & 3, row = row0 + ai * HALF + mm * 16; const size_t off = (size_t)row * ldc + col0; float s = 0.f;
#pragma unroll
            for (int bj = 0; bj < 2; ++bj)
#pragma unroll
                for (int n = 0; n < 2; ++n) { const f32x4 h = pre[i & 1][bj][n] + acc[ai][bj][mm][n] * coef;
                    *(f32x4*)(out + off + bj * HALF + n * 16) = h; s += (h[0] * h[0] + h[1] * h[1]) + (h[2] * h[2] + h[3] * h[3]);
                    const f32x4 y = h * gg[bj][n]; typedef unsigned u32x2 __attribute__((ext_vector_type(2))); u32x2 w; w.x = cvt_pk_bf16(y[0], y[1]); w.y = cvt_pk_bf16(y[2], y[3]);
                    *(u32x2*)(xn + off + bj * HALF + n * 16) = w; }
            s += __shfl_xor(s, 16); s += __shfl_xor(s, 32);
            if (fq == 0) atomicAdd(ss + row, s);
        }
#undef ERN_LD
    }
};
template <class Epi, class Sched, bool ALIGN_EPI = false, bool SP2 = false>
__device__ __forceinline__ void gemm_phase(PG8_LAS unsigned char* lds, const Gemm g, const Sched& S, const Epi& E) {
    const int tid = threadIdx.x, wid = __builtin_amdgcn_readfirstlane(tid >> 6), lane = tid & 63, wr = wid >> 2, wc = wid & 3, fr = lane & 15, fq = lane >> 4;
    const int K = g.K, nt = K / BK;
    unsigned voffA[2], voffB[2];
#pragma unroll
    for (int i = 0; i < 2; ++i) { int R, C; stage_rc(tid * 16 + i * 8192, R, C); const int Rb = Epi::PERM ? ((R & ~31) + perm32(R & 31)) : R;
        voffA[i] = (unsigned)(R * g.lda + C) * 2u; voffB[i] = (unsigned)(Rb * g.ldb + C) * 2u; }
    const size_t kstep = (size_t)(BK * 2);
    const size_t hstepA = (size_t)HALF * g.lda * 2, hstepB = (size_t)HALF * g.ldb * 2;
    const size_t tstepA = 2 * hstepA, tstepB = 2 * hstepB;
    const unsigned ldsw = (unsigned)wid * 1024u;
    const int aoff = lds_byte(wr * 64 + fr, fq * 8), boff = lds_byte(wc * 32 + fr, fq * 8);
#define PG8_SA(b, h) (((b) * 2 + (h)) * HTB)
#define PG8_SB(b, h) ((4 + (b) * 2 + (h)) * HTB)
#define PG8_STAGE(bufoff, gbase, voff) do { _Pragma("unroll") for (int _i = 0; _i < 2; ++_i) \
        __builtin_amdgcn_global_load_lds((const unsigned*)((const char*)(gbase) + (voff)[_i]), (PG8_LAS unsigned*)(lds + (bufoff) + ldsw + _i * 8192), 16, 0, 0); } while (0)
#define PG8_LDA(dst, b, h) do { _Pragma("unroll") for (int m = 0; m < 4; ++m) _Pragma("unroll") for (int k = 0; k < 2; ++k) dst[m][k] = *(const PG8_LAS bf16x8*)(lds + PG8_SA(b, h) + aoff + m * 2048 + k * 1024); } while (0)
#define PG8_LDB(dst, b, h) do { _Pragma("unroll") for (int n = 0; n < 2; ++n) _Pragma("unroll") for (int k = 0; k < 2; ++k) dst[n][k] = *(const PG8_LAS bf16x8*)(lds + PG8_SB(b, h) + boff + n * 2048 + k * 1024); } while (0)
#define PG8_MMA(ai, bj, At, Bt) do { __builtin_amdgcn_s_setprio(1); _Pragma("unroll") for (int m = 0; m < 4; ++m) _Pragma("unroll") for (int n = 0; n < 2; ++n) _Pragma("unroll") for (int k = 0; k < 2; ++k) \
        acc[ai][bj][m][n] = __builtin_amdgcn_mfma_f32_16x16x32_bf16(Bt[n][k], At[m][k], acc[ai][bj][m][n], 0, 0, 0); __builtin_amdgcn_s_setprio(0); } while (0)
#define PG8_WAIT_V(n) asm volatile("s_waitcnt vmcnt(" #n ")" ::: "memory")
#define PG8_WAIT_L(n) asm volatile("s_waitcnt lgkmcnt(" #n ")" ::: "memory")
#define PG8_BAR __builtin_amdgcn_s_barrier()
#define PG8_SCHED __builtin_amdgcn_sched_barrier(0)
    Unit cur, nxt; int ui = 0;
    if (!S.next(0, cur)) return;
    f32x4 acc[2][2][4][2];
#pragma unroll
    for (int a = 0; a < 2; ++a)
#pragma unroll
        for (int b = 0; b < 2; ++b)
#pragma unroll
            for (int m = 0; m < 4; ++m)
#pragma unroll
                for (int n = 0; n < 2; ++n) acc[a][b][m][n] = (f32x4){0.f, 0.f, 0.f, 0.f};
    bf16x8 At[4][2], B0[2][2], B1[2][2];
    const char* cA = (const char*)g.A + (size_t)cur.pm * tstepA + (size_t)cur.pn * g.apn; const char* cB = (const char*)g.Bt + (size_t)cur.pn * g.bpn + (size_t)(cur.pm / g.bdiv) * g.bbytes;
    S.a_ready(cur);
    if constexpr (SP2) {
        PG8_STAGE(PG8_SB(0, 0), cB, voffB); PG8_STAGE(PG8_SB(0, 1), cB + hstepB, voffB); PG8_STAGE(PG8_SA(0, 0), cA, voffA); PG8_STAGE(PG8_SA(0, 1), cA + hstepA, voffA);
        if (wr == 1) PG8_BAR;
        PG8_WAIT_V(2); PG8_BAR;
        PG8_STAGE(PG8_SB(1, 0), cB + kstep, voffB); PG8_STAGE(PG8_SA(1, 0), cA + kstep, voffA); PG8_STAGE(PG8_SB(1, 1), cB + hstepB + kstep, voffB);
        PG8_WAIT_V(6); PG8_BAR;
    } else {
        PG8_STAGE(PG8_SB(0, 0), cB, voffB); PG8_STAGE(PG8_SA(0, 0), cA, voffA); PG8_STAGE(PG8_SB(0, 1), cB + hstepB, voffB); PG8_STAGE(PG8_SA(0, 1), cA + hstepA, voffA);
        if (wr == 1) PG8_BAR;
        PG8_WAIT_V(4); PG8_BAR;
        PG8_STAGE(PG8_SB(1, 0), cB + kstep, voffB); PG8_STAGE(PG8_SA(1, 0), cA + kstep, voffA); PG8_STAGE(PG8_SB(1, 1), cB + hstepB + kstep, voffB);
        PG8_WAIT_V(6); PG8_BAR;
    }
    for (;;) {
        const bool has_next = S.next(ui + 1, nxt);
        const char* nA = has_next ? (const char*)g.A + (size_t)nxt.pm * tstepA + (size_t)nxt.pn * g.apn : cA; const char* nB = has_next ? (const char*)g.Bt + (size_t)nxt.pn * g.bpn + (size_t)(nxt.pm / g.bdiv) * g.bbytes : cB;
#pragma nounroll
        for (int t = 0; t < nt; t += 2) {
            const bool last = (t == nt - 2);
            const char* a1 = cA + (size_t)(t + 1) * kstep;
            const char* a2 = last ? nA : cA + (size_t)(t + 2) * kstep; const char* b2 = last ? nB : cB + (size_t)(t + 2) * kstep;
            const char* a3 = a2 + kstep; const char* b3 = b2 + kstep;
            if (last && has_next) S.a_ready(nxt);
            if constexpr (SP2) {
            PG8_LDB(B0, 0, 0); PG8_LDB(B1, 0, 1); PG8_SCHED; PG8_LDA(At, 0, 0); PG8_STAGE(PG8_SA(1, 1), a1 + hstepA, voffA);
            PG8_WAIT_V(8); PG8_WAIT_L(0); PG8_BAR; PG8_MMA(0, 0, At, B0); PG8_MMA(0, 1, At, B1); PG8_BAR; PG8_SCHED;
            PG8_LDA(At, 0, 1); PG8_STAGE(PG8_SB(0, 0), b2, voffB); PG8_STAGE(PG8_SB(0, 1), b2 + hstepB, voffB); PG8_STAGE(PG8_SA(0, 0), a2, voffA);
            PG8_WAIT_V(8); PG8_WAIT_L(0); PG8_BAR; PG8_MMA(1, 0, At, B0); PG8_MMA(1, 1, At, B1); PG8_BAR; PG8_SCHED;
            PG8_LDB(B0, 1, 0); PG8_LDB(B1, 1, 1); PG8_SCHED; PG8_LDA(At, 1, 0); PG8_STAGE(PG8_SA(0, 1), a2 + hstepA, voffA);
            PG8_WAIT_V(8); PG8_WAIT_L(0); PG8_BAR; PG8_MMA(0, 0, At, B0); PG8_MMA(0, 1, At, B1); PG8_BAR; PG8_SCHED;
            PG8_LDA(At, 1, 1); PG8_STAGE(PG8_SB(1, 0), b3, voffB); PG8_STAGE(PG8_SB(1, 1), b3 + hstepB, voffB); PG8_STAGE(PG8_SA(1, 0), a3, voffA);
            PG8_WAIT_V(8); PG8_WAIT_L(0); PG8_BAR; PG8_MMA(1, 0, At, B0); PG8_MMA(1, 1, At, B1); PG8_BAR; PG8_SCHED;
            } else {
            PG8_LDB(B0, 0, 0); PG8_SCHED; PG8_LDA(At, 0, 0); PG8_STAGE(PG8_SA(1, 1), a1 + hstepA, voffA);
            PG8_WAIT_L(8); PG8_BAR; PG8_WAIT_L(0); PG8_MMA(0, 0, At, B0); PG8_BAR; PG8_SCHED;
            PG8_LDB(B1, 0, 1); PG8_STAGE(PG8_SB(0, 0), b2, voffB);
            PG8_BAR; PG8_WAIT_L(0); PG8_MMA(0, 1, At, B1); PG8_BAR;
            PG8_LDA(At, 0, 1); PG8_STAGE(PG8_SA(0, 0), a2, voffA);
            PG8_BAR; PG8_WAIT_L(0); PG8_MMA(1, 0, At, B0); PG8_BAR; PG8_SCHED;
            PG8_STAGE(PG8_SB(0, 1), b2 + hstepB, voffB);
            PG8_WAIT_V(6); PG8_BAR; PG8_MMA(1, 1, At, B1); PG8_BAR;
            PG8_LDB(B0, 1, 0); PG8_SCHED; PG8_LDA(At, 1, 0); PG8_STAGE(PG8_SA(0, 1), a2 + hstepA, voffA);
            PG8_WAIT_L(8); PG8_BAR; PG8_WAIT_L(0); PG8_MMA(0, 0, At, B0); PG8_BAR; PG8_SCHED;
            PG8_LDB(B1, 1, 1); PG8_STAGE(PG8_SB(1, 0), b3, voffB);
            PG8_BAR; PG8_WAIT_L(0); PG8_MMA(0, 1, At, B1); PG8_BAR;
            PG8_LDA(At, 1, 1); PG8_STAGE(PG8_SA(1, 0), a3, voffA);
            PG8_BAR; PG8_WAIT_L(0); PG8_MMA(1, 0, At, B0); PG8_BAR; PG8_SCHED;
            PG8_STAGE(PG8_SB(1, 1), b3 + hstepB, voffB);
            PG8_WAIT_V(6); PG8_BAR; PG8_MMA(1, 1, At, B1); PG8_BAR;
            }
        }
        if constexpr (ALIGN_EPI) { if (wr == 0) PG8_BAR; }
        if constexpr (!Epi::AFTER_DRAIN) { E(acc, cur, wr, wc, fr, fq); S.done(cur); }
        if (!has_next) break;
#pragma unroll
        for (int a = 0; a < 2; ++a)
#pragma unroll
            for (int b = 0; b < 2; ++b)
#pragma unroll
                for (int m = 0; m < 4; ++m)
#pragma unroll
                    for (int n = 0; n < 2; ++n) acc[a][b][m][n] = (f32x4){0.f, 0.f, 0.f, 0.f};
        cur = nxt; cA = nA; cB = nB; ++ui;
        if constexpr (ALIGN_EPI) { if (wr == 1) PG8_BAR; }
    }
    PG8_WAIT_V(0);
    if constexpr (!ALIGN_EPI) { if (wr == 0) PG8_BAR; }
    PG8_BAR;
    if constexpr (Epi::AFTER_DRAIN) { E.fused(acc, cur, wr, wc, fr, fq, lds, wid, lane); S.done(cur); }
#undef PG8_SA
#undef PG8_SB
#undef PG8_STAGE
#undef PG8_LDA
#undef PG8_LDB
#undef PG8_MMA
#undef PG8_WAIT_V
#undef PG8_WAIT_L
#undef PG8_BAR
#undef PG8_SCHED
}
}
namespace nsa {
typedef unsigned short bf16_t;
typedef short bf16x8 __attribute__((ext_vector_type(8)));
typedef short s16x4 __attribute__((ext_vector_type(4)));
typedef float f32x16 __attribute__((ext_vector_type(16)));
typedef float f32x4 __attribute__((ext_vector_type(4)));
typedef unsigned u32x4 __attribute__((ext_vector_type(4)));
constexpr int D = 128, KVBLK = 64, SHM_K = 16384, SHM_V = 16384, SEQ = 8192;
constexpr float SCALE = 0.08838834764831845f, C2 = 1.4426950408889634f * SCALE, THR = 8.f;
constexpr int L_KV = 0  , L_WS = 65536, L_SELM = 67584, L_PARK = 69632  , L_IMP = L_PARK  , L_END = L_PARK + 65536;
#define KSWZ(row, colB) ((row) * 256 + ((colB) ^ (((row) & 7) << 4)))
#define SBAR() __builtin_amdgcn_sched_barrier(0)
__device__ __forceinline__ int v_st(int k, int c) { const int kk = (k & ~0xC) | ((k & 4) << 1) | ((k & 8) >> 1); return ((kk >> 3) * 4 + (c >> 5)) * 512 + ((kk & 7) * 32 + (c & 31)) * 2; }
__device__ __forceinline__ int v_rd_base(int lane) { return ((lane & 3) << 3) | (((lane >> 2) & 3) << 6) | (((lane >> 4) & 1) << 5) | (((lane >> 5) & 1) << 8); }
constexpr int v_rd_off(int d0, int ks, int half) { return d0 * 512 + ks * 4096 + half * 2048; }
__device__ __forceinline__ int crow(int r, int hi) { return (r & 3) + 8 * (r >> 2) + 4 * hi; }
__device__ __forceinline__ unsigned cvtpk(float lo, float hi) { unsigned r; asm volatile("v_cvt_pk_bf16_f32 %0, %1, %2" : "=v"(r) : "v"(lo), "v"(hi)); return r; }
__device__ __forceinline__ void mask_tile(f32x16& p0, f32x16& p1, int dq, unsigned W) {
    const float NEG = -__builtin_inff();
#pragma unroll
    for (int r = 0; r < 16; ++r) {
        const int c = (r & 3) + 8 * (r >> 2);
        if ((unsigned)(dq - c) >= W) p0[r] = NEG;
        if ((unsigned)(dq - c - 32) >= W) p1[r] = NEG;
    }
}
__device__ __forceinline__ float max3f(float a, float b, float c) { float r; asm("v_max3_f32 %0, %1, %2, %3" : "=v"(r) : "v"(a), "v"(b), "v"(c)); return r; }
__device__ __forceinline__ float rowmax32(const f32x16& p0, const f32x16& p1) {
    float pmax = max3f(p0[0], p0[1], p0[2]);
#pragma unroll
    for (int r = 3; r < 15; r += 2) pmax = max3f(pmax, p0[r], p0[r + 1]);
    pmax = max3f(pmax, p0[15], p1[0]);
#pragma unroll
    for (int r = 1; r < 15; r += 2) pmax = max3f(pmax, p1[r], p1[r + 1]);
    pmax = fmaxf(pmax, p1[15]);
    auto rr = __builtin_amdgcn_permlane32_swap(__float_as_uint(pmax), __float_as_uint(pmax), false, false);
    return fmaxf(__uint_as_float(rr[0]), __uint_as_float(rr[1]));
}
__device__ __forceinline__ float rowsum32(const f32x16& p0, const f32x16& p1) {
    float ps = 0.f;
#pragma unroll
    for (int r = 0; r < 16; ++r) ps += p0[r];
#pragma unroll
    for (int r = 0; r < 16; ++r) ps += p1[r];
    auto rr = __builtin_amdgcn_permlane32_swap(__float_as_uint(ps), __float_as_uint(ps), false, false);
    return __uint_as_float(rr[0]) + __uint_as_float(rr[1]);
}
__device__ __forceinline__ void packP(const f32x16& p0, const f32x16& p1, bf16x8& pa0, bf16x8& pa1, bf16x8& pa2, bf16x8& pa3) {
#define PK4(P, B_, OUT) do { unsigned a0 = cvtpk(P[B_+0], P[B_+1]), a1 = cvtpk(P[B_+2], P[B_+3]);                          \
        unsigned b0 = cvtpk(P[B_+4], P[B_+5]), b1 = cvtpk(P[B_+6], P[B_+7]);                                             \
        auto r0 = __builtin_amdgcn_permlane32_swap(a0, b0, false, false); auto r1 = __builtin_amdgcn_permlane32_swap(a1, b1, false, false); \
        u32x4 w = {r0[0], r1[0], r0[1], r1[1]}; OUT = *reinterpret_cast<bf16x8*>(&w); } while (0)
    PK4(p0, 0, pa0); PK4(p0, 8, pa1); PK4(p1, 0, pa2); PK4(p1, 8, pa3);
#undef PK4
}
__device__ __forceinline__ void qkt(f32x16& p0, f32x16& p1, const char* K_lds, int r32, int hi, const bf16x8* qr) {
    p0 = f32x16{}; p1 = f32x16{};
    const char* kb[4];
#pragma unroll
    for (int dd = 0; dd < 4; ++dd) kb[dd] = K_lds + KSWZ(r32, (dd * 16 + hi * 8) * 2);
    bf16x8 fa[2], fb[2], fc[2];
#define QK_LD(F, d0) do { const char* a0_ = kb[(d0) & 3] + ((d0) >> 2) * 128; F[0] = *reinterpret_cast<const bf16x8*>(a0_); F[1] = *reinterpret_cast<const bf16x8*>(a0_ + 32 * 256); } while (0)
#define QK_MM(F, d0) do { p0 = __builtin_amdgcn_mfma_f32_32x32x16_bf16(F[0], qr[d0], p0, 0, 0, 0); p1 = __builtin_amdgcn_mfma_f32_32x32x16_bf16(F[1], qr[d0], p1, 0, 0, 0); } while (0)
#define QK_W(n) do { SBAR(); asm volatile("s_waitcnt lgkmcnt(" #n ")" ::: "memory"); SBAR(); } while (0)
    QK_LD(fa, 0); SBAR(); QK_LD(fb, 1); SBAR(); QK_LD(fc, 2);
    QK_W(4); QK_MM(fa, 0); SBAR(); QK_LD(fa, 3);
    QK_W(4); QK_MM(fb, 1); SBAR(); QK_LD(fb, 4);
    QK_W(4); QK_MM(fc, 2); SBAR(); QK_LD(fc, 5);
    QK_W(4); QK_MM(fa, 3); SBAR(); QK_LD(fa, 6);
    QK_W(4); QK_MM(fb, 4); SBAR(); QK_LD(fb, 7);
    QK_W(4); QK_MM(fc, 5);
    QK_W(2); QK_MM(fa, 6);
    QK_W(0); QK_MM(fb, 7);
#undef QK_LD
#undef QK_MM
#undef QK_W
}
__device__ __forceinline__ void pv_tile(f32x16* o, int vb0, bf16x8 pa0, bf16x8 pa1, bf16x8 pa2, bf16x8 pa3) {
#define TRRD(dst, off) asm volatile("ds_read_b64_tr_b16 %0, %1 offset:%2" : "=&v"(dst) : "v"(vb0), "i"(off) : "memory")
#define PV_RD(S_, d0) do { constexpr int b_ = v_rd_off(d0, 0, 0); TRRD(S_##0, b_); TRRD(S_##4, b_ + 2048); TRRD(S_##1, b_ + 4096); TRRD(S_##5, b_ + 6144); TRRD(S_##2, b_ + 8192); TRRD(S_##6, b_ + 10240); TRRD(S_##3, b_ + 12288); TRRD(S_##7, b_ + 14336); } while (0)
#define PV_MM(S_, d0) do { \
        o[d0] = __builtin_amdgcn_mfma_f32_32x32x16_bf16(pa0, (bf16x8){S_##0[0], S_##0[1], S_##0[2], S_##0[3], S_##4[0], S_##4[1], S_##4[2], S_##4[3]}, o[d0], 0, 0, 0);   \
        o[d0] = __builtin_amdgcn_mfma_f32_32x32x16_bf16(pa1, (bf16x8){S_##1[0], S_##1[1], S_##1[2], S_##1[3], S_##5[0], S_##5[1], S_##5[2], S_##5[3]}, o[d0], 0, 0, 0);   \
        o[d0] = __builtin_amdgcn_mfma_f32_32x32x16_bf16(pa2, (bf16x8){S_##2[0], S_##2[1], S_##2[2], S_##2[3], S_##6[0], S_##6[1], S_##6[2], S_##6[3]}, o[d0], 0, 0, 0);   \
        o[d0] = __builtin_amdgcn_mfma_f32_32x32x16_bf16(pa3, (bf16x8){S_##3[0], S_##3[1], S_##3[2], S_##3[3], S_##7[0], S_##7[1], S_##7[2], S_##7[3]}, o[d0], 0, 0, 0); } while (0)
    s16x4 a0, a1, a2, a3, a4, a5, a6, a7, b0, b1, b2, b3, b4, b5, b6, b7;
    PV_RD(a, 0); PV_RD(b, 1);
    asm volatile("s_waitcnt lgkmcnt(8)" ::: "memory"); SBAR(); PV_MM(a, 0); SBAR();
    PV_RD(a, 2);
    asm volatile("s_waitcnt lgkmcnt(8)" ::: "memory"); SBAR(); PV_MM(b, 1); SBAR();
    PV_RD(b, 3);
    asm volatile("s_waitcnt lgkmcnt(8)" ::: "memory"); SBAR(); PV_MM(a, 2); SBAR();
    asm volatile("s_waitcnt lgkmcnt(0)" ::: "memory"); SBAR(); PV_MM(b, 3);
#undef PV_MM
#undef PV_RD
#undef TRRD
}

#ifndef MK_SEC
#define MK_SEC 0
#endif
#define SEC_T(k) do { if (MK_SEC && MODE == 2 && KIND == 2 && blockIdx.x == 0 && threadIdx.x == 0) { const unsigned t_ = (unsigned)__builtin_amdgcn_s_memrealtime(); if (MK_SEC == (k)) { volatile __attribute__((address_space(3))) unsigned* ap_ = (volatile __attribute__((address_space(3))) unsigned*)152592; *ap_ = *ap_ + (t_ - tsec); } tsec = t_; } } while (0)
template <int MODE, int KIND>
__device__ __forceinline__ void attend(const bf16_t* __restrict__ Kg, const bf16_t* __restrict__ Vg, int j_lo, int j_hi, int pos, unsigned W,
                                       char* lds, const bf16x8* qr, float& m_reg, float& l_reg, f32x16* o, float f_imp, float f_o, int qb) {
    constexpr bool NEEDV = MODE != 0;
    const int tid = threadIdx.x, wid = __builtin_amdgcn_readfirstlane(tid >> 6), lane = tid & 63, r32 = lane & 31, hi = lane >> 5;
    float* al_l = (float*)(lds + L_WS) + wid * 64 + 32;
    const int vbase = (int)(uintptr_t)(lds + L_KV + 16384) + v_rd_base(lane);
    const int qloc = wid * 8 + (r32 >> 2);
    int gk[2], gv[2];
#pragma unroll
    for (int i = 0; i < 2; ++i) { const int X = (wid + 8 * i) * 1024 + lane * 16;
        { const int row = X >> 8, colB = (X & 255) ^ ((row & 7) << 4); gk[i] = row * D + (colB >> 1); }
        { const int sub = X >> 9, within = X & 511, kk = (sub >> 2) * 8 + (within >> 6), k = (kk & ~0xC) | ((kk & 4) << 1) | ((kk & 8) >> 1), cc = (sub & 3) * 32 + ((within & 63) >> 1); gv[i] = k * D + cc; } }
    typedef __attribute__((address_space(3))) unsigned las_u32;
    las_u32* ldsw = (las_u32*)(lds + L_KV + wid * 1024);
#define NSA_DMA(j, b) do { const bf16_t* kt_ = Kg + (size_t)(j) * KVBLK * D; \
        __builtin_amdgcn_global_load_lds((const unsigned*)(kt_ + gk[0]), ldsw + (b) * 8192, 16, 0, 0); __builtin_amdgcn_global_load_lds((const unsigned*)(kt_ + gk[1]), ldsw + (b) * 8192 + 2048, 16, 0, 0); \
        if (NEEDV) { const bf16_t* vt_ = Vg + (size_t)(j) * KVBLK * D; \
            __builtin_amdgcn_global_load_lds((const unsigned*)(vt_ + gv[0]), ldsw + (b) * 8192 + 4096, 16, 0, 0); __builtin_amdgcn_global_load_lds((const unsigned*)(vt_ + gv[1]), ldsw + (b) * 8192 + 4096 + 2048, 16, 0, 0); } } while (0)
    if (j_lo >= j_hi) return;
    NSA_DMA(j_lo, 0);
    __syncthreads();
    unsigned tsec = 0; SEC_T(0);
    for (int j = j_lo; j < j_hi; ++j) {
        const int cur = (j - j_lo) & 1;
        if (j + 1 < j_hi) NSA_DMA(j + 1, cur ^ 1);
        const char* K_lds = lds + L_KV + cur * 32768;
        const int kb = j * KVBLK;
        bool rowsel = true, act = true;
        if (KIND == 2) { const unsigned wsel = ((const unsigned*)(lds + L_SELM))[qloc * 4 + (j >> 5)]; rowsel = ((wsel >> (j & 31)) & 1u) != 0u; act = __any(rowsel); }
        if (act) {
            f32x16 p0, p1;
            SEC_T(5);
            qkt(p0, p1, K_lds, r32, hi, qr);
            SEC_T(1);
            if (KIND == 2) {
                if (j == qb) mask_tile(p0, p1, pos - kb - 4 * hi, W);
            } else if (KIND == 0) { if (j == qb || j + 8 == qb) mask_tile(p0, p1, pos - kb - 4 * hi, W); }
            else { if (kb + 63 > 4 * qb - 2) mask_tile(p0, p1, pos - kb - 4 * hi, W); }
            if (MODE == 0) {
                const float pmax = rowmax32(p0, p1), mn = fmaxf(m_reg, pmax), alpha = __builtin_amdgcn_exp2f((m_reg - mn) * C2), mnL = -mn * C2;
#pragma unroll
                for (int r = 0; r < 16; ++r) { p0[r] = __builtin_amdgcn_exp2f(fmaf(p0[r], C2, mnL)); p1[r] = __builtin_amdgcn_exp2f(fmaf(p1[r], C2, mnL)); }
                l_reg = l_reg * alpha + rowsum32(p0, p1); m_reg = mn;
            } else {
                if (MODE == 1) {
                    const float mnL = -m_reg * C2;
#pragma unroll
                    for (int r = 0; r < 16; ++r) { p0[r] = __builtin_amdgcn_exp2f(fmaf(p0[r], C2, mnL)); p1[r] = __builtin_amdgcn_exp2f(fmaf(p1[r], C2, mnL)); }
                    float* imp = (float*)(lds + L_IMP) + qloc * 128 + (kb >> 2);
#pragma unroll
                    for (int half = 0; half < 2; ++half)
#pragma unroll
                        for (int i = 0; i < 4; ++i) {
                            const f32x16& P = half ? p1 : p0;
                            float G = ((P[4 * i] + P[4 * i + 1]) + (P[4 * i + 2] + P[4 * i + 3])) * f_imp, L = P[4 * i + 3] * f_imp;
                            G += __shfl_xor(G, 1); G += __shfl_xor(G, 2); L += __shfl_xor(L, 1); L += __shfl_xor(L, 2);
                            const int jl = half * 8 + 2 * i + hi;
                            if ((r32 & 3) == 0) { atomicAdd(imp + jl, G); if ((kb >> 2) + jl + 1 < 128) atomicAdd(imp + jl + 1, L); }
                        }
#pragma unroll
                    for (int r = 0; r < 16; ++r) { p0[r] *= f_o; p1[r] *= f_o; }
                } else {
                    float pmax = rowmax32(p0, p1); if (KIND == 2 && !rowsel) pmax = -__builtin_inff();
                    float mn, alpha;
                    if (__all((pmax - m_reg) * SCALE <= THR)) { mn = m_reg; alpha = 1.f; }
                    else { mn = fmaxf(m_reg, pmax); alpha = __builtin_amdgcn_exp2f((m_reg - mn) * C2); m_reg = mn; }
                    const float mnL = (KIND == 2 && !rowsel) ? -__builtin_inff() : -mn * C2;
#pragma unroll
                    for (int r = 0; r < 16; ++r) { p0[r] = __builtin_amdgcn_exp2f(fmaf(p0[r], C2, mnL)); p1[r] = __builtin_amdgcn_exp2f(fmaf(p1[r], C2, mnL)); }
                    l_reg = l_reg * alpha + rowsum32(p0, p1);
                    if (__any(alpha < 1.f)) { asm volatile("s_waitcnt lgkmcnt(0)" ::: "memory"); if (hi == 0) al_l[r32] = alpha; asm volatile("s_waitcnt lgkmcnt(0)" ::: "memory");
#pragma unroll
                        for (int r = 0; r < 16; ++r) { const float a = al_l[crow(r, hi)];
#pragma unroll
                            for (int d_ = 0; d_ < 4; ++d_) o[d_][r] *= a; }
                        asm volatile("s_waitcnt lgkmcnt(0)" ::: "memory"); }
                }
                bf16x8 pa0, pa1, pa2, pa3;
                packP(p0, p1, pa0, pa1, pa2, pa3);
                SEC_T(2);
                pv_tile(o, vbase + cur * 32768, pa0, pa1, pa2, pa3);
                SEC_T(3);
            }
        }
        SEC_T(6);
        __syncthreads();
        SEC_T(4);
    }
#undef NSA_DMA
}
template <int STEP>
__device__ __forceinline__ void fold(const f32x16* o, float f, char* lds, int wid, int r32, int hi, bf16_t* orow0  , bool do_store) {
    float* li_l = (float*)(lds + L_WS) + wid * 64;
    unsigned* park = (unsigned*)(lds + L_PARK + wid * 8192);
    asm volatile("s_waitcnt lgkmcnt(0)" ::: "memory");
    if (hi == 0) li_l[r32] = f;
    asm volatile("s_waitcnt lgkmcnt(0)" ::: "memory");
#pragma unroll
    for (int r = 0; r < 16; ++r) { const int wrow = crow(r, hi); const float a = li_l[wrow];
#pragma unroll
        for (int d0 = 0; d0 < 4; ++d0) { float v = o[d0][r] * a, vn = __shfl_xor(v, 1);
            if ((r32 & 1) == 0) { const int idx = wrow * 64 + d0 * 16 + (r32 >> 1);
                if (STEP > 0) { const unsigned u = park[idx]; v += __builtin_bit_cast(float, u << 16); vn += __builtin_bit_cast(float, u & 0xffff0000u); }
                if (STEP < 2) park[idx] = cvtpk(v, vn);
                else if (do_store) *(unsigned*)(orow0 + (size_t)(wid * 8 + (wrow >> 2)) * 2048 + (wrow & 3) * 128 + d0 * 32 + r32) = cvtpk(v, vn); } } }
    asm volatile("s_waitcnt lgkmcnt(0)" ::: "memory");
}

__device__ __forceinline__ float bf2f(bf16_t v) { return __builtin_bit_cast(float, (unsigned)v << 16); }
__device__ __forceinline__ float sigm(float x) { return __builtin_amdgcn_rcpf(1.f + __builtin_amdgcn_exp2f(-1.4426950408889634f * x)); }

__device__ __forceinline__ void nsa_unit(int b, int g, int qb, const bf16_t* Q, const bf16_t* KV4, const bf16_t* KCMP, const bf16_t* VCMP, const bf16_t* NSAG, bf16_t* OUT, char* lds, bool do_store) {
    const int tid = threadIdx.x, wid = __builtin_amdgcn_readfirstlane(tid >> 6), lane = tid & 63, r32 = lane & 31, hi = lane >> 5;
    const int ql = wid * 8 + (r32 >> 2), h = r32 & 3, t = qb * 64 + ql;
    const size_t row = (size_t)b * SEQ + t;
    bf16x8 qr[8];
    { const bf16_t* qp = Q + row * 2048 + g * 512 + h * 128 + hi * 8;
#pragma unroll
      for (int d0 = 0; d0 < 8; ++d0) qr[d0] = *(const bf16x8*)(qp + d0 * 16); }
    { f32x4* z = (f32x4*)((float*)(lds + L_IMP) + wid * 8 * 128) + lane;
#pragma unroll
      for (int i = 0; i < 4; ++i) z[64 * i] = (f32x4){0.f, 0.f, 0.f, 0.f}; }
    const float gc = sigm(bf2f(NSAG[row * 64 + 0 * 16 + g * 4 + h])), gs = sigm(bf2f(NSAG[row * 64 + 1 * 16 + g * 4 + h])), gw = sigm(bf2f(NSAG[row * 64 + 2 * 16 + g * 4 + h]));
    const int bg = b * 4 + g;
    const size_t TSTR = (size_t)8 * SEQ * D;
    f32x16 o[4];
#pragma unroll
    for (int d_ = 0; d_ < 4; ++d_) o[d_] = f32x16{};
    {
        const bf16_t* kc = KCMP + (size_t)bg * 512 * D; const bf16_t* vc = VCMP + (size_t)bg * 512 * D;
        const int nmax = (t - 31) >> 4, jh = (4 * qb + 3 + 63) >> 6;
        float m1 = -1e30f, l1 = 0.f;
        attend<0, 1>(kc, vc, 0, jh, nmax, 0x7fffffffu, lds, qr, m1, l1, o, 0.f, 0.f, qb);
        const float inv_l = l1 > 0.f ? 1.f / l1 : 0.f;
        attend<1, 1>(kc, vc, 0, jh, nmax, 0x7fffffffu, lds, qr, m1, l1, o, inv_l, gc * inv_l, qb);
    }
    {
        asm volatile("s_waitcnt lgkmcnt(0)" ::: "memory");
        unsigned* SELM = (unsigned*)(lds + L_SELM);
        const unsigned* IMPu = (const unsigned*)(lds + L_IMP);
        if (qb >= 16) {
            for (int i = 0; i < 8; ++i) {
                const int q = wid * 8 + i;
                const unsigned vlo = IMPu[q * 128 + lane], vhi = IMPu[q * 128 + 64 + lane];
                const bool clo = (lane >= 1) && (lane <= qb - 2), chi = (64 + lane <= qb - 2);
                unsigned T = 0u;
                for (int bit = 30; bit >= 0; --bit) { const unsigned c = T | (1u << bit);
                    const int cnt = __popcll(__ballot(clo && vlo >= c)) + __popcll(__ballot(chi && vhi >= c));
                    if (cnt >= 13) T = c; }
                unsigned long long sel_lo = __ballot(clo && vlo > T), sel_hi = __ballot(chi && vhi > T);
                unsigned long long eq_lo = __ballot(clo && vlo == T), eq_hi = __ballot(chi && vhi == T);
                int need = 13 - __popcll(sel_lo) - __popcll(sel_hi);
                for (; need > 0; --need) {
                    if (eq_lo) { const unsigned long long lb = eq_lo & (0ull - eq_lo); sel_lo |= lb; eq_lo ^= lb; }
                    else if (eq_hi) { const unsigned long long lb = eq_hi & (0ull - eq_hi); sel_hi |= lb; eq_hi ^= lb; }
                }
                sel_lo |= 1ull;
                if (qb - 1 < 64) sel_lo |= 1ull << (qb - 1); else sel_hi |= 1ull << (qb - 1 - 64);
                if (qb < 64) sel_lo |= 1ull << qb; else sel_hi |= 1ull << (qb - 64);
                if (lane == 0) { SELM[q * 4 + 0] = (unsigned)sel_lo; SELM[q * 4 + 1] = (unsigned)(sel_lo >> 32); SELM[q * 4 + 2] = (unsigned)sel_hi; SELM[q * 4 + 3] = (unsigned)(sel_hi >> 32); }
            }
        } else {
            if (lane < 8) { const int q = wid * 8 + lane; SELM[q * 4 + 0] = (2u << qb) - 1u; SELM[q * 4 + 1] = 0u; SELM[q * 4 + 2] = 0u; SELM[q * 4 + 3] = 0u; }
        }
        asm volatile("s_waitcnt lgkmcnt(0)" ::: "memory");
    }
    __syncthreads();
    fold<0>(o, 1.f, lds, wid, r32, hi, nullptr, false);
    {
        const bf16_t* ks = KV4 + 0 * TSTR + (size_t)bg * SEQ * D; const bf16_t* vs = KV4 + 1 * TSTR + (size_t)bg * SEQ * D;
#pragma unroll
        for (int d_ = 0; d_ < 4; ++d_) o[d_] = f32x16{};
        float m = -1e30f, l = 0.f;
        attend<2, 2>(ks, vs, 0, qb + 1, t, 0x7fffffffu, lds, qr, m, l, o, 0.f, 0.f, qb);
        fold<1>(o, l > 0.f ? gs / l : 0.f, lds, wid, r32, hi, nullptr, false);
    }
    {
        const bf16_t* kw = KV4 + 2 * TSTR + (size_t)bg * SEQ * D; const bf16_t* vw = KV4 + 3 * TSTR + (size_t)bg * SEQ * D;
#pragma unroll
        for (int d_ = 0; d_ < 4; ++d_) o[d_] = f32x16{};
        float m = -1e30f, l = 0.f;
        attend<2, 0>(kw, vw, qb >= 8 ? qb - 8 : 0, qb + 1, t, 512u, lds, qr, m, l, o, 0.f, 0.f, qb);
        fold<2>(o, l > 0.f ? gw / l : 0.f, lds, wid, r32, hi, OUT + ((size_t)b * SEQ + qb * 64) * 2048 + g * 512, do_store);
    }
    __syncthreads();
}
#undef KSWZ
#undef SBAR
}
constexpr int NWAVES = 8;
constexpr int SEQ = 8192, M = 2 * SEQ, DM = 2048, FF = 5632, INW_SRC = 10288, INW = 10496, PW = 1024;
constexpr float RMS_EPS = 1e-6f;
constexpr size_t MiB = 1u << 20;
constexpr size_t WS_WIN = 0, WS_WPU = 42 * MiB, WS_WNU = 46 * MiB, WS_WOUT = 54 * MiB, WS_POOLW = 62 * MiB, WS_CW1 = 63 * MiB, WS_CW2 = 67 * MiB;
constexpr size_t WS_PEBP = 68 * MiB, WS_PEB = 68 * MiB + 512 * 1024, WS_SS = 68 * MiB + 768 * 1024  , WS_HIDC = 69 * MiB, WS_KVCMP = 73 * MiB;
constexpr size_t WS_CTL = 75 * MiB, CTL_BYTES = 16384;
constexpr size_t WS_WGU = 76 * MiB, WS_WD = 120 * MiB, WS_GNSA = 76 * MiB;
constexpr size_t WS_XN = 142 * MiB;
constexpr size_t WS_HID = 206 * MiB, WS_XP = 206 * MiB, WS_Q = 238 * MiB, WS_NSAG = 302 * MiB  , WS_KV4 = 304 * MiB, WS_HIDCP = 368 * MiB;
constexpr size_t WS_APOOL = 206 * MiB  ;
constexpr size_t WS_GPOOL = 384 * MiB, WS_KCVC = 448 * MiB, WS_POOLED = 481 * MiB, WS_END = 513 * MiB;
static_assert(WS_WIN + (size_t)INW * DM * 2 <= WS_WPU && WS_WGU + (size_t)2 * FF * DM * 2 <= WS_WD && WS_WD + (size_t)DM * FF * 2 <= WS_XN && WS_GNSA + (size_t)M * DM * 2 <= WS_XN, "ws map 1");
static_assert(WS_HID + (size_t)M * FF * 2 <= WS_GPOOL && WS_KV4 + (size_t)4 * M * 512 * 2 <= WS_HIDCP && WS_HIDCP + (size_t)2 * 8192 * 256 * 4 <= WS_GPOOL && WS_NSAG + (size_t)M * 64 * 2 <= WS_KV4 && WS_KCVC + (size_t)2 * M * 512 * 2 + 8192 <= WS_POOLED && WS_POOLED + (size_t)M * PW * 2 <= WS_END, "ws map 2");
constexpr int LDS_BYTES = 153600;
#define GAS __attribute__((address_space(1)))
#define LAS __attribute__((address_space(3)))
typedef unsigned short bf16;
typedef unsigned v4u __attribute__((ext_vector_type(4)));
typedef float f32x4 __attribute__((ext_vector_type(4)));
#define LDS_WAIT() asm volatile("s_waitcnt lgkmcnt(0)" ::: "memory")
__device__ __forceinline__ unsigned f2bf(float f) { unsigned u = __builtin_bit_cast(unsigned, f); return (u + 0x7fffu + ((u >> 16) & 1u)) >> 16; }
__device__ __forceinline__ unsigned pk2(float lo, float hi) { return f2bf(lo) | (f2bf(hi) << 16); }
__device__ __forceinline__ float wave_sum(float v) {
#pragma unroll
    for (int o = 1; o < 64; o <<= 1) v += __shfl_xor(v, o);
    return v;
}
struct TItem { int c0, nv, drow, k0; };
__device__ __forceinline__ void titem_load(float (&v)[32], const float* W, int N, const TItem& t, int lane) {
    const bool cv = 4 * (lane & 7) < t.nv; const float* p = W + (size_t)(t.k0 + (lane >> 3)) * N + t.c0 + 4 * (lane & 7);
#pragma unroll
    for (int i = 0; i < 8; ++i) { f32x4 q = cv ? *(const f32x4*)(p + (size_t)(8 * i) * N) : (f32x4){0.f, 0.f, 0.f, 0.f}; v[4 * i] = q.x; v[4 * i + 1] = q.y; v[4 * i + 2] = q.z; v[4 * i + 3] = q.w; }
}
__device__ __forceinline__ void titem_store(const float (&v)[32], int K, bf16* WT, const TItem& t, LAS float* scr, int lane) {
#pragma unroll
    for (int i = 0; i < 8; ++i)
#pragma unroll
        for (int e = 0; e < 4; ++e) scr[(8 * i + (lane >> 3)) * 33 + 4 * (lane & 7) + e] = v[4 * i + e];
    LDS_WAIT(); asm volatile("" ::: "memory");
    const int c = lane & 7;
#pragma unroll
    for (int j = 0; j < 4; ++j) { const int n = (lane >> 3) + 8 * j; const LAS float* s = scr + (8 * c) * 33 + n;
        v4u o; o.x = pk2(s[0 * 33], s[1 * 33]); o.y = pk2(s[2 * 33], s[3 * 33]); o.z = pk2(s[4 * 33], s[5 * 33]); o.w = pk2(s[6 * 33], s[7 * 33]);
        if (n < t.nv) *(v4u*)(WT + (size_t)(t.drow + n) * K + t.k0 + 8 * c) = o; }
    LDS_WAIT(); asm volatile("" ::: "memory");
}
__device__ __forceinline__ void transpose_seg(const float* W, int K, int N, int src0, int ncols, bf16* WT, int drow0, bool gu, LAS float* scr, int lane, int gw, int NGW, int& base) {
    const int nblk = (ncols + 31) >> 5, nitems = (K >> 6) * nblk;
    int first = (gw - base) % NGW; if (first < 0) first += NGW;
    base = (base + nitems) % NGW;
#define TI_DECODE(t, it_) do { const int kb_ = (it_) / nblk, nb_ = (it_) - kb_ * nblk, c0_ = nb_ * 32; (t).nv = (ncols - c0_) < 32 ? (ncols - c0_) : 32; \
        (t).drow = gu ? (256 * (c0_ >> 7) + (c0_ & 127) + drow0) : (drow0 + c0_); (t).c0 = src0 + c0_; (t).k0 = kb_ * 64; } while (0)
    int it = first; if (it >= nitems) return;
    TItem tc, tn; float v[32], vn[32];
    TI_DECODE(tc, it); titem_load(v, W, N, tc, lane);
    for (;;) {
        const int itn = it + NGW; const bool more = itn < nitems;
        if (more) { TI_DECODE(tn, itn); titem_load(vn, W, N, tn, lane); }
        titem_store(v, K, WT, tc, scr, lane);
        if (!more) break;
#pragma unroll
        for (int i = 0; i < 32; ++i) v[i] = vn[i];
        tc = tn; it = itn;
    }
#undef TI_DECODE
}
__device__ __forceinline__ void rms_row_bf16(const float* xrow, const float* g, bf16* orow, int lane) {
    const f32x4* xr = (const f32x4*)xrow + lane; const f32x4* gr = (const f32x4*)g + lane;
    f32x4 v[8]; float s = 0.f;
#pragma unroll
    for (int j = 0; j < 8; ++j) { v[j] = xr[64 * j]; s += (v[j].x * v[j].x + v[j].y * v[j].y) + (v[j].z * v[j].z + v[j].w * v[j].w); }
    const float rs = 1.f / sqrtf(wave_sum(s) * (1.f / DM) + RMS_EPS);
    unsigned long long* o8 = (unsigned long long*)orow + lane;
#pragma unroll
    for (int j = 0; j < 8; ++j) { const f32x4 gg = gr[64 * j];
        o8[64 * j] = (unsigned long long)pk2(v[j].x * rs * gg.x, v[j].y * rs * gg.y) | ((unsigned long long)pk2(v[j].z * rs * gg.z, v[j].w * rs * gg.w) << 32); }
}
__device__ __forceinline__ void xg_row_bf16(const float* xrow, const float* g, bf16* orow, float* ssp, int lane) {
    const f32x4* xr = (const f32x4*)xrow + lane; const f32x4* gr = (const f32x4*)g + lane;
    f32x4 v[8]; float s = 0.f;
#pragma unroll
    for (int j = 0; j < 8; ++j) { v[j] = xr[64 * j]; s += (v[j].x * v[j].x + v[j].y * v[j].y) + (v[j].z * v[j].z + v[j].w * v[j].w); }
    s = wave_sum(s); if (lane == 0) *ssp = s;
    unsigned long long* o8 = (unsigned long long*)orow + lane;
#pragma unroll
    for (int j = 0; j < 8; ++j) { const f32x4 gg = gr[64 * j];
        o8[64 * j] = (unsigned long long)pk2(v[j].x * gg.x, v[j].y * gg.y) | ((unsigned long long)pk2(v[j].z * gg.z, v[j].w * gg.w) << 32); }
}
__device__ __forceinline__ void rms_row_f32(float* xrow, const float* g, int lane) {
    f32x4* xr = (f32x4*)xrow + lane; const f32x4* gr = (const f32x4*)g + lane;
    f32x4 v[8]; float s = 0.f;
#pragma unroll
    for (int j = 0; j < 8; ++j) { v[j] = xr[64 * j]; s += (v[j].x * v[j].x + v[j].y * v[j].y) + (v[j].z * v[j].z + v[j].w * v[j].w); }
    const float rs = 1.f / sqrtf(wave_sum(s) * (1.f / DM) + RMS_EPS);
#pragma unroll
    for (int j = 0; j < 8; ++j) { const f32x4 gg = gr[64 * j]; xr[64 * j] = (f32x4){v[j].x * rs * gg.x, v[j].y * rs * gg.y, v[j].z * rs * gg.z, v[j].w * rs * gg.w}; }
}
template <int WIN> __device__ __forceinline__ void pool_rows(const bf16* XP, bf16* POOLED, int rp, int gi, int lane) {
    const int row = 2 * rp + (lane >> 5), c8 = gi * 256 + (lane & 31) * 8, t = row & (SEQ - 1);
    v4u w[WIN];
#pragma unroll
    for (int j = 0; j < WIN; ++j) { const int rr = (j <= t) ? row - j : row; w[j] = *(const v4u*)(XP + (size_t)rr * PW + c8); }
    float acc[8] = {0.f, 0.f, 0.f, 0.f, 0.f, 0.f, 0.f, 0.f};
#pragma unroll
    for (int j = 0; j < WIN; ++j) { const float k = (j <= t) ? 1.f : 0.f;
        acc[0] += k * pg8::bf_lo(w[j].x); acc[1] += k * pg8::bf_hi(w[j].x); acc[2] += k * pg8::bf_lo(w[j].y); acc[3] += k * pg8::bf_hi(w[j].y);
        acc[4] += k * pg8::bf_lo(w[j].z); acc[5] += k * pg8::bf_hi(w[j].z); acc[6] += k * pg8::bf_lo(w[j].w); acc[7] += k * pg8::bf_hi(w[j].w); }
    const int n = (t + 1) < WIN ? (t + 1) : WIN; const float inv = 1.f / (float)n;
    v4u o; o.x = pk2(acc[0] * inv - pg8::bf_lo(w[0].x), acc[1] * inv - pg8::bf_hi(w[0].x)); o.y = pk2(acc[2] * inv - pg8::bf_lo(w[0].y), acc[3] * inv - pg8::bf_hi(w[0].y));
    o.z = pk2(acc[4] * inv - pg8::bf_lo(w[0].z), acc[5] * inv - pg8::bf_hi(w[0].z)); o.w = pk2(acc[6] * inv - pg8::bf_lo(w[0].w), acc[7] * inv - pg8::bf_hi(w[0].w));
    *(v4u*)(POOLED + (size_t)row * PW + c8) = o;
}
__device__ __forceinline__ void pool_item(const bf16* XP, bf16* POOLED, int rp, int gi, int lane) {
    if (gi == 0) pool_rows<2>(XP, POOLED, rp, gi, lane); else if (gi == 1) pool_rows<4>(XP, POOLED, rp, gi, lane);
    else if (gi == 2) pool_rows<8>(XP, POOLED, rp, gi, lane); else pool_rows<16>(XP, POOLED, rp, gi, lane);
}
using pg8::u32x4;
struct FWin {
    struct Pre {}; __device__ __forceinline__ void load(Pre&, int, int) const {}
    bf16 *XP, *Q, *KCVC, *KV4, *GPOOL, *GNSA;
    __device__ __forceinline__ void operator()(int row, int col, int pn, pg8::f32x4 v0, pg8::f32x4 v1, const Pre& pre) const {
        const u32x4 w = pg8::pack8(v0, v1); bf16* dst;
        if (pn < 4) dst = XP + (size_t)row * 1024 + col;
        else if (pn < 12) dst = Q + (size_t)row * 2048 + (col - 1024);
        else if (pn < 24) { const int c = col - 3072, tensor = c >> 9, g = (c >> 7) & 3, d = c & 127, b = row >> 13, t = row & 8191;
            dst = (tensor < 2 ? KCVC + (size_t)tensor * 8 * SEQ * 128 : KV4 + (size_t)(tensor - 2) * 8 * SEQ * 128) + ((size_t)(b * 4 + g) * SEQ + t) * 128 + d; }
        else if (pn < 32) dst = GPOOL + (size_t)row * 2048 + (col - 6144);
        else dst = GNSA + (size_t)row * 2048 + (col - 8192);
        *(u32x4*)dst = w;
    }
};
struct FSiluBias { bf16* O; const float* bias;
    struct Pre {}; __device__ __forceinline__ void load(Pre&, int, int) const {}
    __device__ __forceinline__ void operator()(int row, int col, int pn, pg8::f32x4 v0, pg8::f32x4 v1, const Pre& pre) const {
        const float* bp = bias + ((row >> 12) << 8) + col; const pg8::f32x4 b0 = *(const pg8::f32x4*)bp, b1 = *(const pg8::f32x4*)(bp + 4);
#pragma unroll
        for (int j = 0; j < 4; ++j) { v0[j] = pg8::siluf_(v0[j] + b0[j]); v1[j] = pg8::siluf_(v1[j] + b1[j]); }
        *(u32x4*)(O + (size_t)row * 256 + col) = pg8::pack8(v0, v1);
    }
};
struct FGates { bf16* O;
    struct Pre {}; __device__ __forceinline__ void load(Pre&, int, int) const {}
    __device__ __forceinline__ void operator()(int row, int col, int pn, pg8::f32x4 v0, pg8::f32x4 v1, const Pre& pre) const {
        if (col < 64) *(u32x4*)(O + (size_t)row * 64 + col) = pg8::pack8(v0, v1);
    }
};
struct FPartial { float* O;
    struct Pre {}; __device__ __forceinline__ void load(Pre&, int, int) const {}
    __device__ __forceinline__ void operator()(int row, int col, int pn, pg8::f32x4 v0, pg8::f32x4 v1, const Pre& pre) const {
        float* p = O + ((size_t)pn * 8192 + row) * 256 + (col & 255); *(pg8::f32x4*)p = v0; *(pg8::f32x4*)(p + 4) = v1;
    }
};
struct FStore128 { bf16* O;
    struct Pre {}; __device__ __forceinline__ void load(Pre&, int, int) const {}
    __device__ __forceinline__ void operator()(int row, int col, int pn, pg8::f32x4 v0, pg8::f32x4 v1, const Pre& pre) const {
        if (col < 128) *(u32x4*)(O + (size_t)row * 128 + col) = pg8::pack8(v0, v1);
    }
};
struct FPool { bf16* O; const float* scale;
    struct Pre {}; __device__ __forceinline__ void load(Pre&, int, int) const {}
    __device__ __forceinline__ void operator()(int row, int col, int pn, pg8::f32x4 v0, pg8::f32x4 v1, const Pre& pre) const {
        const pg8::f32x4 s0 = *(const pg8::f32x4*)(scale + col), s1 = *(const pg8::f32x4*)(scale + col + 4);
        *(u32x4*)(O + (size_t)row * PW + col) = pg8::pack8(v0 * s0, v1 * s1);
    }
};
struct FGate { bf16* MG; const bf16* Gt; bool add;
    struct Pre { u32x4 g, m; };
    __device__ __forceinline__ void load(Pre& p, int row, int col) const { const size_t off = (size_t)row * DM + col; p.g = *(const u32x4*)(Gt + off); if (add) p.m = *(const u32x4*)(MG + off); }
    __device__ __forceinline__ void operator()(int row, int col, int pn, pg8::f32x4 v0, pg8::f32x4 v1, const Pre& pre) const {
        const size_t off = (size_t)row * DM + col;
        const u32x4 gw = pre.g;
        pg8::f32x4 r0, r1;
        r0[0] = pg8::sigmoidf_(pg8::bf_lo(gw.x)) * v0[0]; r0[1] = pg8::sigmoidf_(pg8::bf_hi(gw.x)) * v0[1]; r0[2] = pg8::sigmoidf_(pg8::bf_lo(gw.y)) * v0[2]; r0[3] = pg8::sigmoidf_(pg8::bf_hi(gw.y)) * v0[3];
        r1[0] = pg8::sigmoidf_(pg8::bf_lo(gw.z)) * v1[0]; r1[1] = pg8::sigmoidf_(pg8::bf_hi(gw.z)) * v1[1]; r1[2] = pg8::sigmoidf_(pg8::bf_lo(gw.w)) * v1[2]; r1[3] = pg8::sigmoidf_(pg8::bf_hi(gw.w)) * v1[3];
        if (add) { const u32x4 mw = pre.m;
            r0[0] += pg8::bf_lo(mw.x); r0[1] += pg8::bf_hi(mw.x); r0[2] += pg8::bf_lo(mw.y); r0[3] += pg8::bf_hi(mw.y);
            r1[0] += pg8::bf_lo(mw.z); r1[1] += pg8::bf_hi(mw.z); r1[2] += pg8::bf_lo(mw.w); r1[3] += pg8::bf_hi(mw.w); }
        *(u32x4*)(MG + off) = pg8::pack8(r0, r1);
    }
};

#define XB_TMO      128
#define XB_XCNT(j)  (256  + 64 * (j))
#define XB_XSUB(j)  (1280 + 64 * (j))
#define XB_XGEN(j)  (2304 + 64 * (j))
#define XB_TOP      3328
#define XB_TOPGEN   3392
#define XCD_BAR_WORDS 3456
#define XB_SPIN_CAP (1u << 18)

__device__ __forceinline__ unsigned xb_ld(unsigned* p)              { return __hip_atomic_load(p, __ATOMIC_RELAXED, __HIP_MEMORY_SCOPE_AGENT); }
__device__ __forceinline__ unsigned xb_add(unsigned* p, unsigned v) { return __hip_atomic_fetch_add(p, v, __ATOMIC_RELAXED, __HIP_MEMORY_SCOPE_AGENT); }
__device__ __forceinline__ unsigned xb_xcc_id() { return (unsigned)__builtin_amdgcn_s_getreg((3 << 11) | 20) & 0xFu; }
#define XB_SPIN(cond, bar) do { unsigned _sp = 0; while (cond) { __builtin_amdgcn_s_sleep(1); \
    if ((++_sp & 255u) == 0u) { if (xb_ld(&(bar)[XB_TMO])) break; if (_sp > XB_SPIN_CAP) { atomicAdd(&(bar)[XB_TMO], 1u); break; } } } } while (0)

struct XcdBarrier {
    unsigned* bar; unsigned x;
    volatile LAS unsigned* st;
};

__device__ __forceinline__ XcdBarrier xcd_barrier_post(unsigned* bar, volatile LAS unsigned* st) {
    XcdBarrier b; b.bar = bar; b.x = xb_xcc_id(); b.st = st;
    if (threadIdx.x == 0) (void)xb_add(&bar[XB_XCNT(b.x)], 1u);
    return b;
}
__device__ __forceinline__ void xcd_barrier_complete(unsigned* bar, unsigned x, unsigned& nloc, unsigned& nx) {
    const unsigned G = gridDim.x * gridDim.y * gridDim.z;
    unsigned sum, cnt, mine, sp = 0u;
    for (;;) {
        sum = 0u; cnt = 0u; mine = 0u;
#pragma unroll
        for (unsigned j = 0; j < 16; ++j) { const unsigned c = xb_ld(&bar[XB_XCNT(j)]); sum += c; cnt += (c > 0u) ? 1u : 0u; mine = (j == x) ? c : mine; }
        if (sum == G) break;
        __builtin_amdgcn_s_sleep(1);
        if ((++sp & 255u) == 0u) { if (xb_ld(&bar[XB_TMO])) break; if (sp > XB_SPIN_CAP) { atomicAdd(&bar[XB_TMO], 1u); break; } }
    }
    nloc = mine > 0u ? mine : 1u; nx = cnt > 0u ? cnt : 1u;
}

__device__ __forceinline__ void xcd_barrier(const XcdBarrier& b) {
    asm volatile("s_waitcnt vmcnt(0)" ::: "memory");
    __syncthreads();
    if (threadIdx.x == 0) {
        unsigned* bar = b.bar;
        __builtin_amdgcn_s_waitcnt(0);
        unsigned nloc = b.st[0], nx = b.st[1];
        if (nloc == 0u) { xcd_barrier_complete(bar, b.x, nloc, nx); b.st[0] = nloc; b.st[1] = nx; }
        const unsigned old = xb_add(&bar[XB_XSUB(b.x)], 1u);
        const unsigned gen = old / nloc;
        if (old + 1u == (gen + 1u) * nloc) {
            __builtin_amdgcn_fence(__ATOMIC_RELEASE, "agent");
            asm volatile("s_waitcnt vmcnt(0)" ::: "memory");
            const unsigned og = xb_add(&bar[XB_TOP], 1u);
            const unsigned tg = og / nx;
            if (og + 1u == (tg + 1u) * nx) xb_add(&bar[XB_TOPGEN], 1u);
            else XB_SPIN(xb_ld(&bar[XB_TOPGEN]) == tg, bar);
            __builtin_amdgcn_fence(__ATOMIC_ACQUIRE, "agent");
            xb_add(&bar[XB_XGEN(b.x)], 1u);
            asm volatile("s_waitcnt vmcnt(0)" ::: "memory");
        } else {
            XB_SPIN(xb_ld(&bar[XB_XGEN(b.x)]) == gen, bar);
            __builtin_amdgcn_fence(__ATOMIC_ACQUIRE, "agent");
            asm volatile("s_waitcnt vmcnt(0)" ::: "memory");
        }
    }
    __syncthreads();
}

struct Args { const float* in[23]; float* out; unsigned char* ws; int ph_lo, ph_hi; };
enum { I_X = 0, I_F1N, I_F1G, I_F1U, I_F1D, I_MIXN, I_WIN, I_POOLW, I_POOLS, I_PEK, I_PEV, I_CKW1, I_CKW2, I_CVW1, I_CVW2, I_WPU, I_WNU, I_WOUT, I_F2N, I_F2G, I_F2U, I_F2D, I_FINN };
constexpr int N_PHASES = 12;

template <class Epi> __device__ __forceinline__ void run_gemm(LAS unsigned char* lds, const bf16* A, int lda, const bf16* Bt, int ldb, int Mr, int N, int K, int G, int c, const Epi& E, int apn = 0, int bdiv = 1 << 30, int bbytes = 0, int bpn = -1) {
    pg8::Gemm g{A, Bt, Mr, N, K, lda, ldb, apn, bpn >= 0 ? bpn : 256 * ldb * 2, bdiv, bbytes}; pg8::StaticOrder S; S.init(Mr, N, G, c);
    pg8::gemm_phase<Epi, pg8::StaticOrder, true, true>(lds, g, S, E);
    __syncthreads();
}

__global__ void __launch_bounds__(NWAVES * 64, 2) mk_fwd(Args a) {
    extern __shared__ __attribute__((aligned(16))) unsigned char lds_raw[];
    LAS unsigned char* lds = (LAS unsigned char*)lds_raw;
    const int tid = threadIdx.x, lane = tid & 63, wave = __builtin_amdgcn_readfirstlane(tid >> 6);
    const int G = gridDim.x, bx = blockIdx.x;
    const int vcu = (G % 8 == 0) ? (bx % 8) * (G / 8) + bx / 8 : bx;
    const int gw = vcu * NWAVES + wave, NGW = G * NWAVES;
    unsigned char* ws = a.ws;
    bf16* Win_t = (bf16*)(ws + WS_WIN); bf16* Wpu_t = (bf16*)(ws + WS_WPU); bf16* Wnu_t = (bf16*)(ws + WS_WNU); bf16* Wout_t = (bf16*)(ws + WS_WOUT);
    bf16* Poolw_t = (bf16*)(ws + WS_POOLW); bf16* Cw1_t = (bf16*)(ws + WS_CW1); bf16* Cw2_t = (bf16*)(ws + WS_CW2);
    float* PEBP = (float*)(ws + WS_PEBP); float* PEB = (float*)(ws + WS_PEB); float* SS0 = (float*)(ws + WS_SS); float* SS1 = SS0 + M; float* SS2 = SS1 + M;
    bf16* HIDC = (bf16*)(ws + WS_HIDC); bf16* KVCMP = (bf16*)(ws + WS_KVCMP);
    bf16* Wgu_t = (bf16*)(ws + WS_WGU); bf16* Wd_t = (bf16*)(ws + WS_WD); bf16* GNSA = (bf16*)(ws + WS_GNSA);
    bf16* XN = (bf16*)(ws + WS_XN); bf16* POOLED = (bf16*)(ws + WS_POOLED); bf16* APOOL = (bf16*)(ws + WS_APOOL); float* HIDCP = (float*)(ws + WS_HIDCP);
    bf16* HID = (bf16*)(ws + WS_HID); bf16* XP = (bf16*)(ws + WS_XP); bf16* Q = (bf16*)(ws + WS_Q); bf16* KV4 = (bf16*)(ws + WS_KV4); bf16* KCVC = (bf16*)(ws + WS_KCVC); bf16* NSAG = (bf16*)(ws + WS_NSAG);
    bf16* GPOOL = (bf16*)(ws + WS_GPOOL);
    float* H = a.out;
    const int lo = a.ph_lo, hi = a.ph_hi;
    volatile LAS unsigned* xb_st = (volatile LAS unsigned*)(lds + 152608);
    if (tid == 0) { xb_st[0] = 0u; xb_st[1] = 0u; }
    __syncthreads();
    XcdBarrier xbar; xbar.bar = (unsigned*)(ws + WS_CTL); xbar.x = 0; xbar.st = nullptr;
    if (hi - lo > 1) xbar = xcd_barrier_post((unsigned*)(ws + WS_CTL), xb_st);
#ifndef MK_PHASE_MASK
#define MK_PHASE_MASK 0xfff
#endif
#define IN(k) (((MK_PHASE_MASK >> (k)) & 1) && lo <= (k) && (k) < hi)
#ifndef MK_REP_MASK
#define MK_REP_MASK 0
#endif
#define REP(k) ((MK_REP_MASK >> (k)) & 1)
#ifndef MK_PROBE_K
#define MK_PROBE_K -1
#endif
#ifndef MK_PROBE_MULT
#define MK_PROBE_MULT 1
#endif
    volatile LAS unsigned long long* stamps = (volatile LAS unsigned long long*)(lds + 152576);
    if (bx == 0 && tid == 0) *(volatile LAS unsigned*)(lds + 152592) = 0u;
    if (MK_PROBE_K == 0 && bx == 0 && tid == 0) stamps[0] = __builtin_amdgcn_s_memrealtime();
#ifndef MK_XSYNC
#define MK_XSYNC 0
#endif
#define SEAM(k) do { if (IN(k) && IN((k) + 1)) { if (a.ph_lo < 0) { __syncthreads(); cg::this_grid().sync(); }     \
            xcd_barrier(xbar); for (int xs_ = 0; xs_ < ((k) == 1 ? MK_XSYNC : 0); ++xs_) xcd_barrier(xbar); } \
        if (MK_PROBE_K >= 0 && bx == 0 && tid == 0) { if ((k) == MK_PROBE_K - 1) stamps[0] = __builtin_amdgcn_s_memrealtime(); if ((k) == MK_PROBE_K) stamps[1] = __builtin_amdgcn_s_memrealtime(); } } while (0)
    LAS float* scr = (LAS float*)(lds + wave * 16384);

    if (IN(0)) for (int rep = 0; rep <= REP(0); ++rep) {
        int base = 0;
        transpose_seg(a.in[I_F1G], DM, FF, 0, FF, Wgu_t, 0, true, scr, lane, gw, NGW, base);
        transpose_seg(a.in[I_F1U], DM, FF, 0, FF, Wgu_t, 128, true, scr, lane, gw, NGW, base);
        transpose_seg(a.in[I_F1D], FF, DM, 0, DM, Wd_t, 0, false, scr, lane, gw, NGW, base);
        transpose_seg(a.in[I_WIN], DM, INW_SRC, 0, 6144, Win_t, 0, false, scr, lane, gw, NGW, base);
        transpose_seg(a.in[I_WIN], DM, INW_SRC, 6192, 2048, Win_t, 6144, false, scr, lane, gw, NGW, base);
        transpose_seg(a.in[I_WIN], DM, INW_SRC, 8240, 2048, Win_t, 8192, false, scr, lane, gw, NGW, base);
        transpose_seg(a.in[I_WIN], DM, INW_SRC, 6144, 48, Win_t, 10240, false, scr, lane, gw, NGW, base);
        transpose_seg(a.in[I_WPU], PW, DM, 0, DM, Wpu_t, 0, false, scr, lane, gw, NGW, base);
        transpose_seg(a.in[I_WNU], DM, DM, 0, DM, Wnu_t, 0, false, scr, lane, gw, NGW, base);
        transpose_seg(a.in[I_WOUT], DM, DM, 0, DM, Wout_t, 0, false, scr, lane, gw, NGW, base);
        for (int gi = 0; gi < 4; ++gi) transpose_seg(a.in[I_POOLW] + (size_t)gi * 65536, 256, 256, 0, 256, Poolw_t + (size_t)gi * 65536, 0, false, scr, lane, gw, NGW, base);
        transpose_seg(a.in[I_CKW1], 4096, 256, 0, 256, Cw1_t, 0, false, scr, lane, gw, NGW, base);
        transpose_seg(a.in[I_CVW1], 4096, 256, 0, 256, Cw1_t + (size_t)256 * 4096, 0, false, scr, lane, gw, NGW, base);
        transpose_seg(a.in[I_CKW2], 256, 128, 0, 128, Cw2_t, 0, false, scr, lane, gw, NGW, base);
        transpose_seg(a.in[I_CVW2], 256, 128, 0, 128, Cw2_t + 65536, 0, false, scr, lane, gw, NGW, base);
        for (int m = gw; m < M; m += NGW) xg_row_bf16(a.in[I_X] + (size_t)m * DM, a.in[I_F1N], XN + (size_t)m * DM, SS0 + m, lane);
        for (int i = vcu * 512 + tid; i < 2 * M; i += G * 512) SS1[i] = 0.f;
        if (wave == NWAVES - 1) for (int task = vcu; task < 256; task += G) {
            const int tensor = task >> 7, chunk = (task >> 2) & 31, col = (task & 3) * 64 + lane;
            const float* pe = a.in[tensor ? I_PEV : I_PEK] + chunk * 128; const float* w1 = a.in[tensor ? I_CVW1 : I_CKW1] + (size_t)chunk * 128 * 256 + col;
            float acc = 0.f;
#pragma unroll 16
            for (int k = 0; k < 128; ++k) acc += pe[k] * w1[(size_t)k * 256];
            PEBP[(tensor * 32 + chunk) * 256 + col] = acc;
        }
    }
    SEAM(0);
    if (IN(1)) for (int rep = 0; rep <= REP(1); ++rep) { pg8::EpiSwiglu E{HID, FF, SS0}; run_gemm(lds, XN, DM, Wgu_t, DM, M, 2 * FF, DM, G, bx, E); }
    SEAM(1);
    if (IN(2)) { pg8::EpiResNorm E{a.in[I_X], H, XN, a.in[I_MIXN], SS1, DM, 0.5f}; run_gemm(lds, HID, FF, Wd_t, FF, M, DM, FF, G, bx, E); }
    SEAM(2);
    if (IN(3)) for (int rep = 0; rep <= REP(3); ++rep) {
        if (bx == G - 1) { float pv[32];
#pragma unroll
            for (int c = 0; c < 32; ++c) pv[c] = PEBP[((tid >> 8) * 32 + c) * 256 + (tid & 255)];
            float s = 0.f;
#pragma unroll
            for (int c = 0; c < 32; ++c) s += pv[c];
            PEB[tid] = s; }
        pg8::EpiP8<FWin> E{FWin{XP, Q, KCVC, KV4, GPOOL, GNSA}, SS1}; run_gemm(lds, XN, DM, Win_t, DM, M, INW - 256, DM, G, bx, E); }
    SEAM(3);
    if (IN(4)) for (int rep = 0; rep <= REP(4); ++rep) {
        { pg8::EpiP8<FPartial> E{FPartial{HIDCP}, nullptr};
          run_gemm(lds, KCVC, 2048, Cw1_t, 4096, 8192, 512, 2048, G, bx, E, 2048 * 2, 16, 256 * 4096 * 2, 2048 * 2); }
        { pg8::EpiP8<FGates> E{FGates{NSAG}, SS1}; run_gemm(lds, XN, DM, Win_t + (size_t)10240 * DM, DM, M, 256, DM, G, (bx + G - 64 % G) % G, E); }
        const bool std = (G == 256);
        {
            constexpr int NIT = (M / 2) * 4, NA = (NIT * 27 / 32) & ~1023;
            if (!std) { for (int item = gw; item < NIT; item += NGW) pool_item(XP, POOLED, item >> 2, item & 3, lane); }
            else if (bx >= 128) { for (int item = (bx - 128) * NWAVES + wave; item < NA; item += 128 * NWAVES) pool_item(XP, POOLED, item >> 2, item & 3, lane); }
            else { for (int item = NA + bx * NWAVES + wave; item < NIT; item += 128 * NWAVES) pool_item(XP, POOLED, item >> 2, item & 3, lane); }
        }
    }
    SEAM(4);
    if (IN(5)) for (int rep = 0; rep <= REP(5); ++rep) {
        { pg8::StaticOrder S; S.init(8192, 256, G, bx); pg8::Unit u;
          if (S.next(0, u)) {
#pragma unroll 8
              for (int i = 0; i < 16; ++i) { const int e8 = i * 512 + tid, r = u.pm * 256 + (e8 >> 5), c8 = (e8 & 31) * 8;
                  const float* p0 = HIDCP + (size_t)r * 256 + c8; const float* p1 = p0 + (size_t)8192 * 256; const float* bp = PEB + ((r >> 12) << 8) + c8;
                  pg8::f32x4 a0 = *(const pg8::f32x4*)p0 + *(const pg8::f32x4*)p1 + *(const pg8::f32x4*)bp, a1 = *(const pg8::f32x4*)(p0 + 4) + *(const pg8::f32x4*)(p1 + 4) + *(const pg8::f32x4*)(bp + 4);
#pragma unroll
                  for (int j = 0; j < 4; ++j) { a0[j] = pg8::siluf_(a0[j]); a1[j] = pg8::siluf_(a1[j]); }
                  *(u32x4*)(HIDC + (size_t)r * 256 + c8) = pg8::pack8(a0, a1); }
              asm volatile("s_waitcnt vmcnt(0)" ::: "memory"); __syncthreads();
          } }
        { pg8::EpiP8<FStore128> E{FStore128{KVCMP}, nullptr}; run_gemm(lds, HIDC, 256, Cw2_t, 256, 8192, 256, 256, G, bx, E, 0, 16, 65536 * 2); }
        { pg8::EpiP8<FPool> E{FPool{APOOL, a.in[I_POOLS]}, nullptr}; run_gemm(lds, POOLED, PW, Poolw_t, 256, M, PW, 256, G, bx, E, 256 * 2); }
    }
    SEAM(5);
    if (IN(6)) {
        { pg8::EpiP8<FGate> E{FGate{GPOOL, GPOOL, false}, nullptr}; run_gemm(lds, APOOL, PW, Wpu_t, PW, M, DM, PW, G, bx, E); }
        for (int rep = REP(6) ? 0 : 1; rep < 2; ++rep)
        for (int it = vcu; it < 1024; it += G) {
            const int c = it & 255, k = it >> 8, bg = c >> 5, i = c & 31;
            const int qb = (k == 0) ? i : (k == 1) ? 63 - i : (k == 2) ? 64 + i : 127 - i;
            nsa::nsa_unit(bg >> 2, bg & 3, qb, Q, KV4, KVCMP, KVCMP + (size_t)4096 * 128, NSAG, Q, (char*)lds_raw, rep == 1 || a.ph_lo != 0);
        }
    }
    SEAM(6);
    if (IN(7)) { pg8::EpiP8<FGate> E{FGate{GPOOL, GNSA, true}, nullptr}; run_gemm(lds, Q, DM, Wnu_t, DM, M, DM, DM, G, bx, E); }
    SEAM(7);
    if (IN(8)) {
        int base = 0;
        transpose_seg(a.in[I_F2G], DM, FF, 0, FF, Wgu_t, 0, true, scr, lane, gw, NGW, base);
        transpose_seg(a.in[I_F2U], DM, FF, 0, FF, Wgu_t, 128, true, scr, lane, gw, NGW, base);
        transpose_seg(a.in[I_F2D], FF, DM, 0, DM, Wd_t, 0, false, scr, lane, gw, NGW, base);
        __syncthreads();
        pg8::EpiResNorm E{H, H, XN, a.in[I_F2N], SS2, DM, 1.0f}; run_gemm(lds, GPOOL, DM, Wout_t, DM, M, DM, DM, G, bx, E);
    }
    SEAM(8);
    if (IN(9)) for (int rep = 0; rep <= REP(9); ++rep) { pg8::EpiSwiglu E{HID, FF, SS2}; run_gemm(lds, XN, DM, Wgu_t, DM, M, 2 * FF, DM, G, bx, E); }
    SEAM(9);
    if (IN(10)) { pg8::EpiResF32 E{H, H, DM, 0.5f}; run_gemm(lds, HID, FF, Wd_t, FF, M, DM, FF, G, bx, E); }
    SEAM(10);
    if (IN(11)) { for (int m = gw; m < M; m += NGW) rms_row_f32(H + (size_t)m * DM, a.in[I_FINN], lane); }
    if (MK_PROBE_K >= 0 && bx == 0 && tid == 0) {
        const unsigned long long te = __builtin_amdgcn_s_memrealtime(); const unsigned long long t1 = (MK_PROBE_K == N_PHASES - 1) ? te : stamps[1];
        const unsigned long long dt = (t1 - stamps[0]) * MK_PROBE_MULT;
        while (__builtin_amdgcn_s_memrealtime() - te < dt) __builtin_amdgcn_s_sleep(32);
    }
#ifdef MK_SEC
    if (MK_SEC && bx == 0 && tid == 0) { const unsigned long long te = __builtin_amdgcn_s_memrealtime(), dt = (unsigned long long)(*(volatile LAS unsigned*)(lds + 152592)) * MK_PROBE_MULT; while (__builtin_amdgcn_s_memrealtime() - te < dt) __builtin_amdgcn_s_sleep(32); }
#endif
#undef IN
#undef SEAM
}

#ifndef MK_ONE_LAUNCH
#define MK_ONE_LAUNCH 1
#endif
extern "C" void kernel_launch(void* const* d_in, const int* in_sizes, int n_in, void* d_out, int out_size, void* d_ws, size_t ws_size, hipStream_t stream) {
    static int grid = 0;
    if (grid == 0) {
        if (n_in != 23 || out_size != M * DM || ws_size < WS_END) { fprintf(stderr, "kernel_launch: unexpected shapes (n_in %d out %d ws %zu)\n", n_in, out_size, ws_size); grid = -1; return; }
        int dev = 0, cus = 0, per_cu = 0;
        (void)hipGetDevice(&dev); (void)hipDeviceGetAttribute(&cus, hipDeviceAttributeMultiprocessorCount, dev);
        if (hipFuncSetAttribute((const void*)mk_fwd, hipFuncAttributeMaxDynamicSharedMemorySize, LDS_BYTES) != hipSuccess) { fprintf(stderr, "kernel_launch: hipFuncSetAttribute failed\n"); grid = -1; return; }
        if (hipOccupancyMaxActiveBlocksPerMultiprocessor(&per_cu, (const void*)mk_fwd, NWAVES * 64, LDS_BYTES) != hipSuccess || per_cu < 1) { fprintf(stderr, "kernel_launch: occupancy query says %d\n", per_cu); per_cu = 1; }
        (void)hipGetLastError();
        grid = cus > 0 ? cus : 256;
    }
    if (grid < 0) return;
    Args a{};
    for (int i = 0; i < 23; ++i) a.in[i] = (const float*)d_in[i];
    a.out = (float*)d_out; a.ws = (unsigned char*)d_ws;
#if MK_ONE_LAUNCH
    (void)hipMemsetAsync((char*)d_ws + WS_CTL, 0, CTL_BYTES, stream);
    a.ph_lo = 0; a.ph_hi = N_PHASES;
    void* args[] = {&a};
    hipError_t e = hipLaunchCooperativeKernel((const void*)mk_fwd, dim3(grid), dim3(NWAVES * 64), args, LDS_BYTES, stream);
    if (e != hipSuccess) fprintf(stderr, "kernel_launch: cooperative launch failed: %s (grid %d)\n", hipGetErrorString(e), grid);
#else
    for (int p = 0; p < N_PHASES; ++p) { a.ph_lo = p; a.ph_hi = p + 1; hipLaunchKernelGGL(mk_fwd, dim3(grid), dim3(NWAVES * 64), LDS_BYTES, stream, a); }
#endif
}
```

```cpp
#include <hip/hip_runtime.h>
#include <hip/hip_cooperative_groups.h>
#include <cstdio>
#include <cstdint>
namespace cg = cooperative_groups;
namespace pg8 {
#define PG8_LAS __attribute__((address_space(3)))
typedef unsigned short bf16_t;
typedef short bf16x8 __attribute__((ext_vector_type(8)));
typedef float f32x4 __attribute__((ext_vector_type(4)));
typedef unsigned u32x4 __attribute__((ext_vector_type(4)));
constexpr int BM = 256, BK = 64, HALF = 128, HTB = HALF * BK * 2  , STAGE_BYTES = 8 * HTB, NXCD = 8, WGM = 4;

__host__ __device__ __forceinline__ int lds_byte(int r, int c) { const int st = (r >> 4) * 2 + (c >> 5), rr = r & 15, cc = c & 31, ob = rr * 64 + cc * 2; return st * 1024 + (ob ^ (((ob >> 9) & 1) << 5)); }
__host__ __device__ __forceinline__ void stage_rc(int b, int& R, int& C) { const int st = b / 1024, sb = b % 1024, swz = sb ^ (((sb >> 9) & 1) << 5); R = (st >> 1) * 16 + swz / 64; C = (st & 1) * 32 + (swz % 64) / 2; }
__host__ __device__ __forceinline__ int perm32(int rho) { const int n = rho >> 4, i = rho & 15; return 8 * (i >> 2) + 4 * n + (i & 3); }

struct Unit { int pm, pn; };
struct Gemm { const bf16_t* A; const bf16_t* Bt; int M, N, K, lda, ldb; int apn  , bpn  , bdiv, bbytes  ; };

struct StaticOrder {
    int nM, nN, nwg, G, c;
    __host__ __device__ __forceinline__ void init(int M, int N, int G_, int c_) { nM = M / BM; nN = N / BM; nwg = nM * nN; G = G_; c = c_; }
    __host__ __device__ __forceinline__ bool next(int i, Unit& u) const {
        const long L = (long)i * G + c; if (L >= nwg) return false;
        int wgid = (int)L; { const int q = nwg / NXCD, r = nwg % NXCD, xcd = wgid % NXCD, off = wgid / NXCD; wgid = (xcd < r ? xcd * (q + 1) : r * (q + 1) + (xcd - r) * q) + off; }
        const int nig = WGM * nN, gid = wgid / nig, fm = gid * WGM, gsz = (nM - fm) < WGM ? (nM - fm) : WGM;
        u.pm = fm + ((wgid % nig) % gsz); u.pn = (wgid % nig) / gsz; return true;
    }
    __device__ __forceinline__ void a_ready(const Unit&) const {}
    __device__ __forceinline__ void done(const Unit&) const {}
};

__device__ __forceinline__ unsigned cvt_pk_bf16(float lo, float hi) { unsigned r; asm volatile("v_cvt_pk_bf16_f32 %0, %1, %2" : "=v"(r) : "v"(lo), "v"(hi)); return r; }
__device__ __forceinline__ float bf_lo(unsigned w) { return __builtin_bit_cast(float, w << 16); }
__device__ __forceinline__ float bf_hi(unsigned w) { return __builtin_bit_cast(float, w & 0xffff0000u); }
__device__ __forceinline__ float sigmoidf_(float x) { return __builtin_amdgcn_rcpf(1.f + __builtin_amdgcn_exp2f(-1.4426950408889634f * x)); }
__device__ __forceinline__ float siluf_(float x) { return x * sigmoidf_(x); }
__device__ __forceinline__ u32x4 pack8(f32x4 a, f32x4 b) { u32x4 w; w.x = cvt_pk_bf16(a[0], a[1]); w.y = cvt_pk_bf16(a[2], a[3]); w.z = cvt_pk_bf16(b[0], b[1]); w.w = cvt_pk_bf16(b[2], b[3]); return w; }

template <class F> struct EpiP8 {
    static constexpr bool PERM = true, AFTER_DRAIN = false;
    F f; const float* ss;
    __device__ __forceinline__ void operator()(const f32x4 (&acc)[2][2][4][2], const Unit& u, int wr, int wc, int fr, int fq) const {
        const int row0 = u.pm * BM + wr * 64 + fr, col0 = u.pn * BM + wc * 32 + 8 * fq;
        typename F::Pre pre[2][2]; float rsv[2];
#define EP8_LD(s_, i_) do { const int r_ = row0 + ((i_) >> 2) * HALF + ((i_) & 3) * 16; f.load(pre[s_][0], r_, col0); f.load(pre[s_][1], r_, col0 + HALF); rsv[s_] = ss ? ss[r_] : 0.f; } while (0)
        EP8_LD(0, 0);
#pragma unroll
        for (int i = 0; i < 8; ++i) {
            if (i + 1 < 8) EP8_LD((i + 1) & 1, i + 1);
            const int ai = i >> 2, mm = i & 3, row = row0 + ai * HALF + mm * 16;
            const float rs = ss ? __builtin_amdgcn_rsqf(rsv[i & 1] * (1.f / 2048.f) + 1e-6f) : 1.f;
#pragma unroll
            for (int bj = 0; bj < 2; ++bj) f(row, col0 + bj * HALF, u.pn, acc[ai][bj][mm][0] * rs, acc[ai][bj][mm][1] * rs, pre[i & 1][bj]);
        }
#undef EP8_LD
    }
};
struct EpiSwiglu {
    static constexpr bool PERM = true, AFTER_DRAIN = false;
    bf16_t* O; int ldc; const float* ss;
    __device__ __forceinline__ void operator()(const f32x4 (&acc)[2][2][4][2], const Unit& u, int wr, int wc, int fr, int fq) const {
        const int row0 = u.pm * BM + wr * 64 + fr, col0 = u.pn * HALF + wc * 32 + 8 * fq;
#pragma unroll
        for (int ai = 0; ai < 2; ++ai)
#pragma unroll
            for (int m = 0; m < 4; ++m) {
                const int row = row0 + ai * HALF + m * 16;
                const float rs = __builtin_amdgcn_rsqf(ss[row] * (1.f / 2048.f) + 1e-6f);
                f32x4 h0, h1;
#pragma unroll
                for (int j = 0; j < 4; ++j) { h0[j] = siluf_(acc[ai][0][m][0][j] * rs) * (acc[ai][1][m][0][j] * rs); h1[j] = siluf_(acc[ai][0][m][1][j] * rs) * (acc[ai][1][m][1][j] * rs); }
                *(u32x4*)(O + (size_t)row * ldc + col0) = pack8(h0, h1);
            }
    }
};
struct EpiResF32 {
    static constexpr bool PERM = false, AFTER_DRAIN = false;
    const float* base; float* out; int ldc; float coef;
    __device__ __forceinline__ void operator()(const f32x4 (&acc)[2][2][4][2], const Unit& u, int wr, int wc, int fr, int fq) const {
        const int row0 = u.pm * BM + wr * 64 + fr, col0 = u.pn * BM + wc * 32 + 4 * fq;
        f32x4 pre[2][2][2];
#define ERF_LD(s_, i_) do { const size_t off_ = (size_t)(row0 + ((i_) >> 2) * HALF + ((i_) & 3) * 16) * ldc + col0; \
        pre[s_][0][0] = *(const f32x4*)(base + off_); pre[s_][0][1] = *(const f32x4*)(base + off_ + 16); pre[s_][1][0] = *(const f32x4*)(base + off_ + HALF); pre[s_][1][1] = *(const f32x4*)(base + off_ + HALF + 16); } while (0)
        ERF_LD(0, 0);
#pragma unroll
        for (int i = 0; i < 8; ++i) {
            if (i + 1 < 8) ERF_LD((i + 1) & 1, i + 1);
            const int ai = i >> 2, mm = i & 3; const size_t off = (size_t)(row0 + ai * HALF + mm * 16) * ldc + col0;
#pragma unroll
            for (int bj = 0; bj < 2; ++bj)
#pragma unroll
                for (int n = 0; n < 2; ++n) *(f32x4*)(out + off + bj * HALF + n * 16) = pre[i & 1][bj][n] + acc[ai][bj][mm][n] * coef;
        }
#undef ERF_LD
    }
};
struct EpiResNorm {
    static constexpr bool PERM = false, AFTER_DRAIN = false;
    const float* base; float* out; bf16_t* xn; const float* gain; float* ss; int ldc; float coef;
    __device__ __forceinline__ void operator()(const f32x4 (&acc)[2][2][4][2], const Unit& u, int wr, int wc, int fr, int fq) const {
        const int row0 = u.pm * BM + wr * 64 + fr, col0 = u.pn * BM + wc * 32 + 4 * fq;
        f32x4 gg[2][2];
#pragma unroll
        for (int bj = 0; bj < 2; ++bj)
#pragma unroll
            for (int n = 0; n < 2; ++n) gg[bj][n] = *(const f32x4*)(gain + col0 + bj * HALF + n * 16);
        f32x4 pre[2][2][2];
#define ERN_LD(s_, i_) do { const size_t off_ = (size_t)(row0 + ((i_) >> 2) * HALF + ((i_) & 3) * 16) * ldc + col0; \
        pre[s_][0][0] = *(const f32x4*)(base + off_); pre[s_][0][1] = *(const f32x4*)(base + off_ + 16); pre[s_][1][0] = *(const f32x4*)(base + off_ + HALF); pre[s_][1][1] = *(const f32x4*)(base + off_ + HALF + 16); } while (0)
        ERN_LD(0, 0);
#pragma unroll
        for (int i = 0; i < 8; ++i) {
            if (i + 1 < 8) ERN_LD((i + 1) & 1, i + 1);
            const int ai = i >> 2, mm = i & 3, row = row0 + ai * HALF + mm * 16; const size_t off = (size_t)row * ldc + col0; float s = 0.f;
#pragma unroll
            for (int bj = 0; bj < 2; ++bj)
#pragma unroll
                for (int n = 0; n < 2; ++n) { const f32x4 h = pre[i & 1][bj][n] + acc[ai][bj][mm][n] * coef;
                    *(f32x4*)(out + off + bj * HALF + n * 16) = h; s += (h[0] * h[0] + h[1] * h[1]) + (h[2] * h[2] + h[3] * h[3]);
                    const f32x4 y = h * gg[bj][n]; typedef unsigned u32x2 __attribute__((ext_vector_type(2))); u32x2 w; w.x = cvt_pk_bf16(y[0], y[1]); w.y = cvt_pk_bf16(y[2], y[3]);
                    *(u32x2*)(xn + off + bj * HALF + n * 16) = w; }
            s += __shfl_xor(s, 16); s += __shfl_xor(s, 32);
            if (fq == 0) atomicAdd(ss + row, s);
        }
#undef ERN_LD
    }
};
template <bool BASE_BF, bool OUT_BF, bool OUT_F32> struct EpiResBf {
    static constexpr bool PERM = false, AFTER_DRAIN = false;
    const float* basef; const bf16_t* baseb; float* outf; bf16_t* xn; float* ss; int ldc; float coef;
    typedef unsigned u32x2 __attribute__((ext_vector_type(2)));
    __device__ __forceinline__ void operator()(const f32x4 (&acc)[2][2][4][2], const Unit& u, int wr, int wc, int fr, int fq) const {
        const int row0 = u.pm * BM + wr * 64 + fr, col0 = u.pn * BM + wc * 32 + 4 * fq;
        f32x4 pf[2][2][2]; u32x2 pb[2][2][2];
#define ERB_LD(s_, i_) do { const size_t off_ = (size_t)(row0 + ((i_) >> 2) * HALF + ((i_) & 3) * 16) * ldc + col0; \
        _Pragma("unroll") for (int bj_ = 0; bj_ < 2; ++bj_) _Pragma("unroll") for (int n_ = 0; n_ < 2; ++n_) { \
            if (BASE_BF) pb[s_][bj_][n_] = *(const u32x2*)(baseb + off_ + bj_ * HALF + n_ * 16); else pf[s_][bj_][n_] = *(const f32x4*)(basef + off_ + bj_ * HALF + n_ * 16); } } while (0)
        ERB_LD(0, 0);
#pragma unroll
        for (int i = 0; i < 8; ++i) {
            if (i + 1 < 8) ERB_LD((i + 1) & 1, i + 1);
            const int ai = i >> 2, mm = i & 3, row = row0 + ai * HALF + mm * 16; const size_t off = (size_t)row * ldc + col0; float s = 0.f;
#pragma unroll
            for (int bj = 0; bj < 2; ++bj)
#pragma unroll
                for (int n = 0; n < 2; ++n) {
                    f32x4 b;
                    if (BASE_BF) { const u32x2 w = pb[i & 1][bj][n]; b = (f32x4){bf_lo(w.x), bf_hi(w.x), bf_lo(w.y), bf_hi(w.y)}; } else b = pf[i & 1][bj][n];
                    const f32x4 h = b + acc[ai][bj][mm][n] * coef;
                    if (OUT_F32) *(f32x4*)(outf + off + bj * HALF + n * 16) = h;
                    if (OUT_BF) { s += (h[0] * h[0] + h[1] * h[1]) + (h[2] * h[2] + h[3] * h[3]);
                        u32x2 w; w.x = cvt_pk_bf16(h[0], h[1]); w.y = cvt_pk_bf16(h[2], h[3]); *(u32x2*)(xn + off + bj * HALF + n * 16) = w; }
                }
            if (OUT_BF) { s += __shfl_xor(s, 16); s += __shfl_xor(s, 32); if (fq == 0) atomicAdd(ss + row, s); }
        }
#undef ERB_LD
    }
};
template <class Epi, class Sched, bool ALIGN_EPI = false, bool SP2 = false>
__device__ __forceinline__ void gemm_phase(PG8_LAS unsigned char* lds, const Gemm g, const Sched& S, const Epi& E) {
    const int tid = threadIdx.x, wid = __builtin_amdgcn_readfirstlane(tid >> 6), lane = tid & 63, wr = wid >> 2, wc = wid & 3, fr = lane & 15, fq = lane >> 4;
    const int K = g.K, nt = K / BK;
    unsigned voffA[2], voffB[2];
#pragma unroll
    for (int i = 0; i < 2; ++i) { int R, C; stage_rc(tid * 16 + i * 8192, R, C); const int Rb = Epi::PERM ? ((R & ~31) + perm32(R & 31)) : R;
        voffA[i] = (unsigned)(R * g.lda + C) * 2u; voffB[i] = (unsigned)(Rb * g.ldb + C) * 2u; }
    const size_t kstep = (size_t)(BK * 2);
    const size_t hstepA = (size_t)HALF * g.lda * 2, hstepB = (size_t)HALF * g.ldb * 2;
    const size_t tstepA = 2 * hstepA, tstepB = 2 * hstepB;
    const unsigned ldsw = (unsigned)wid * 1024u;
    const int aoff = lds_byte(wr * 64 + fr, fq * 8), boff = lds_byte(wc * 32 + fr, fq * 8);
#define PG8_SA(b, h) (((b) * 2 + (h)) * HTB)
#define PG8_SB(b, h) ((4 + (b) * 2 + (h)) * HTB)
#define PG8_STAGE(bufoff, gbase, voff) do { _Pragma("unroll") for (int _i = 0; _i < 2; ++_i) \
        __builtin_amdgcn_global_load_lds((const unsigned*)((const char*)(gbase) + (voff)[_i]), (PG8_LAS unsigned*)(lds + (bufoff) + ldsw + _i * 8192), 16, 0, 0); } while (0)
#define PG8_LDA(dst, b, h) do { _Pragma("unroll") for (int m = 0; m < 4; ++m) _Pragma("unroll") for (int k = 0; k < 2; ++k) dst[m][k] = *(const PG8_LAS bf16x8*)(lds + PG8_SA(b, h) + aoff + m * 2048 + k * 1024); } while (0)
#define PG8_LDB(dst, b, h) do { _Pragma("unroll") for (int n = 0; n < 2; ++n) _Pragma("unroll") for (int k = 0; k < 2; ++k) dst[n][k] = *(const PG8_LAS bf16x8*)(lds + PG8_SB(b, h) + boff + n * 2048 + k * 1024); } while (0)
#define PG8_MMA(ai, bj, At, Bt) do { __builtin_amdgcn_s_setprio(1); _Pragma("unroll") for (int m = 0; m < 4; ++m) _Pragma("unroll") for (int n = 0; n < 2; ++n) _Pragma("unroll") for (int k = 0; k < 2; ++k) \
        acc[ai][bj][m][n] = __builtin_amdgcn_mfma_f32_16x16x32_bf16(Bt[n][k], At[m][k], acc[ai][bj][m][n], 0, 0, 0); __builtin_amdgcn_s_setprio(0); } while (0)
#define PG8_WAIT_V(n) asm volatile("s_waitcnt vmcnt(" #n ")" ::: "memory")
#define PG8_WAIT_L(n) asm volatile("s_waitcnt lgkmcnt(" #n ")" ::: "memory")
#define PG8_BAR __builtin_amdgcn_s_barrier()
#define PG8_SCHED __builtin_amdgcn_sched_barrier(0)
    Unit cur, nxt; int ui = 0;
    if (!S.next(0, cur)) return;
    f32x4 acc[2][2][4][2];
#pragma unroll
    for (int a = 0; a < 2; ++a)
#pragma unroll
        for (int b = 0; b < 2; ++b)
#pragma unroll
            for (int m = 0; m < 4; ++m)
#pragma unroll
                for (int n = 0; n < 2; ++n) acc[a][b][m][n] = (f32x4){0.f, 0.f, 0.f, 0.f};
    bf16x8 At[4][2], B0[2][2], B1[2][2];
    const char* cA = (const char*)g.A + (size_t)cur.pm * tstepA + (size_t)cur.pn * g.apn; const char* cB = (const char*)g.Bt + (size_t)cur.pn * g.bpn + (size_t)(cur.pm / g.bdiv) * g.bbytes;
    S.a_ready(cur);
    if constexpr (SP2) {
        PG8_STAGE(PG8_SB(0, 0), cB, voffB); PG8_STAGE(PG8_SB(0, 1), cB + hstepB, voffB); PG8_STAGE(PG8_SA(0, 0), cA, voffA); PG8_STAGE(PG8_SA(0, 1), cA + hstepA, voffA);
        if (wr == 1) PG8_BAR;
        PG8_WAIT_V(2); PG8_BAR;
        PG8_STAGE(PG8_SB(1, 0), cB + kstep, voffB); PG8_STAGE(PG8_SA(1, 0), cA + kstep, voffA); PG8_STAGE(PG8_SB(1, 1), cB + hstepB + kstep, voffB);
        PG8_WAIT_V(6); PG8_BAR;
    } else {
        PG8_STAGE(PG8_SB(0, 0), cB, voffB); PG8_STAGE(PG8_SA(0, 0), cA, voffA); PG8_STAGE(PG8_SB(0, 1), cB + hstepB, voffB); PG8_STAGE(PG8_SA(0, 1), cA + hstepA, voffA);
        if (wr == 1) PG8_BAR;
        PG8_WAIT_V(4); PG8_BAR;
        PG8_STAGE(PG8_SB(1, 0), cB + kstep, voffB); PG8_STAGE(PG8_SA(1, 0), cA + kstep, voffA); PG8_STAGE(PG8_SB(1, 1), cB + hstepB + kstep, voffB);
        PG8_WAIT_V(6); PG8_BAR;
    }
    for (;;) {
        const bool has_next = S.next(ui + 1, nxt);
        const char* nA = has_next ? (const char*)g.A + (size_t)nxt.pm * tstepA + (size_t)nxt.pn * g.apn : cA; const char* nB = has_next ? (const char*)g.Bt + (size_t)nxt.pn * g.bpn + (size_t)(nxt.pm / g.bdiv) * g.bbytes : cB;
#pragma nounroll
        for (int t = 0; t < nt; t += 2) {
            const bool last = (t == nt - 2);
            const char* a1 = cA + (size_t)(t + 1) * kstep;
            const char* a2 = last ? nA : cA + (size_t)(t + 2) * kstep; const char* b2 = last ? nB : cB + (size_t)(t + 2) * kstep;
            const char* a3 = a2 + kstep; const char* b3 = b2 + kstep;
            if (last && has_next) S.a_ready(nxt);
            if constexpr (SP2) {
            PG8_LDB(B0, 0, 0); PG8_LDB(B1, 0, 1); PG8_SCHED; PG8_LDA(At, 0, 0); PG8_STAGE(PG8_SA(1, 1), a1 + hstepA, voffA);
            PG8_WAIT_V(8); PG8_WAIT_L(0); PG8_BAR; PG8_MMA(0, 0, At, B0); PG8_MMA(0, 1, At, B1); PG8_BAR; PG8_SCHED;
            PG8_LDA(At, 0, 1); PG8_STAGE(PG8_SB(0, 0), b2, voffB); PG8_STAGE(PG8_SB(0, 1), b2 + hstepB, voffB); PG8_STAGE(PG8_SA(0, 0), a2, voffA);
            PG8_WAIT_V(8); PG8_WAIT_L(0); PG8_BAR; PG8_MMA(1, 0, At, B0); PG8_MMA(1, 1, At, B1); PG8_BAR; PG8_SCHED;
            PG8_LDB(B0, 1, 0); PG8_LDB(B1, 1, 1); PG8_SCHED; PG8_LDA(At, 1, 0); PG8_STAGE(PG8_SA(0, 1), a2 + hstepA, voffA);
            PG8_WAIT_V(8); PG8_WAIT_L(0); PG8_BAR; PG8_MMA(0, 0, At, B0); PG8_MMA(0, 1, At, B1); PG8_BAR; PG8_SCHED;
            PG8_LDA(At, 1, 1); PG8_STAGE(PG8_SB(1, 0), b3, voffB); PG8_STAGE(PG8_SB(1, 1), b3 + hstepB, voffB); PG8_STAGE(PG8_SA(1, 0), a3, voffA);
            PG8_WAIT_V(8); PG8_WAIT_L(0); PG8_BAR; PG8_MMA(1, 0, At, B0); PG8_MMA(1, 1, At, B1); PG8_BAR; PG8_SCHED;
            } else {
            PG8_LDB(B0, 0, 0); PG8_SCHED; PG8_LDA(At, 0, 0); PG8_STAGE(PG8_SA(1, 1), a1 + hstepA, voffA);
            PG8_WAIT_L(8); PG8_BAR; PG8_WAIT_L(0); PG8_MMA(0, 0, At, B0); PG8_BAR; PG8_SCHED;
            PG8_LDB(B1, 0, 1); PG8_STAGE(PG8_SB(0, 0), b2, voffB);
            PG8_BAR; PG8_WAIT_L(0); PG8_MMA(0, 1, At, B1); PG8_BAR;
            PG8_LDA(At, 0, 1); PG8_STAGE(PG8_SA(0, 0), a2, voffA);
            PG8_BAR; PG8_WAIT_L(0); PG8_MMA(1, 0, At, B0); PG8_BAR; PG8_SCHED;
            PG8_STAGE(PG8_SB(0, 1), b2 + hstepB, voffB);
            PG8_WAIT_V(6); PG8_BAR; PG8_MMA(1, 1, At, B1); PG8_BAR;
            PG8_LDB(B0, 1, 0); PG8_SCHED; PG8_LDA(At, 1, 0); PG8_STAGE(PG8_SA(0, 1), a2 + hstepA, voffA);
            PG8_WAIT_L(8); PG8_BAR; PG8_WAIT_L(0); PG8_MMA(0, 0, At, B0); PG8_BAR; PG8_SCHED;
            PG8_LDB(B1, 1, 1); PG8_STAGE(PG8_SB(1, 0), b3, voffB);
            PG8_BAR; PG8_WAIT_L(0); PG8_MMA(0, 1, At, B1); PG8_BAR;
            PG8_LDA(At, 1, 1); PG8_STAGE(PG8_SA(1, 0), a3, voffA);
            PG8_BAR; PG8_WAIT_L(0); PG8_MMA(1, 0, At, B0); PG8_BAR; PG8_SCHED;
            PG8_STAGE(PG8_SB(1, 1), b3 + hstepB, voffB);
            PG8_WAIT_V(6); PG8_BAR; PG8_MMA(1, 1, At, B1); PG8_BAR;
            }
        }
        if constexpr (ALIGN_EPI) { if (wr == 0) PG8_BAR; }
        if constexpr (!Epi::AFTER_DRAIN) { E(acc, cur, wr, wc, fr, fq); S.done(cur); }
        if (!has_next) break;
#pragma unroll
        for (int a = 0; a < 2; ++a)
#pragma unroll
            for (int b = 0; b < 2; ++b)
#pragma unroll
                for (int m = 0; m < 4; ++m)
#pragma unroll
                    for (int n = 0; n < 2; ++n) acc[a][b][m][n] = (f32x4){0.f, 0.f, 0.f, 0.f};
        cur = nxt; cA = nA; cB = nB; ++ui;
        if constexpr (ALIGN_EPI) { if (wr == 1) PG8_BAR; }
    }
    PG8_WAIT_V(0);
    if constexpr (!ALIGN_EPI) { if (wr == 0) PG8_BAR; }
    PG8_BAR;
    if constexpr (Epi::AFTER_DRAIN) { E.fused(acc, cur, wr, wc, fr, fq, lds, wid, lane); S.done(cur); }
#undef PG8_SA
#undef PG8_SB
#undef PG8_STAGE
#undef PG8_LDA
#undef PG8_LDB
#undef PG8_MMA
#undef PG8_WAIT_V
#undef PG8_WAIT_L
#undef PG8_BAR
#undef PG8_SCHED
}
}
namespace nsa {
typedef unsigned short bf16_t;
typedef short bf16x8 __attribute__((ext_vector_type(8)));
typedef short s16x4 __attribute__((ext_vector_type(4)));
typedef float f32x16 __attribute__((ext_vector_type(16)));
typedef float f32x4 __attribute__((ext_vector_type(4)));
typedef unsigned u32x4 __attribute__((ext_vector_type(4)));
constexpr int D = 128, KVBLK = 64, SHM_K = 16384, SHM_V = 16384, SEQ = 8192;
constexpr float SCALE = 0.08838834764831845f, C2 = 1.4426950408889634f * SCALE, THR = 8.f;
constexpr int L_KV = 0  , L_WS = 65536, L_SELM = 67584, L_PARK = 69632  , L_IMP = L_PARK  , L_END = L_PARK + 65536;
#define KSWZ(row, colB) ((row) * 256 + ((colB) ^ (((row) & 7) << 4)))
#define SBAR() __builtin_amdgcn_sched_barrier(0)
__device__ __forceinline__ int v_st(int k, int c) { const int kk = (k & ~0xC) | ((k & 4) << 1) | ((k & 8) >> 1); return ((kk >> 3) * 4 + (c >> 5)) * 512 + ((kk & 7) * 32 + (c & 31)) * 2; }
__device__ __forceinline__ int v_rd_base(int lane) { return ((lane & 3) << 3) | (((lane >> 2) & 3) << 6) | (((lane >> 4) & 1) << 5) | (((lane >> 5) & 1) << 8); }
constexpr int v_rd_off(int d0, int ks, int half) { return d0 * 512 + ks * 4096 + half * 2048; }
__device__ __forceinline__ int crow(int r, int hi) { return (r & 3) + 8 * (r >> 2) + 4 * hi; }
__device__ __forceinline__ unsigned cvtpk(float lo, float hi) { unsigned r; asm volatile("v_cvt_pk_bf16_f32 %0, %1, %2" : "=v"(r) : "v"(lo), "v"(hi)); return r; }
__device__ __forceinline__ void mask_tile(f32x16& p0, f32x16& p1, int dq, unsigned W) {
    const float NEG = -__builtin_inff();
#pragma unroll
    for (int r = 0; r < 16; ++r) {
        const int c = (r & 3) + 8 * (r >> 2);
        if ((unsigned)(dq - c) >= W) p0[r] = NEG;
        if ((unsigned)(dq - c - 32) >= W) p1[r] = NEG;
    }
}
__device__ __forceinline__ float max3f(float a, float b, float c) { float r; asm("v_max3_f32 %0, %1, %2, %3" : "=v"(r) : "v"(a), "v"(b), "v"(c)); return r; }
__device__ __forceinline__ float rowmax32(const f32x16& p0, const f32x16& p1) {
    float pmax = max3f(p0[0], p0[1], p0[2]);
#pragma unroll
    for (int r = 3; r < 15; r += 2) pmax = max3f(pmax, p0[r], p0[r + 1]);
    pmax = max3f(pmax, p0[15], p1[0]);
#pragma unroll
    for (int r = 1; r < 15; r += 2) pmax = max3f(pmax, p1[r], p1[r + 1]);
    pmax = fmaxf(pmax, p1[15]);
    auto rr = __builtin_amdgcn_permlane32_swap(__float_as_uint(pmax), __float_as_uint(pmax), false, false);
    return fmaxf(__uint_as_float(rr[0]), __uint_as_float(rr[1]));
}
__device__ __forceinline__ float rowsum32(const f32x16& p0, const f32x16& p1) {
    float ps = 0.f;
#pragma unroll
    for (int r = 0; r < 16; ++r) ps += p0[r];
#pragma unroll
    for (int r = 0; r < 16; ++r) ps += p1[r];
    auto rr = __builtin_amdgcn_permlane32_swap(__float_as_uint(ps), __float_as_uint(ps), false, false);
    return __uint_as_float(rr[0]) + __uint_as_float(rr[1]);
}
__device__ __forceinline__ void packP(const f32x16& p0, const f32x16& p1, bf16x8& pa0, bf16x8& pa1, bf16x8& pa2, bf16x8& pa3) {
#define PK4(P, B_, OUT) do { unsigned a0 = cvtpk(P[B_+0], P[B_+1]), a1 = cvtpk(P[B_+2], P[B_+3]);                          \
        unsigned b0 = cvtpk(P[B_+4], P[B_+5]), b1 = cvtpk(P[B_+6], P[B_+7]);                                             \
        auto r0 = __builtin_amdgcn_permlane32_swap(a0, b0, false, false); auto r1 = __builtin_amdgcn_permlane32_swap(a1, b1, false, false); \
        u32x4 w = {r0[0], r1[0], r0[1], r1[1]}; OUT = *reinterpret_cast<bf16x8*>(&w); } while (0)
    PK4(p0, 0, pa0); PK4(p0, 8, pa1); PK4(p1, 0, pa2); PK4(p1, 8, pa3);
#undef PK4
}
__device__ __forceinline__ void qkt(f32x16& p0, f32x16& p1, const char* K_lds, int r32, int hi, const bf16x8* qr) {
    p0 = f32x16{}; p1 = f32x16{};
    const char* kb[4];
#pragma unroll
    for (int dd = 0; dd < 4; ++dd) kb[dd] = K_lds + KSWZ(r32, (dd * 16 + hi * 8) * 2);
    bf16x8 fa[2], fb[2], fc[2];
#define QK_LD(F, d0) do { const char* a0_ = kb[(d0) & 3] + ((d0) >> 2) * 128; F[0] = *reinterpret_cast<const bf16x8*>(a0_); F[1] = *reinterpret_cast<const bf16x8*>(a0_ + 32 * 256); } while (0)
#define QK_MM(F, d0) do { p0 = __builtin_amdgcn_mfma_f32_32x32x16_bf16(F[0], qr[d0], p0, 0, 0, 0); p1 = __builtin_amdgcn_mfma_f32_32x32x16_bf16(F[1], qr[d0], p1, 0, 0, 0); } while (0)
#define QK_W(n) do { SBAR(); asm volatile("s_waitcnt lgkmcnt(" #n ")" ::: "memory"); SBAR(); } while (0)
    QK_LD(fa, 0); SBAR(); QK_LD(fb, 1); SBAR(); QK_LD(fc, 2);
    QK_W(4); QK_MM(fa, 0); SBAR(); QK_LD(fa, 3);
    QK_W(4); QK_MM(fb, 1); SBAR(); QK_LD(fb, 4);
    QK_W(4); QK_MM(fc, 2); SBAR(); QK_LD(fc, 5);
    QK_W(4); QK_MM(fa, 3); SBAR(); QK_LD(fa, 6);
    QK_W(4); QK_MM(fb, 4); SBAR(); QK_LD(fb, 7);
    QK_W(4); QK_MM(fc, 5);
    QK_W(2); QK_MM(fa, 6);
    QK_W(0); QK_MM(fb, 7);
#undef QK_LD
#undef QK_MM
#undef QK_W
}
__device__ __forceinline__ void pv_tile(f32x16* o, int vb0, bf16x8 pa0, bf16x8 pa1, bf16x8 pa2, bf16x8 pa3) {
#define TRRD(dst, off) asm volatile("ds_read_b64_tr_b16 %0, %1 offset:%2" : "=&v"(dst) : "v"(vb0), "i"(off) : "memory")
#define PV_RD(S_, d0) do { constexpr int b_ = v_rd_off(d0, 0, 0); TRRD(S_##0, b_); TRRD(S_##4, b_ + 2048); TRRD(S_##1, b_ + 4096); TRRD(S_##5, b_ + 6144); TRRD(S_##2, b_ + 8192); TRRD(S_##6, b_ + 10240); TRRD(S_##3, b_ + 12288); TRRD(S_##7, b_ + 14336); } while (0)
#define PV_MM(S_, d0) do { \
        o[d0] = __builtin_amdgcn_mfma_f32_32x32x16_bf16(pa0, (bf16x8){S_##0[0], S_##0[1], S_##0[2], S_##0[3], S_##4[0], S_##4[1], S_##4[2], S_##4[3]}, o[d0], 0, 0, 0);   \
        o[d0] = __builtin_amdgcn_mfma_f32_32x32x16_bf16(pa1, (bf16x8){S_##1[0], S_##1[1], S_##1[2], S_##1[3], S_##5[0], S_##5[1], S_##5[2], S_##5[3]}, o[d0], 0, 0, 0);   \
        o[d0] = __builtin_amdgcn_mfma_f32_32x32x16_bf16(pa2, (bf16x8){S_##2[0], S_##2[1], S_##2[2], S_##2[3], S_##6[0], S_##6[1], S_##6[2], S_##6[3]}, o[d0], 0, 0, 0);   \
        o[d0] = __builtin_amdgcn_mfma_f32_32x32x16_bf16(pa3, (bf16x8){S_##3[0], S_##3[1], S_##3[2], S_##3[3], S_##7[0], S_##7[1], S_##7[2], S_##7[3]}, o[d0], 0, 0, 0); } while (0)
    s16x4 a0, a1, a2, a3, a4, a5, a6, a7, b0, b1, b2, b3, b4, b5, b6, b7;
    PV_RD(a, 0); PV_RD(b, 1);
    asm volatile("s_waitcnt lgkmcnt(8)" ::: "memory"); SBAR(); PV_MM(a, 0); SBAR();
    PV_RD(a, 2);
    asm volatile("s_waitcnt lgkmcnt(8)" ::: "memory"); SBAR(); PV_MM(b, 1); SBAR();
    PV_RD(b, 3);
    asm volatile("s_waitcnt lgkmcnt(8)" ::: "memory"); SBAR(); PV_MM(a, 2); SBAR();
    asm volatile("s_waitcnt lgkmcnt(0)" ::: "memory"); SBAR(); PV_MM(b, 3);
#undef PV_MM
#undef PV_RD
#undef TRRD
}

#ifndef MK_SEC
#define MK_SEC 0
#endif
#define SEC_T(k) do { if (MK_SEC && MODE == 2 && KIND == 2 && blockIdx.x == 0 && threadIdx.x == 0) { const unsigned t_ = (unsigned)__builtin_amdgcn_s_memrealtime(); if (MK_SEC == (k)) { volatile __attribute__((address_space(3))) unsigned* ap_ = (volatile __attribute__((address_space(3))) unsigned*)152592; *ap_ = *ap_ + (t_ - tsec); } tsec = t_; } } while (0)
template <int MODE, int KIND>
__device__ __forceinline__ void attend(const bf16_t* __restrict__ Kg, const bf16_t* __restrict__ Vg, int j_lo, int j_hi, int pos, unsigned W,
                                       char* lds, const bf16x8* qr, float& m_reg, float& l_reg, f32x16* o, float f_imp, float f_o, int qb) {
    constexpr bool NEEDV = MODE != 0;
    const int tid = threadIdx.x, wid = __builtin_amdgcn_readfirstlane(tid >> 6), lane = tid & 63, r32 = lane & 31, hi = lane >> 5;
    float* al_l = (float*)(lds + L_WS) + wid * 64 + 32;
    const int vbase = (int)(uintptr_t)(lds + L_KV + 16384) + v_rd_base(lane);
    const int qloc = wid * 8 + (r32 >> 2);
    int gk[2], gv[2];
#pragma unroll
    for (int i = 0; i < 2; ++i) { const int X = (wid + 8 * i) * 1024 + lane * 16;
        { const int row = X >> 8, colB = (X & 255) ^ ((row & 7) << 4); gk[i] = row * D + (colB >> 1); }
        { const int sub = X >> 9, within = X & 511, kk = (sub >> 2) * 8 + (within >> 6), k = (kk & ~0xC) | ((kk & 4) << 1) | ((kk & 8) >> 1), cc = (sub & 3) * 32 + ((within & 63) >> 1); gv[i] = k * D + cc; } }
    typedef __attribute__((address_space(3))) unsigned las_u32;
    las_u32* ldsw = (las_u32*)(lds + L_KV + wid * 1024);
#define NSA_DMA(j, b) do { const bf16_t* kt_ = Kg + (size_t)(j) * KVBLK * D; \
        __builtin_amdgcn_global_load_lds((const unsigned*)(kt_ + gk[0]), ldsw + (b) * 8192, 16, 0, 0); __builtin_amdgcn_global_load_lds((const unsigned*)(kt_ + gk[1]), ldsw + (b) * 8192 + 2048, 16, 0, 0); \
        if (NEEDV) { const bf16_t* vt_ = Vg + (size_t)(j) * KVBLK * D; \
            __builtin_amdgcn_global_load_lds((const unsigned*)(vt_ + gv[0]), ldsw + (b) * 8192 + 4096, 16, 0, 0); __builtin_amdgcn_global_load_lds((const unsigned*)(vt_ + gv[1]), ldsw + (b) * 8192 + 4096 + 2048, 16, 0, 0); } } while (0)
    if (j_lo >= j_hi) return;
    NSA_DMA(j_lo, 0);
    __syncthreads();
    unsigned tsec = 0; SEC_T(0);
    for (int j = j_lo; j < j_hi; ++j) {
        const int cur = (j - j_lo) & 1;
        if (j + 1 < j_hi) NSA_DMA(j + 1, cur ^ 1);
        const char* K_lds = lds + L_KV + cur * 32768;
        const int kb = j * KVBLK;
        bool rowsel = true, act = true;
        if (KIND == 2) { const unsigned wsel = ((const unsigned*)(lds + L_SELM))[qloc * 4 + (j >> 5)]; rowsel = ((wsel >> (j & 31)) & 1u) != 0u; act = __any(rowsel); }
        if (act) {
            f32x16 p0, p1;
            SEC_T(5);
            qkt(p0, p1, K_lds, r32, hi, qr);
            SEC_T(1);
            if (KIND == 2) {
                if (j == qb) mask_tile(p0, p1, pos - kb - 4 * hi, W);
            } else if (KIND == 0) { if (j == qb || j + 8 == qb) mask_tile(p0, p1, pos - kb - 4 * hi, W); }
            else { if (kb + 63 > 4 * qb - 2) mask_tile(p0, p1, pos - kb - 4 * hi, W); }
            if (MODE == 0) {
                const float pmax = rowmax32(p0, p1), mn = fmaxf(m_reg, pmax), alpha = __builtin_amdgcn_exp2f((m_reg - mn) * C2), mnL = -mn * C2;
#pragma unroll
                for (int r = 0; r < 16; ++r) { p0[r] = __builtin_amdgcn_exp2f(fmaf(p0[r], C2, mnL)); p1[r] = __builtin_amdgcn_exp2f(fmaf(p1[r], C2, mnL)); }
                l_reg = l_reg * alpha + rowsum32(p0, p1); m_reg = mn;
            } else {
                if (MODE == 1) {
                    const float mnL = -m_reg * C2;
#pragma unroll
                    for (int r = 0; r < 16; ++r) { p0[r] = __builtin_amdgcn_exp2f(fmaf(p0[r], C2, mnL)); p1[r] = __builtin_amdgcn_exp2f(fmaf(p1[r], C2, mnL)); }
                    float* imp = (float*)(lds + L_IMP) + qloc * 128 + (kb >> 2);
#pragma unroll
                    for (int half = 0; half < 2; ++half)
#pragma unroll
                        for (int i = 0; i < 4; ++i) {
                            const f32x16& P = half ? p1 : p0;
                            float G = ((P[4 * i] + P[4 * i + 1]) + (P[4 * i + 2] + P[4 * i + 3])) * f_imp, L = P[4 * i + 3] * f_imp;
                            G += __shfl_xor(G, 1); G += __shfl_xor(G, 2); L += __shfl_xor(L, 1); L += __shfl_xor(L, 2);
                            const int jl = half * 8 + 2 * i + hi;
                            if ((r32 & 3) == 0) { atomicAdd(imp + jl, G); if ((kb >> 2) + jl + 1 < 128) atomicAdd(imp + jl + 1, L); }
                        }
#pragma unroll
                    for (int r = 0; r < 16; ++r) { p0[r] *= f_o; p1[r] *= f_o; }
                } else {
                    float pmax = rowmax32(p0, p1); if (KIND == 2 && !rowsel) pmax = -__builtin_inff();
                    float mn, alpha;
                    if (__all((pmax - m_reg) * SCALE <= THR)) { mn = m_reg; alpha = 1.f; }
                    else { mn = fmaxf(m_reg, pmax); alpha = __builtin_amdgcn_exp2f((m_reg - mn) * C2); m_reg = mn; }
                    const float mnL = (KIND == 2 && !rowsel) ? -__builtin_inff() : -mn * C2;
#pragma unroll
                    for (int r = 0; r < 16; ++r) { p0[r] = __builtin_amdgcn_exp2f(fmaf(p0[r], C2, mnL)); p1[r] = __builtin_amdgcn_exp2f(fmaf(p1[r], C2, mnL)); }
                    l_reg = l_reg * alpha + rowsum32(p0, p1);
                    if (__any(alpha < 1.f)) { asm volatile("s_waitcnt lgkmcnt(0)" ::: "memory"); if (hi == 0) al_l[r32] = alpha; asm volatile("s_waitcnt lgkmcnt(0)" ::: "memory");
#pragma unroll
                        for (int r = 0; r < 16; ++r) { const float a = al_l[crow(r, hi)];
#pragma unroll
                            for (int d_ = 0; d_ < 4; ++d_) o[d_][r] *= a; }
                        asm volatile("s_waitcnt lgkmcnt(0)" ::: "memory"); }
                }
                bf16x8 pa0, pa1, pa2, pa3;
                packP(p0, p1, pa0, pa1, pa2, pa3);
                SEC_T(2);
                pv_tile(o, vbase + cur * 32768, pa0, pa1, pa2, pa3);
                SEC_T(3);
            }
        }
        SEC_T(6);
        __syncthreads();
        SEC_T(4);
    }
#undef NSA_DMA
}
template <int STEP>
__device__ __forceinline__ void fold(const f32x16* o, float f, char* lds, int wid, int r32, int hi, bf16_t* orow0  , bool do_store) {
    float* li_l = (float*)(lds + L_WS) + wid * 64;
    unsigned* park = (unsigned*)(lds + L_PARK + wid * 8192);
    asm volatile("s_waitcnt lgkmcnt(0)" ::: "memory");
    if (hi == 0) li_l[r32] = f;
    asm volatile("s_waitcnt lgkmcnt(0)" ::: "memory");
#pragma unroll
    for (int r = 0; r < 16; ++r) { const int wrow = crow(r, hi); const float a = li_l[wrow];
#pragma unroll
        for (int d0 = 0; d0 < 4; ++d0) { float v = o[d0][r] * a, vn = __shfl_xor(v, 1);
            if ((r32 & 1) == 0) { const int idx = wrow * 64 + d0 * 16 + (r32 >> 1);
                if (STEP > 0) { const unsigned u = park[idx]; v += __builtin_bit_cast(float, u << 16); vn += __builtin_bit_cast(float, u & 0xffff0000u); }
                if (STEP < 2) park[idx] = cvtpk(v, vn);
                else if (do_store) *(unsigned*)(orow0 + (size_t)(wid * 8 + (wrow >> 2)) * 2048 + (wrow & 3) * 128 + d0 * 32 + r32) = cvtpk(v, vn); } } }
    asm volatile("s_waitcnt lgkmcnt(0)" ::: "memory");
}

__device__ __forceinline__ float bf2f(bf16_t v) { return __builtin_bit_cast(float, (unsigned)v << 16); }
__device__ __forceinline__ float sigm(float x) { return __builtin_amdgcn_rcpf(1.f + __builtin_amdgcn_exp2f(-1.4426950408889634f * x)); }

__device__ __forceinline__ void nsa_unit(int b, int g, int qb, const bf16_t* Q, const bf16_t* KV4, const bf16_t* KCMP, const bf16_t* VCMP, const bf16_t* NSAG, bf16_t* OUT, char* lds, bool do_store) {
    const int tid = threadIdx.x, wid = __builtin_amdgcn_readfirstlane(tid >> 6), lane = tid & 63, r32 = lane & 31, hi = lane >> 5;
    const int ql = wid * 8 + (r32 >> 2), h = r32 & 3, t = qb * 64 + ql;
    const size_t row = (size_t)b * SEQ + t;
    bf16x8 qr[8];
    { const bf16_t* qp = Q + row * 2048 + g * 512 + h * 128 + hi * 8;
#pragma unroll
      for (int d0 = 0; d0 < 8; ++d0) qr[d0] = *(const bf16x8*)(qp + d0 * 16); }
    { f32x4* z = (f32x4*)((float*)(lds + L_IMP) + wid * 8 * 128) + lane;
#pragma unroll
      for (int i = 0; i < 4; ++i) z[64 * i] = (f32x4){0.f, 0.f, 0.f, 0.f}; }
    const float gc = sigm(bf2f(NSAG[row * 64 + 0 * 16 + g * 4 + h])), gs = sigm(bf2f(NSAG[row * 64 + 1 * 16 + g * 4 + h])), gw = sigm(bf2f(NSAG[row * 64 + 2 * 16 + g * 4 + h]));
    const int bg = b * 4 + g;
    const size_t TSTR = (size_t)8 * SEQ * D;
    f32x16 o[4];
#pragma unroll
    for (int d_ = 0; d_ < 4; ++d_) o[d_] = f32x16{};
    {
        const bf16_t* kc = KCMP + (size_t)bg * 512 * D; const bf16_t* vc = VCMP + (size_t)bg * 512 * D;
        const int nmax = (t - 31) >> 4, jh = (4 * qb + 3 + 63) >> 6;
        float m1 = -1e30f, l1 = 0.f;
        attend<0, 1>(kc, vc, 0, jh, nmax, 0x7fffffffu, lds, qr, m1, l1, o, 0.f, 0.f, qb);
        const float inv_l = l1 > 0.f ? 1.f / l1 : 0.f;
        attend<1, 1>(kc, vc, 0, jh, nmax, 0x7fffffffu, lds, qr, m1, l1, o, inv_l, gc * inv_l, qb);
    }
    {
        asm volatile("s_waitcnt lgkmcnt(0)" ::: "memory");
        unsigned* SELM = (unsigned*)(lds + L_SELM);
        const unsigned* IMPu = (const unsigned*)(lds + L_IMP);
        if (qb >= 16) {
            for (int i = 0; i < 8; ++i) {
                const int q = wid * 8 + i;
                const unsigned vlo = IMPu[q * 128 + lane], vhi = IMPu[q * 128 + 64 + lane];
                const bool clo = (lane >= 1) && (lane <= qb - 2), chi = (64 + lane <= qb - 2);
                unsigned T = 0u;
                for (int bit = 30; bit >= 0; --bit) { const unsigned c = T | (1u << bit);
                    const int cnt = __popcll(__ballot(clo && vlo >= c)) + __popcll(__ballot(chi && vhi >= c));
                    if (cnt >= 13) T = c; }
                unsigned long long sel_lo = __ballot(clo && vlo > T), sel_hi = __ballot(chi && vhi > T);
                unsigned long long eq_lo = __ballot(clo && vlo == T), eq_hi = __ballot(chi && vhi == T);
                int need = 13 - __popcll(sel_lo) - __popcll(sel_hi);
                for (; need > 0; --need) {
                    if (eq_lo) { const unsigned long long lb = eq_lo & (0ull - eq_lo); sel_lo |= lb; eq_lo ^= lb; }
                    else if (eq_hi) { const unsigned long long lb = eq_hi & (0ull - eq_hi); sel_hi |= lb; eq_hi ^= lb; }
                }
                sel_lo |= 1ull;
                if (qb - 1 < 64) sel_lo |= 1ull << (qb - 1); else sel_hi |= 1ull << (qb - 1 - 64);
                if (qb < 64) sel_lo |= 1ull << qb; else sel_hi |= 1ull << (qb - 64);
                if (lane == 0) { SELM[q * 4 + 0] = (unsigned)sel_lo; SELM[q * 4 + 1] = (unsigned)(sel_lo >> 32); SELM[q * 4 + 2] = (unsigned)sel_hi; SELM[q * 4 + 3] = (unsigned)(sel_hi >> 32); }
            }
        } else {
            if (lane < 8) { const int q = wid * 8 + lane; SELM[q * 4 + 0] = (2u << qb) - 1u; SELM[q * 4 + 1] = 0u; SELM[q * 4 + 2] = 0u; SELM[q * 4 + 3] = 0u; }
        }
        asm volatile("s_waitcnt lgkmcnt(0)" ::: "memory");
    }
    __syncthreads();
    fold<0>(o, 1.f, lds, wid, r32, hi, nullptr, false);
    {
        const bf16_t* ks = KV4 + 0 * TSTR + (size_t)bg * SEQ * D; const bf16_t* vs = KV4 + 1 * TSTR + (size_t)bg * SEQ * D;
#pragma unroll
        for (int d_ = 0; d_ < 4; ++d_) o[d_] = f32x16{};
        float m = -1e30f, l = 0.f;
        attend<2, 2>(ks, vs, 0, qb + 1, t, 0x7fffffffu, lds, qr, m, l, o, 0.f, 0.f, qb);
        fold<1>(o, l > 0.f ? gs / l : 0.f, lds, wid, r32, hi, nullptr, false);
    }
    {
        const bf16_t* kw = KV4 + 2 * TSTR + (size_t)bg * SEQ * D; const bf16_t* vw = KV4 + 3 * TSTR + (size_t)bg * SEQ * D;
#pragma unroll
        for (int d_ = 0; d_ < 4; ++d_) o[d_] = f32x16{};
        float m = -1e30f, l = 0.f;
        attend<2, 0>(kw, vw, qb >= 8 ? qb - 8 : 0, qb + 1, t, 512u, lds, qr, m, l, o, 0.f, 0.f, qb);
        fold<2>(o, l > 0.f ? gw / l : 0.f, lds, wid, r32, hi, OUT + ((size_t)b * SEQ + qb * 64) * 2048 + g * 512, do_store);
    }
    __syncthreads();
}
#undef KSWZ
#undef SBAR
}
constexpr int NWAVES = 8;
constexpr int SEQ = 8192, M = 2 * SEQ, DM = 2048, FF = 5632, INW_SRC = 10288, INW = 10496, PW = 1024;
constexpr float RMS_EPS = 1e-6f;
constexpr size_t MiB = 1u << 20;
constexpr size_t WS_WIN = 0, WS_WPU = 42 * MiB, WS_WNU = 46 * MiB, WS_WOUT = 54 * MiB, WS_POOLW = 62 * MiB, WS_CW1 = 63 * MiB, WS_CW2 = 67 * MiB;
constexpr size_t WS_PEBP = 68 * MiB, WS_PEB = 68 * MiB + 512 * 1024, WS_SS = 68 * MiB + 768 * 1024  , WS_HIDC = 69 * MiB, WS_KVCMP = 73 * MiB;
constexpr size_t WS_CTL = 75 * MiB, CTL_BYTES = 16384;
constexpr size_t WS_WGU = 76 * MiB, WS_WD = 120 * MiB, WS_GNSA = 76 * MiB;
constexpr size_t WS_XN = 142 * MiB;
constexpr size_t WS_HID = 206 * MiB, WS_XP = 206 * MiB, WS_Q = 238 * MiB, WS_NSAG = 302 * MiB  , WS_KV4 = 304 * MiB, WS_HIDCP = 368 * MiB;
constexpr size_t WS_APOOL = 206 * MiB  ;
constexpr size_t WS_GPOOL = 384 * MiB, WS_KCVC = 448 * MiB, WS_POOLED = 481 * MiB, WS_END = 513 * MiB;
static_assert(WS_WIN + (size_t)INW * DM * 2 <= WS_WPU && WS_WGU + (size_t)2 * FF * DM * 2 <= WS_WD && WS_WD + (size_t)DM * FF * 2 <= WS_XN && WS_GNSA + (size_t)M * DM * 2 <= WS_XN, "ws map 1");
static_assert(WS_HID + (size_t)M * FF * 2 <= WS_GPOOL && WS_KV4 + (size_t)4 * M * 512 * 2 <= WS_HIDCP && WS_HIDCP + (size_t)2 * 8192 * 256 * 4 <= WS_GPOOL && WS_NSAG + (size_t)M * 64 * 2 <= WS_KV4 && WS_KCVC + (size_t)2 * M * 512 * 2 + 8192 <= WS_POOLED && WS_POOLED + (size_t)M * PW * 2 <= WS_END, "ws map 2");
constexpr int LDS_BYTES = 153600;
#define GAS __attribute__((address_space(1)))
#define LAS __attribute__((address_space(3)))
typedef unsigned short bf16;
typedef unsigned v4u __attribute__((ext_vector_type(4)));
typedef float f32x4 __attribute__((ext_vector_type(4)));
#define LDS_WAIT() asm volatile("s_waitcnt lgkmcnt(0)" ::: "memory")
__device__ __forceinline__ unsigned f2bf(float f) { unsigned u = __builtin_bit_cast(unsigned, f); return (u + 0x7fffu + ((u >> 16) & 1u)) >> 16; }
__device__ __forceinline__ unsigned pk2(float lo, float hi) { return f2bf(lo) | (f2bf(hi) << 16); }
__device__ __forceinline__ float wave_sum(float v) {
#pragma unroll
    for (int o = 1; o < 64; o <<= 1) v += __shfl_xor(v, o);
    return v;
}
struct TItem { int c0, nv, drow, k0; };
__device__ __forceinline__ void titem_load(float (&v)[32], const float* W, int N, const TItem& t, int lane, const float* kg) {
    const bool cv = 4 * (lane & 7) < t.nv; const float* p = W + (size_t)(t.k0 + (lane >> 3)) * N + t.c0 + 4 * (lane & 7);
#pragma unroll
    for (int i = 0; i < 8; ++i) { f32x4 q = cv ? *(const f32x4*)(p + (size_t)(8 * i) * N) : (f32x4){0.f, 0.f, 0.f, 0.f};
        if (kg) q = q * kg[t.k0 + 8 * i + (lane >> 3)];
        v[4 * i] = q.x; v[4 * i + 1] = q.y; v[4 * i + 2] = q.z; v[4 * i + 3] = q.w; }
}
__device__ __forceinline__ void titem_store(const float (&v)[32], int K, bf16* WT, const TItem& t, LAS float* scr, int lane) {
#pragma unroll
    for (int i = 0; i < 8; ++i)
#pragma unroll
        for (int e = 0; e < 4; ++e) scr[(8 * i + (lane >> 3)) * 33 + 4 * (lane & 7) + e] = v[4 * i + e];
    LDS_WAIT(); asm volatile("" ::: "memory");
    const int c = lane & 7;
#pragma unroll
    for (int j = 0; j < 4; ++j) { const int n = (lane >> 3) + 8 * j; const LAS float* s = scr + (8 * c) * 33 + n;
        v4u o; o.x = pk2(s[0 * 33], s[1 * 33]); o.y = pk2(s[2 * 33], s[3 * 33]); o.z = pk2(s[4 * 33], s[5 * 33]); o.w = pk2(s[6 * 33], s[7 * 33]);
        if (n < t.nv) *(v4u*)(WT + (size_t)(t.drow + n) * K + t.k0 + 8 * c) = o; }
    LDS_WAIT(); asm volatile("" ::: "memory");
}
__device__ __forceinline__ void transpose_seg(const float* W, int K, int N, int src0, int ncols, bf16* WT, int drow0, bool gu, LAS float* scr, int lane, int gw, int NGW, int& base, const float* kg = nullptr) {
    const int nblk = (ncols + 31) >> 5, nitems = (K >> 6) * nblk;
    int first = (gw - base) % NGW; if (first < 0) first += NGW;
    base = (base + nitems) % NGW;
#define TI_DECODE(t, it_) do { const int kb_ = (it_) / nblk, nb_ = (it_) - kb_ * nblk, c0_ = nb_ * 32; (t).nv = (ncols - c0_) < 32 ? (ncols - c0_) : 32; \
        (t).drow = gu ? (256 * (c0_ >> 7) + (c0_ & 127) + drow0) : (drow0 + c0_); (t).c0 = src0 + c0_; (t).k0 = kb_ * 64; } while (0)
    int it = first; if (it >= nitems) return;
    TItem tc, tn; float v[32], vn[32];
    TI_DECODE(tc, it); titem_load(v, W, N, tc, lane, kg);
    for (;;) {
        const int itn = it + NGW; const bool more = itn < nitems;
        if (more) { TI_DECODE(tn, itn); titem_load(vn, W, N, tn, lane, kg); }
        titem_store(v, K, WT, tc, scr, lane);
        if (!more) break;
#pragma unroll
        for (int i = 0; i < 32; ++i) v[i] = vn[i];
        tc = tn; it = itn;
    }
#undef TI_DECODE
}
__device__ __forceinline__ void rms_row_bf16(const float* xrow, const float* g, bf16* orow, int lane) {
    const f32x4* xr = (const f32x4*)xrow + lane; const f32x4* gr = (const f32x4*)g + lane;
    f32x4 v[8]; float s = 0.f;
#pragma unroll
    for (int j = 0; j < 8; ++j) { v[j] = xr[64 * j]; s += (v[j].x * v[j].x + v[j].y * v[j].y) + (v[j].z * v[j].z + v[j].w * v[j].w); }
    const float rs = 1.f / sqrtf(wave_sum(s) * (1.f / DM) + RMS_EPS);
    unsigned long long* o8 = (unsigned long long*)orow + lane;
#pragma unroll
    for (int j = 0; j < 8; ++j) { const f32x4 gg = gr[64 * j];
        o8[64 * j] = (unsigned long long)pk2(v[j].x * rs * gg.x, v[j].y * rs * gg.y) | ((unsigned long long)pk2(v[j].z * rs * gg.z, v[j].w * rs * gg.w) << 32); }
}
__device__ __forceinline__ void xg_row_bf16(const float* xrow, const float* g, bf16* orow, float* ssp, int lane) {
    const f32x4* xr = (const f32x4*)xrow + lane; const f32x4* gr = (const f32x4*)g + lane;
    f32x4 v[8]; float s = 0.f;
#pragma unroll
    for (int j = 0; j < 8; ++j) { v[j] = xr[64 * j]; s += (v[j].x * v[j].x + v[j].y * v[j].y) + (v[j].z * v[j].z + v[j].w * v[j].w); }
    s = wave_sum(s); if (lane == 0) *ssp = s;
    unsigned long long* o8 = (unsigned long long*)orow + lane;
#pragma unroll
    for (int j = 0; j < 8; ++j) { const f32x4 gg = g ? gr[64 * j] : (f32x4){1.f, 1.f, 1.f, 1.f};
        o8[64 * j] = g ? ((unsigned long long)pk2(v[j].x * gg.x, v[j].y * gg.y) | ((unsigned long long)pk2(v[j].z * gg.z, v[j].w * gg.w) << 32)) : ((unsigned long long)pk2(v[j].x, v[j].y) | ((unsigned long long)pk2(v[j].z, v[j].w) << 32)); }
}
__device__ __forceinline__ void rms_row_f32(float* xrow, const float* g, int lane) {
    f32x4* xr = (f32x4*)xrow + lane; const f32x4* gr = (const f32x4*)g + lane;
    f32x4 v[8]; float s = 0.f;
#pragma unroll
    for (int j = 0; j < 8; ++j) { v[j] = xr[64 * j]; s += (v[j].x * v[j].x + v[j].y * v[j].y) + (v[j].z * v[j].z + v[j].w * v[j].w); }
    const float rs = 1.f / sqrtf(wave_sum(s) * (1.f / DM) + RMS_EPS);
#pragma unroll
    for (int j = 0; j < 8; ++j) { const f32x4 gg = gr[64 * j]; xr[64 * j] = (f32x4){v[j].x * rs * gg.x, v[j].y * rs * gg.y, v[j].z * rs * gg.z, v[j].w * rs * gg.w}; }
}
template <int WIN> __device__ __forceinline__ void pool_rows(const bf16* XP, bf16* POOLED, int rp, int gi, int lane) {
    const int row = 2 * rp + (lane >> 5), c8 = gi * 256 + (lane & 31) * 8, t = row & (SEQ - 1);
    v4u w[WIN];
#pragma unroll
    for (int j = 0; j < WIN; ++j) { const int rr = (j <= t) ? row - j : row; w[j] = *(const v4u*)(XP + (size_t)rr * PW + c8); }
    float acc[8] = {0.f, 0.f, 0.f, 0.f, 0.f, 0.f, 0.f, 0.f};
#pragma unroll
    for (int j = 0; j < WIN; ++j) { const float k = (j <= t) ? 1.f : 0.f;
        acc[0] += k * pg8::bf_lo(w[j].x); acc[1] += k * pg8::bf_hi(w[j].x); acc[2] += k * pg8::bf_lo(w[j].y); acc[3] += k * pg8::bf_hi(w[j].y);
        acc[4] += k * pg8::bf_lo(w[j].z); acc[5] += k * pg8::bf_hi(w[j].z); acc[6] += k * pg8::bf_lo(w[j].w); acc[7] += k * pg8::bf_hi(w[j].w); }
    const int n = (t + 1) < WIN ? (t + 1) : WIN; const float inv = 1.f / (float)n;
    v4u o; o.x = pk2(acc[0] * inv - pg8::bf_lo(w[0].x), acc[1] * inv - pg8::bf_hi(w[0].x)); o.y = pk2(acc[2] * inv - pg8::bf_lo(w[0].y), acc[3] * inv - pg8::bf_hi(w[0].y));
    o.z = pk2(acc[4] * inv - pg8::bf_lo(w[0].z), acc[5] * inv - pg8::bf_hi(w[0].z)); o.w = pk2(acc[6] * inv - pg8::bf_lo(w[0].w), acc[7] * inv - pg8::bf_hi(w[0].w));
    *(v4u*)(POOLED + (size_t)row * PW + c8) = o;
}
__device__ __forceinline__ void pool_item(const bf16* XP, bf16* POOLED, int rp, int gi, int lane) {
    if (gi == 0) pool_rows<2>(XP, POOLED, rp, gi, lane); else if (gi == 1) pool_rows<4>(XP, POOLED, rp, gi, lane);
    else if (gi == 2) pool_rows<8>(XP, POOLED, rp, gi, lane); else pool_rows<16>(XP, POOLED, rp, gi, lane);
}
using pg8::u32x4;
struct FWin {
    struct Pre {}; __device__ __forceinline__ void load(Pre&, int, int) const {}
    bf16 *XP, *Q, *KCVC, *KV4, *GPOOL, *GNSA;
    __device__ __forceinline__ void operator()(int row, int col, int pn, pg8::f32x4 v0, pg8::f32x4 v1, const Pre& pre) const {
        const u32x4 w = pg8::pack8(v0, v1); bf16* dst;
        if (pn < 4) dst = XP + (size_t)row * 1024 + col;
        else if (pn < 12) dst = Q + (size_t)row * 2048 + (col - 1024);
        else if (pn < 24) { const int c = col - 3072, tensor = c >> 9, g = (c >> 7) & 3, d = c & 127, b = row >> 13, t = row & 8191;
            dst = (tensor < 2 ? KCVC + (size_t)tensor * 8 * SEQ * 128 : KV4 + (size_t)(tensor - 2) * 8 * SEQ * 128) + ((size_t)(b * 4 + g) * SEQ + t) * 128 + d; }
        else if (pn < 32) dst = GPOOL + (size_t)row * 2048 + (col - 6144);
        else dst = GNSA + (size_t)row * 2048 + (col - 8192);
        *(u32x4*)dst = w;
    }
};
struct FSiluBias { bf16* O; const float* bias;
    struct Pre {}; __device__ __forceinline__ void load(Pre&, int, int) const {}
    __device__ __forceinline__ void operator()(int row, int col, int pn, pg8::f32x4 v0, pg8::f32x4 v1, const Pre& pre) const {
        const float* bp = bias + ((row >> 12) << 8) + col; const pg8::f32x4 b0 = *(const pg8::f32x4*)bp, b1 = *(const pg8::f32x4*)(bp + 4);
#pragma unroll
        for (int j = 0; j < 4; ++j) { v0[j] = pg8::siluf_(v0[j] + b0[j]); v1[j] = pg8::siluf_(v1[j] + b1[j]); }
        *(u32x4*)(O + (size_t)row * 256 + col) = pg8::pack8(v0, v1);
    }
};
struct FGates { bf16* O;
    struct Pre {}; __device__ __forceinline__ void load(Pre&, int, int) const {}
    __device__ __forceinline__ void operator()(int row, int col, int pn, pg8::f32x4 v0, pg8::f32x4 v1, const Pre& pre) const {
        if (col < 64) *(u32x4*)(O + (size_t)row * 64 + col) = pg8::pack8(v0, v1);
    }
};
struct FPartial { float* O;
    struct Pre {}; __device__ __forceinline__ void load(Pre&, int, int) const {}
    __device__ __forceinline__ void operator()(int row, int col, int pn, pg8::f32x4 v0, pg8::f32x4 v1, const Pre& pre) const {
        float* p = O + ((size_t)pn * 8192 + row) * 256 + (col & 255); *(pg8::f32x4*)p = v0; *(pg8::f32x4*)(p + 4) = v1;
    }
};
struct FStore128 { bf16* O;
    struct Pre {}; __device__ __forceinline__ void load(Pre&, int, int) const {}
    __device__ __forceinline__ void operator()(int row, int col, int pn, pg8::f32x4 v0, pg8::f32x4 v1, const Pre& pre) const {
        if (col < 128) *(u32x4*)(O + (size_t)row * 128 + col) = pg8::pack8(v0, v1);
    }
};
struct FPool { bf16* O; const float* scale;
    struct Pre {}; __device__ __forceinline__ void load(Pre&, int, int) const {}
    __device__ __forceinline__ void operator()(int row, int col, int pn, pg8::f32x4 v0, pg8::f32x4 v1, const Pre& pre) const {
        const pg8::f32x4 s0 = *(const pg8::f32x4*)(scale + col), s1 = *(const pg8::f32x4*)(scale + col + 4);
        *(u32x4*)(O + (size_t)row * PW + col) = pg8::pack8(v0 * s0, v1 * s1);
    }
};
struct FGate { bf16* MG; const bf16* Gt; bool add;
    struct Pre { u32x4 g, m; };
    __device__ __forceinline__ void load(Pre& p, int row, int col) const { const size_t off = (size_t)row * DM + col; p.g = *(const u32x4*)(Gt + off); if (add) p.m = *(const u32x4*)(MG + off); }
    __device__ __forceinline__ void operator()(int row, int col, int pn, pg8::f32x4 v0, pg8::f32x4 v1, const Pre& pre) const {
        const size_t off = (size_t)row * DM + col;
        const u32x4 gw = pre.g;
        pg8::f32x4 r0, r1;
        r0[0] = pg8::sigmoidf_(pg8::bf_lo(gw.x)) * v0[0]; r0[1] = pg8::sigmoidf_(pg8::bf_hi(gw.x)) * v0[1]; r0[2] = pg8::sigmoidf_(pg8::bf_lo(gw.y)) * v0[2]; r0[3] = pg8::sigmoidf_(pg8::bf_hi(gw.y)) * v0[3];
        r1[0] = pg8::sigmoidf_(pg8::bf_lo(gw.z)) * v1[0]; r1[1] = pg8::sigmoidf_(pg8::bf_hi(gw.z)) * v1[1]; r1[2] = pg8::sigmoidf_(pg8::bf_lo(gw.w)) * v1[2]; r1[3] = pg8::sigmoidf_(pg8::bf_hi(gw.w)) * v1[3];
        if (add) { const u32x4 mw = pre.m;
            r0[0] += pg8::bf_lo(mw.x); r0[1] += pg8::bf_hi(mw.x); r0[2] += pg8::bf_lo(mw.y); r0[3] += pg8::bf_hi(mw.y);
            r1[0] += pg8::bf_lo(mw.z); r1[1] += pg8::bf_hi(mw.z); r1[2] += pg8::bf_lo(mw.w); r1[3] += pg8::bf_hi(mw.w); }
        *(u32x4*)(MG + off) = pg8::pack8(r0, r1);
    }
};

#define XB_TMO      128
#define XB_XCNT(j)  (256  + 64 * (j))
#define XB_XSUB(j)  (1280 + 64 * (j))
#define XB_XGEN(j)  (2304 + 64 * (j))
#define XB_TOP      3328
#define XB_TOPGEN   3392
#define XCD_BAR_WORDS 3456
#define XB_SPIN_CAP (1u << 18)

__device__ __forceinline__ unsigned xb_ld(unsigned* p)              { return __hip_atomic_load(p, __ATOMIC_RELAXED, __HIP_MEMORY_SCOPE_AGENT); }
__device__ __forceinline__ unsigned xb_add(unsigned* p, unsigned v) { return __hip_atomic_fetch_add(p, v, __ATOMIC_RELAXED, __HIP_MEMORY_SCOPE_AGENT); }
__device__ __forceinline__ unsigned xb_xcc_id() { return (unsigned)__builtin_amdgcn_s_getreg((3 << 11) | 20) & 0xFu; }
#define XB_SPIN(cond, bar) do { unsigned _sp = 0; while (cond) { __builtin_amdgcn_s_sleep(1); \
    if ((++_sp & 255u) == 0u) { if (xb_ld(&(bar)[XB_TMO])) break; if (_sp > XB_SPIN_CAP) { atomicAdd(&(bar)[XB_TMO], 1u); break; } } } } while (0)

struct XcdBarrier {
    unsigned* bar; unsigned x;
    volatile LAS unsigned* st;
};

__device__ __forceinline__ XcdBarrier xcd_barrier_post(unsigned* bar, volatile LAS unsigned* st) {
    XcdBarrier b; b.bar = bar; b.x = xb_xcc_id(); b.st = st;
    if (threadIdx.x == 0) (void)xb_add(&bar[XB_XCNT(b.x)], 1u);
    return b;
}
__device__ __forceinline__ void xcd_barrier_complete(unsigned* bar, unsigned x, unsigned& nloc, unsigned& nx) {
    const unsigned G = gridDim.x * gridDim.y * gridDim.z;
    unsigned sum, cnt, mine, sp = 0u;
    for (;;) {
        sum = 0u; cnt = 0u; mine = 0u;
#pragma unroll
        for (unsigned j = 0; j < 16; ++j) { const unsigned c = xb_ld(&bar[XB_XCNT(j)]); sum += c; cnt += (c > 0u) ? 1u : 0u; mine = (j == x) ? c : mine; }
        if (sum == G) break;
        __builtin_amdgcn_s_sleep(1);
        if ((++sp & 255u) == 0u) { if (xb_ld(&bar[XB_TMO])) break; if (sp > XB_SPIN_CAP) { atomicAdd(&bar[XB_TMO], 1u); break; } }
    }
    nloc = mine > 0u ? mine : 1u; nx = cnt > 0u ? cnt : 1u;
}

__device__ __forceinline__ void xcd_barrier(const XcdBarrier& b) {
    asm volatile("s_waitcnt vmcnt(0)" ::: "memory");
    __syncthreads();
    if (threadIdx.x == 0) {
        unsigned* bar = b.bar;
        __builtin_amdgcn_s_waitcnt(0);
        unsigned nloc = b.st[0], nx = b.st[1];
        if (nloc == 0u) { xcd_barrier_complete(bar, b.x, nloc, nx); b.st[0] = nloc; b.st[1] = nx; }
        const unsigned old = xb_add(&bar[XB_XSUB(b.x)], 1u);
        const unsigned gen = old / nloc;
        if (old + 1u == (gen + 1u) * nloc) {
            __builtin_amdgcn_fence(__ATOMIC_RELEASE, "agent");
            asm volatile("s_waitcnt vmcnt(0)" ::: "memory");
            const unsigned og = xb_add(&bar[XB_TOP], 1u);
            const unsigned tg = og / nx;
            if (og + 1u == (tg + 1u) * nx) xb_add(&bar[XB_TOPGEN], 1u);
            else XB_SPIN(xb_ld(&bar[XB_TOPGEN]) == tg, bar);
            __builtin_amdgcn_fence(__ATOMIC_ACQUIRE, "agent");
            xb_add(&bar[XB_XGEN(b.x)], 1u);
            asm volatile("s_waitcnt vmcnt(0)" ::: "memory");
        } else {
            XB_SPIN(xb_ld(&bar[XB_XGEN(b.x)]) == gen, bar);
            __builtin_amdgcn_fence(__ATOMIC_ACQUIRE, "agent");
            asm volatile("s_waitcnt vmcnt(0)" ::: "memory");
        }
    }
    __syncthreads();
}

struct Args { const float* in[23]; float* out; unsigned char* ws; int ph_lo, ph_hi; };
enum { I_X = 0, I_F1N, I_F1G, I_F1U, I_F1D, I_MIXN, I_WIN, I_POOLW, I_POOLS, I_PEK, I_PEV, I_CKW1, I_CKW2, I_CVW1, I_CVW2, I_WPU, I_WNU, I_WOUT, I_F2N, I_F2G, I_F2U, I_F2D, I_FINN };
constexpr int N_PHASES = 12;

template <class Epi> __device__ __forceinline__ void run_gemm(LAS unsigned char* lds, const bf16* A, int lda, const bf16* Bt, int ldb, int Mr, int N, int K, int G, int c, const Epi& E, int apn = 0, int bdiv = 1 << 30, int bbytes = 0, int bpn = -1) {
    pg8::Gemm g{A, Bt, Mr, N, K, lda, ldb, apn, bpn >= 0 ? bpn : 256 * ldb * 2, bdiv, bbytes}; pg8::StaticOrder S; S.init(Mr, N, G, c);
    pg8::gemm_phase<Epi, pg8::StaticOrder, true, true>(lds, g, S, E);
    __syncthreads();
}

__global__ void __launch_bounds__(NWAVES * 64, 2) mk_fwd(Args a) {
    extern __shared__ __attribute__((aligned(16))) unsigned char lds_raw[];
    LAS unsigned char* lds = (LAS unsigned char*)lds_raw;
    const int tid = threadIdx.x, lane = tid & 63, wave = __builtin_amdgcn_readfirstlane(tid >> 6);
    const int G = gridDim.x, bx = blockIdx.x;
    const int vcu = (G % 8 == 0) ? (bx % 8) * (G / 8) + bx / 8 : bx;
    const int gw = vcu * NWAVES + wave, NGW = G * NWAVES;
    unsigned char* ws = a.ws;
    bf16* Win_t = (bf16*)(ws + WS_WIN); bf16* Wpu_t = (bf16*)(ws + WS_WPU); bf16* Wnu_t = (bf16*)(ws + WS_WNU); bf16* Wout_t = (bf16*)(ws + WS_WOUT);
    bf16* Poolw_t = (bf16*)(ws + WS_POOLW); bf16* Cw1_t = (bf16*)(ws + WS_CW1); bf16* Cw2_t = (bf16*)(ws + WS_CW2);
    float* PEBP = (float*)(ws + WS_PEBP); float* PEB = (float*)(ws + WS_PEB); float* SS0 = (float*)(ws + WS_SS); float* SS1 = SS0 + M; float* SS2 = SS1 + M;
    bf16* HIDC = (bf16*)(ws + WS_HIDC); bf16* KVCMP = (bf16*)(ws + WS_KVCMP);
    bf16* Wgu_t = (bf16*)(ws + WS_WGU); bf16* Wd_t = (bf16*)(ws + WS_WD); bf16* GNSA = (bf16*)(ws + WS_GNSA);
    bf16* XN = (bf16*)(ws + WS_XN); bf16* POOLED = (bf16*)(ws + WS_POOLED); bf16* APOOL = (bf16*)(ws + WS_APOOL); float* HIDCP = (float*)(ws + WS_HIDCP);
    bf16* HID = (bf16*)(ws + WS_HID); bf16* XP = (bf16*)(ws + WS_XP); bf16* Q = (bf16*)(ws + WS_Q); bf16* KV4 = (bf16*)(ws + WS_KV4); bf16* KCVC = (bf16*)(ws + WS_KCVC); bf16* NSAG = (bf16*)(ws + WS_NSAG);
    bf16* GPOOL = (bf16*)(ws + WS_GPOOL);
    float* H = a.out;
    const int lo = a.ph_lo, hi = a.ph_hi;
    volatile LAS unsigned* xb_st = (volatile LAS unsigned*)(lds + 152608);
    if (tid == 0) { xb_st[0] = 0u; xb_st[1] = 0u; }
    __syncthreads();
    XcdBarrier xbar; xbar.bar = (unsigned*)(ws + WS_CTL); xbar.x = 0; xbar.st = nullptr;
    if (hi - lo > 1) xbar = xcd_barrier_post((unsigned*)(ws + WS_CTL), xb_st);
#ifndef MK_PHASE_MASK
#define MK_PHASE_MASK 0xfff
#endif
#define IN(k) (((MK_PHASE_MASK >> (k)) & 1) && lo <= (k) && (k) < hi)
#ifndef MK_REP_MASK
#define MK_REP_MASK 0
#endif
#define REP(k) ((MK_REP_MASK >> (k)) & 1)
#ifndef MK_PROBE_K
#define MK_PROBE_K -1
#endif
#ifndef MK_PROBE_MULT
#define MK_PROBE_MULT 1
#endif
    volatile LAS unsigned long long* stamps = (volatile LAS unsigned long long*)(lds + 152576);
    if (bx == 0 && tid == 0) *(volatile LAS unsigned*)(lds + 152592) = 0u;
    if (MK_PROBE_K == 0 && bx == 0 && tid == 0) stamps[0] = __builtin_amdgcn_s_memrealtime();
#ifndef MK_XSYNC
#define MK_XSYNC 0
#endif
#define SEAM(k) do { if (IN(k) && IN((k) + 1)) { if (a.ph_lo < 0) { __syncthreads(); cg::this_grid().sync(); }     \
            xcd_barrier(xbar); for (int xs_ = 0; xs_ < ((k) == 1 ? MK_XSYNC : 0); ++xs_) xcd_barrier(xbar); } \
        if (MK_PROBE_K >= 0 && bx == 0 && tid == 0) { if ((k) == MK_PROBE_K - 1) stamps[0] = __builtin_amdgcn_s_memrealtime(); if ((k) == MK_PROBE_K) stamps[1] = __builtin_amdgcn_s_memrealtime(); } } while (0)
    LAS float* scr = (LAS float*)(lds + wave * 16384);

    if (IN(0)) for (int rep = 0; rep <= REP(0); ++rep) {
        int base = 0;
        transpose_seg(a.in[I_F1G], DM, FF, 0, FF, Wgu_t, 0, true, scr, lane, gw, NGW, base, a.in[I_F1N]);
        transpose_seg(a.in[I_F1U], DM, FF, 0, FF, Wgu_t, 128, true, scr, lane, gw, NGW, base, a.in[I_F1N]);
        transpose_seg(a.in[I_F1D], FF, DM, 0, DM, Wd_t, 0, false, scr, lane, gw, NGW, base);
        transpose_seg(a.in[I_WIN], DM, INW_SRC, 0, 6144, Win_t, 0, false, scr, lane, gw, NGW, base, a.in[I_MIXN]);
        transpose_seg(a.in[I_WIN], DM, INW_SRC, 6192, 2048, Win_t, 6144, false, scr, lane, gw, NGW, base, a.in[I_MIXN]);
        transpose_seg(a.in[I_WIN], DM, INW_SRC, 8240, 2048, Win_t, 8192, false, scr, lane, gw, NGW, base, a.in[I_MIXN]);
        transpose_seg(a.in[I_WIN], DM, INW_SRC, 6144, 48, Win_t, 10240, false, scr, lane, gw, NGW, base, a.in[I_MIXN]);
        transpose_seg(a.in[I_WPU], PW, DM, 0, DM, Wpu_t, 0, false, scr, lane, gw, NGW, base);
        transpose_seg(a.in[I_WNU], DM, DM, 0, DM, Wnu_t, 0, false, scr, lane, gw, NGW, base);
        transpose_seg(a.in[I_WOUT], DM, DM, 0, DM, Wout_t, 0, false, scr, lane, gw, NGW, base);
        for (int gi = 0; gi < 4; ++gi) transpose_seg(a.in[I_POOLW] + (size_t)gi * 65536, 256, 256, 0, 256, Poolw_t + (size_t)gi * 65536, 0, false, scr, lane, gw, NGW, base);
        transpose_seg(a.in[I_CKW1], 4096, 256, 0, 256, Cw1_t, 0, false, scr, lane, gw, NGW, base);
        transpose_seg(a.in[I_CVW1], 4096, 256, 0, 256, Cw1_t + (size_t)256 * 4096, 0, false, scr, lane, gw, NGW, base);
        transpose_seg(a.in[I_CKW2], 256, 128, 0, 128, Cw2_t, 0, false, scr, lane, gw, NGW, base);
        transpose_seg(a.in[I_CVW2], 256, 128, 0, 128, Cw2_t + 65536, 0, false, scr, lane, gw, NGW, base);
        for (int m = gw; m < M; m += NGW) xg_row_bf16(a.in[I_X] + (size_t)m * DM, nullptr, XN + (size_t)m * DM, SS0 + m, lane);
        for (int i = vcu * 512 + tid; i < 2 * M; i += G * 512) SS1[i] = 0.f;
        if (wave == NWAVES - 1) for (int task = vcu; task < 256; task += G) {
            const int tensor = task >> 7, chunk = (task >> 2) & 31, col = (task & 3) * 64 + lane;
            const float* pe = a.in[tensor ? I_PEV : I_PEK] + chunk * 128; const float* w1 = a.in[tensor ? I_CVW1 : I_CKW1] + (size_t)chunk * 128 * 256 + col;
            float acc = 0.f;
#pragma unroll 16
            for (int k = 0; k < 128; ++k) acc += pe[k] * w1[(size_t)k * 256];
            PEBP[(tensor * 32 + chunk) * 256 + col] = acc;
        }
    }
    SEAM(0);
    if (IN(1)) for (int rep = 0; rep <= REP(1); ++rep) { pg8::EpiSwiglu E{HID, FF, SS0}; run_gemm(lds, XN, DM, Wgu_t, DM, M, 2 * FF, DM, G, bx, E); }
    SEAM(1);
    if (IN(2)) { pg8::EpiResBf<false, true, false> E{a.in[I_X], nullptr, nullptr, XN, SS1, DM, 0.5f}; run_gemm(lds, HID, FF, Wd_t, FF, M, DM, FF, G, bx, E); }
    SEAM(2);
    if (IN(3)) for (int rep = 0; rep <= REP(3); ++rep) {
        if (bx == G - 1) { float pv[32];
#pragma unroll
            for (int c = 0; c < 32; ++c) pv[c] = PEBP[((tid >> 8) * 32 + c) * 256 + (tid & 255)];
            float s = 0.f;
#pragma unroll
            for (int c = 0; c < 32; ++c) s += pv[c];
            PEB[tid] = s; }
        pg8::EpiP8<FWin> E{FWin{XP, Q, KCVC, KV4, GPOOL, GNSA}, SS1}; run_gemm(lds, XN, DM, Win_t, DM, M, INW - 256, DM, G, bx, E); }
    SEAM(3);
    if (IN(4)) for (int rep = 0; rep <= REP(4); ++rep) {
        { pg8::EpiP8<FPartial> E{FPartial{HIDCP}, nullptr};
          run_gemm(lds, KCVC, 2048, Cw1_t, 4096, 8192, 512, 2048, G, bx, E, 2048 * 2, 16, 256 * 4096 * 2, 2048 * 2); }
        { pg8::EpiP8<FGates> E{FGates{NSAG}, SS1}; run_gemm(lds, XN, DM, Win_t + (size_t)10240 * DM, DM, M, 256, DM, G, (bx + G - 64 % G) % G, E); }
        const bool std = (G == 256);
        {
            constexpr int NIT = (M / 2) * 4, NA = (NIT * 27 / 32) & ~1023;
            if (!std) { for (int item = gw; item < NIT; item += NGW) pool_item(XP, POOLED, item >> 2, item & 3, lane); }
            else if (bx >= 128) { for (int item = (bx - 128) * NWAVES + wave; item < NA; item += 128 * NWAVES) pool_item(XP, POOLED, item >> 2, item & 3, lane); }
            else { for (int item = NA + bx * NWAVES + wave; item < NIT; item += 128 * NWAVES) pool_item(XP, POOLED, item >> 2, item & 3, lane); }
        }
    }
    SEAM(4);
    if (IN(5)) for (int rep = 0; rep <= REP(5); ++rep) {
        { pg8::StaticOrder S; S.init(8192, 256, G, bx); pg8::Unit u;
          if (S.next(0, u)) {
#pragma unroll 8
              for (int i = 0; i < 16; ++i) { const int e8 = i * 512 + tid, r = u.pm * 256 + (e8 >> 5), c8 = (e8 & 31) * 8;
                  const float* p0 = HIDCP + (size_t)r * 256 + c8; const float* p1 = p0 + (size_t)8192 * 256; const float* bp = PEB + ((r >> 12) << 8) + c8;
                  pg8::f32x4 a0 = *(const pg8::f32x4*)p0 + *(const pg8::f32x4*)p1 + *(const pg8::f32x4*)bp, a1 = *(const pg8::f32x4*)(p0 + 4) + *(const pg8::f32x4*)(p1 + 4) + *(const pg8::f32x4*)(bp + 4);
#pragma unroll
                  for (int j = 0; j < 4; ++j) { a0[j] = pg8::siluf_(a0[j]); a1[j] = pg8::siluf_(a1[j]); }
                  *(u32x4*)(HIDC + (size_t)r * 256 + c8) = pg8::pack8(a0, a1); }
              asm volatile("s_waitcnt vmcnt(0)" ::: "memory"); __syncthreads();
          } }
        { pg8::EpiP8<FStore128> E{FStore128{KVCMP}, nullptr}; run_gemm(lds, HIDC, 256, Cw2_t, 256, 8192, 256, 256, G, bx, E, 0, 16, 65536 * 2); }
        { pg8::EpiP8<FPool> E{FPool{APOOL, a.in[I_POOLS]}, nullptr}; run_gemm(lds, POOLED, PW, Poolw_t, 256, M, PW, 256, G, bx, E, 256 * 2); }
    }
    SEAM(5);
    if (IN(6)) {
        { pg8::EpiP8<FGate> E{FGate{GPOOL, GPOOL, false}, nullptr}; run_gemm(lds, APOOL, PW, Wpu_t, PW, M, DM, PW, G, bx, E); }
        for (int rep = REP(6) ? 0 : 1; rep < 2; ++rep)
        for (int it = vcu; it < 1024; it += G) {
            const int c = it & 255, k = it >> 8, bg = c >> 5, i = c & 31;
            const int qb = (k == 0) ? i : (k == 1) ? 63 - i : (k == 2) ? 64 + i : 127 - i;
            nsa::nsa_unit(bg >> 2, bg & 3, qb, Q, KV4, KVCMP, KVCMP + (size_t)4096 * 128, NSAG, Q, (char*)lds_raw, rep == 1 || a.ph_lo != 0);
        }
    }
    SEAM(6);
    if (IN(7)) { pg8::EpiP8<FGate> E{FGate{GPOOL, GNSA, true}, nullptr}; run_gemm(lds, Q, DM, Wnu_t, DM, M, DM, DM, G, bx, E); }
    SEAM(7);
    if (IN(8)) {
        int base = 0;
        transpose_seg(a.in[I_F2G], DM, FF, 0, FF, Wgu_t, 0, true, scr, lane, gw, NGW, base, a.in[I_F2N]);
        transpose_seg(a.in[I_F2U], DM, FF, 0, FF, Wgu_t, 128, true, scr, lane, gw, NGW, base, a.in[I_F2N]);
        transpose_seg(a.in[I_F2D], FF, DM, 0, DM, Wd_t, 0, false, scr, lane, gw, NGW, base);
        __syncthreads();
        pg8::EpiResBf<true, true, false> E{nullptr, XN, nullptr, XN, SS2, DM, 1.0f}; run_gemm(lds, GPOOL, DM, Wout_t, DM, M, DM, DM, G, bx, E);
    }
    SEAM(8);
    if (IN(9)) for (int rep = 0; rep <= REP(9); ++rep) { pg8::EpiSwiglu E{HID, FF, SS2}; run_gemm(lds, XN, DM, Wgu_t, DM, M, 2 * FF, DM, G, bx, E); }
    SEAM(9);
    if (IN(10)) { pg8::EpiResBf<true, false, true> E{nullptr, XN, H, nullptr, nullptr, DM, 0.5f}; run_gemm(lds, HID, FF, Wd_t, FF, M, DM, FF, G, bx, E); }
    SEAM(10);
    if (IN(11)) { for (int m = gw; m < M; m += NGW) rms_row_f32(H + (size_t)m * DM, a.in[I_FINN], lane); }
    if (MK_PROBE_K >= 0 && bx == 0 && tid == 0) {
        const unsigned long long te = __builtin_amdgcn_s_memrealtime(); const unsigned long long t1 = (MK_PROBE_K == N_PHASES - 1) ? te : stamps[1];
        const unsigned long long dt = (t1 - stamps[0]) * MK_PROBE_MULT;
        while (__builtin_amdgcn_s_memrealtime() - te < dt) __builtin_amdgcn_s_sleep(32);
    }
#ifdef MK_SEC
    if (MK_SEC && bx == 0 && tid == 0) { const unsigned long long te = __builtin_amdgcn_s_memrealtime(), dt = (unsigned long long)(*(volatile LAS unsigned*)(lds + 152592)) * MK_PROBE_MULT; while (__builtin_amdgcn_s_memrealtime() - te < dt) __builtin_amdgcn_s_sleep(32); }
#endif
#undef IN
#undef SEAM
}

#ifndef MK_ONE_LAUNCH
#define MK_ONE_LAUNCH 1
#endif
extern "C" void kernel_launch(void* const* d_in, const int* in_sizes, int n_in, void* d_out, int out_size, void* d_ws, size_t ws_size, hipStream_t stream) {
    static int grid = 0;
    if (grid == 0) {
        if (n_in != 23 || out_size != M * DM || ws_size < WS_END) { fprintf(stderr, "kernel_launch: unexpected shapes (n_in %d out %d ws %zu)\n", n_in, out_size, ws_size); grid = -1; return; }
        int dev = 0, cus = 0, per_cu = 0;
        (void)hipGetDevice(&dev); (void)hipDeviceGetAttribute(&cus, hipDeviceAttributeMultiprocessorCount, dev);
        if (hipFuncSetAttribute((const void*)mk_fwd, hipFuncAttributeMaxDynamicSharedMemorySize, LDS_BYTES) != hipSuccess) { fprintf(stderr, "kernel_launch: hipFuncSetAttribute failed\n"); grid = -1; return; }
        if (hipOccupancyMaxActiveBlocksPerMultiprocessor(&per_cu, (const void*)mk_fwd, NWAVES * 64, LDS_BYTES) != hipSuccess || per_cu < 1) { fprintf(stderr, "kernel_launch: occupancy query says %d\n", per_cu); per_cu = 1; }
        (void)hipGetLastError();
        grid = cus > 0 ? cus : 256;
    }
    if (grid < 0) return;
    Args a{};
    for (int i = 0; i < 23; ++i) a.in[i] = (const float*)d_in[i];
    a.out = (float*)d_out; a.ws = (unsigned char*)d_ws;
#if MK_ONE_LAUNCH
    (void)hipMemsetAsync((char*)d_ws + WS_CTL, 0, CTL_BYTES, stream);
    a.ph_lo = 0; a.ph_hi = N_PHASES;
    void* args[] = {&a};
    hipError_t e = hipLaunchCooperativeKernel((const void*)mk_fwd, dim3(grid), dim3(NWAVES * 64), args, LDS_BYTES, stream);
    if (e != hipSuccess) fprintf(stderr, "kernel_launch: cooperative launch failed: %s (grid %d)\n", hipGetErrorString(e), grid);
#else
    for (int p = 0; p < N_PHASES; ++p) { a.ph_lo = p; a.ph_hi = p + 1; hipLaunchKernelGGL(mk_fwd, dim3(grid), dim3(NWAVES * 64), LDS_BYTES, stream, a); }
#endif
}
```

```cpp
#include <hip/hip_runtime.h>
#include <hip/hip_cooperative_groups.h>
#include <cstdio>
#include <cstdint>
namespace cg = cooperative_groups;
namespace pg8 {
#define PG8_LAS __attribute__((address_space(3)))
typedef unsigned short bf16_t;
typedef short bf16x8 __attribute__((ext_vector_type(8)));
typedef float f32x4 __attribute__((ext_vector_type(4)));
typedef unsigned u32x4 __attribute__((ext_vector_type(4)));
constexpr int BM = 256, BK = 64, HALF = 128, HTB = HALF * BK * 2  , STAGE_BYTES = 8 * HTB, NXCD = 8, WGM = 4;

__host__ __device__ __forceinline__ int lds_byte(int r, int c) { const int st = (r >> 4) * 2 + (c >> 5), rr = r & 15, cc = c & 31, ob = rr * 64 + cc * 2; return st * 1024 + (ob ^ (((ob >> 9) & 1) << 5)); }
__host__ __device__ __forceinline__ void stage_rc(int b, int& R, int& C) { const int st = b / 1024, sb = b % 1024, swz = sb ^ (((sb >> 9) & 1) << 5); R = (st >> 1) * 16 + swz / 64; C = (st & 1) * 32 + (swz % 64) / 2; }
__host__ __device__ __forceinline__ int perm32(int rho) { const int n = rho >> 4, i = rho & 15; return 8 * (i >> 2) + 4 * n + (i & 3); }

struct Unit { int pm, pn; };
struct Gemm { const bf16_t* A; const bf16_t* Bt; int M, N, K, lda, ldb; int apn  , bpn  , bdiv, bbytes  ; };

struct StaticOrder {
    int nM, nN, nwg, G, c;
    __host__ __device__ __forceinline__ void init(int M, int N, int G_, int c_) { nM = M / BM; nN = N / BM; nwg = nM * nN; G = G_; c = c_; }
    __host__ __device__ __forceinline__ bool next(int i, Unit& u) const {
        const long L = (long)i * G + c; if (L >= nwg) return false;
        int wgid = (int)L; { const int q = nwg / NXCD, r = nwg % NXCD, xcd = wgid % NXCD, off = wgid / NXCD; wgid = (xcd < r ? xcd * (q + 1) : r * (q + 1) + (xcd - r) * q) + off; }
        const int nig = WGM * nN, gid = wgid / nig, fm = gid * WGM, gsz = (nM - fm) < WGM ? (nM - fm) : WGM;
        u.pm = fm + ((wgid % nig) % gsz); u.pn = (wgid % nig) / gsz; return true;
    }
    __device__ __forceinline__ void a_ready(const Unit&) const {}
    __device__ __forceinline__ void done(const Unit&) const {}
};

__device__ __forceinline__ unsigned cvt_pk_bf16(float lo, float hi) { unsigned r; asm volatile("v_cvt_pk_bf16_f32 %0, %1, %2" : "=v"(r) : "v"(lo), "v"(hi)); return r; }
__device__ __forceinline__ float bf_lo(unsigned w) { return __builtin_bit_cast(float, w << 16); }
__device__ __forceinline__ float bf_hi(unsigned w) { return __builtin_bit_cast(float, w & 0xffff0000u); }
__device__ __forceinline__ float sigmoidf_(float x) { return __builtin_amdgcn_rcpf(1.f + __builtin_amdgcn_exp2f(-1.4426950408889634f * x)); }
__device__ __forceinline__ float siluf_(float x) { return x * sigmoidf_(x); }
__device__ __forceinline__ u32x4 pack8(f32x4 a, f32x4 b) { u32x4 w; w.x = cvt_pk_bf16(a[0], a[1]); w.y = cvt_pk_bf16(a[2], a[3]); w.z = cvt_pk_bf16(b[0], b[1]); w.w = cvt_pk_bf16(b[2], b[3]); return w; }

template <class F> struct EpiP8 {
    static constexpr bool PERM = true, AFTER_DRAIN = false;
    F f; const float* ss;
    __device__ __forceinline__ void operator()(const f32x4 (&acc)[2][2][4][2], const Unit& u, int wr, int wc, int fr, int fq) const {
        const int row0 = u.pm * BM + wr * 64 + fr, col0 = u.pn * BM + wc * 32 + 8 * fq;
        typename F::Pre pre[2][2]; float rsv[2];
#define EP8_LD(s_, i_) do { const int r_ = row0 + ((i_) >> 2) * HALF + ((i_) & 3) * 16; f.load(pre[s_][0], r_, col0); f.load(pre[s_][1], r_, col0 + HALF); rsv[s_] = ss ? ss[r_] : 0.f; } while (0)
        EP8_LD(0, 0);
#pragma unroll
        for (int i = 0; i < 8; ++i) {
            if (i + 1 < 8) EP8_LD((i + 1) & 1, i + 1);
            const int ai = i >> 2, mm = i & 3, row = row0 + ai * HALF + mm * 16;
            const float rs = ss ? __builtin_amdgcn_rsqf(rsv[i & 1] * (1.f / 2048.f) + 1e-6f) : 1.f;
#pragma unroll
            for (int bj = 0; bj < 2; ++bj) f(row, col0 + bj * HALF, u.pn, acc[ai][bj][mm][0] * rs, acc[ai][bj][mm][1] * rs, pre[i & 1][bj]);
        }
#undef EP8_LD
    }
};
struct EpiSwiglu {
    static constexpr bool PERM = true, AFTER_DRAIN = false;
    bf16_t* O; int ldc; const float* ss;
    __device__ __forceinline__ void operator()(const f32x4 (&acc)[2][2][4][2], const Unit& u, int wr, int wc, int fr, int fq) const {
        const int row0 = u.pm * BM + wr * 64 + fr, col0 = u.pn * HALF + wc * 32 + 8 * fq;
#pragma unroll
        for (int ai = 0; ai < 2; ++ai)
#pragma unroll
            for (int m = 0; m < 4; ++m) {
                const int row = row0 + ai * HALF + m * 16;
                const float rs = __builtin_amdgcn_rsqf(ss[row] * (1.f / 2048.f) + 1e-6f);
                f32x4 h0, h1;
#pragma unroll
                for (int j = 0; j < 4; ++j) { h0[j] = siluf_(acc[ai][0][m][0][j] * rs) * (acc[ai][1][m][0][j] * rs); h1[j] = siluf_(acc[ai][0][m][1][j] * rs) * (acc[ai][1][m][1][j] * rs); }
                *(u32x4*)(O + (size_t)row * ldc + col0) = pack8(h0, h1);
            }
    }
};
struct EpiResF32 {
    static constexpr bool PERM = false, AFTER_DRAIN = false;
    const float* base; float* out; int ldc; float coef;
    __device__ __forceinline__ void operator()(const f32x4 (&acc)[2][2][4][2], const Unit& u, int wr, int wc, int fr, int fq) const {
        const int row0 = u.pm * BM + wr * 64 + fr, col0 = u.pn * BM + wc * 32 + 4 * fq;
        f32x4 pre[2][2][2];
#define ERF_LD(s_, i_) do { const size_t off_ = (size_t)(row0 + ((i_) >> 2) * HALF + ((i_) & 3) * 16) * ldc + col0; \
        pre[s_][0][0] = *(const f32x4*)(base + off_); pre[s_][0][1] = *(const f32x4*)(base + off_ + 16); pre[s_][1][0] = *(const f32x4*)(base + off_ + HALF); pre[s_][1][1] = *(const f32x4*)(base + off_ + HALF + 16); } while (0)
        ERF_LD(0, 0);
#pragma unroll
        for (int i = 0; i < 8; ++i) {
            if (i + 1 < 8) ERF_LD((i + 1) & 1, i + 1);
            const int ai = i >> 2, mm = i & 3; const size_t off = (size_t)(row0 + ai * HALF + mm * 16) * ldc + col0;
#pragma unroll
            for (int bj = 0; bj < 2; ++bj)
#pragma unroll
                for (int n = 0; n < 2; ++n) *(f32x4*)(out + off + bj * HALF + n * 16) = pre[i & 1][bj][n] + acc[ai][bj][mm][n] * coef;
        }
#undef ERF_LD
    }
};
struct EpiResNorm {
    static constexpr bool PERM = false, AFTER_DRAIN = false;
    const float* base; float* out; bf16_t* xn; const float* gain; float* ss; int ldc; float coef;
    __device__ __forceinline__ void operator()(const f32x4 (&acc)[2][2][4][2], const Unit& u, int wr, int wc, int fr, int fq) const {
        const int row0 = u.pm * BM + wr * 64 + fr, col0 = u.pn * BM + wc * 32 + 4 * fq;
        f32x4 gg[2][2];
#pragma unroll
        for (int bj = 0; bj < 2; ++bj)
#pragma unroll
            for (int n = 0; n < 2; ++n) gg[bj][n] = *(const f32x4*)(gain + col0 + bj * HALF + n * 16);
        f32x4 pre[2][2][2];
#define ERN_LD(s_, i_) do { const size_t off_ = (size_t)(row0 + ((i_) >> 2) * HALF + ((i_) & 3) * 16) * ldc + col0; \
        pre[s_][0][0] = *(const f32x4*)(base + off_); pre[s_][0][1] = *(const f32x4*)(base + off_ + 16); pre[s_][1][0] = *(const f32x4*)(base + off_ + HALF); pre[s_][1][1] = *(const f32x4*)(base + off_ + HALF + 16); } while (0)
        ERN_LD(0, 0);
#pragma unroll
        for (int i = 0; i < 8; ++i) {
            if (i + 1 < 8) ERN_LD((i + 1) & 1, i + 1);
            const int ai = i >> 2, mm = i & 3, row = row0 + ai * HALF + mm * 16; const size_t off = (size_t)row * ldc + col0; float s = 0.f;
#pragma unroll
            for (int bj = 0; bj < 2; ++bj)
#pragma unroll
                for (int n = 0; n < 2; ++n) { const f32x4 h = pre[i & 1][bj][n] + acc[ai][bj][mm][n] * coef;
                    *(f32x4*)(out + off + bj * HALF + n * 16) = h; s += (h[0] * h[0] + h[1] * h[1]) + (h[2] * h[2] + h[3] * h[3]);
                    const f32x4 y = h * gg[bj][n]; typedef unsigned u32x2 __attribute__((ext_vector_type(2))); u32x2 w; w.x = cvt_pk_bf16(y[0], y[1]); w.y = cvt_pk_bf16(y[2], y[3]);
                    *(u32x2*)(xn + off + bj * HALF + n * 16) = w; }
            s += __shfl_xor(s, 16); s += __shfl_xor(s, 32);
            if (fq == 0) atomicAdd(ss + row, s);
        }
#undef ERN_LD
    }
};
template <bool BASE_BF, bool OUT_BF, bool OUT_F32> struct EpiResBf {
    static constexpr bool PERM = false, AFTER_DRAIN = false;
    const float* basef; const bf16_t* baseb; float* outf; bf16_t* xn; float* ss; int ldc; float coef;
    typedef unsigned u32x2 __attribute__((ext_vector_type(2)));
    __device__ __forceinline__ void operator()(const f32x4 (&acc)[2][2][4][2], const Unit& u, int wr, int wc, int fr, int fq) const {
        const int row0 = u.pm * BM + wr * 64 + fr, col0 = u.pn * BM + wc * 32 + 4 * fq;
        f32x4 pf[2][2][2]; u32x2 pb[2][2][2];
#define ERB_LD(s_, i_) do { const size_t off_ = (size_t)(row0 + ((i_) >> 2) * HALF + ((i_) & 3) * 16) * ldc + col0; \
        _Pragma("unroll") for (int bj_ = 0; bj_ < 2; ++bj_) _Pragma("unroll") for (int n_ = 0; n_ < 2; ++n_) { \
            if (BASE_BF) pb[s_][bj_][n_] = *(const u32x2*)(baseb + off_ + bj_ * HALF + n_ * 16); else pf[s_][bj_][n_] = *(const f32x4*)(basef + off_ + bj_ * HALF + n_ * 16); } } while (0)
        ERB_LD(0, 0);
#pragma unroll
        for (int i = 0; i < 8; ++i) {
            if (i + 1 < 8) ERB_LD((i + 1) & 1, i + 1);
            const int ai = i >> 2, mm = i & 3, row = row0 + ai * HALF + mm * 16; const size_t off = (size_t)row * ldc + col0; float s = 0.f;
#pragma unroll
            for (int bj = 0; bj < 2; ++bj)
#pragma unroll
                for (int n = 0; n < 2; ++n) {
                    f32x4 b;
                    if (BASE_BF) { const u32x2 w = pb[i & 1][bj][n]; b = (f32x4){bf_lo(w.x), bf_hi(w.x), bf_lo(w.y), bf_hi(w.y)}; } else b = pf[i & 1][bj][n];
                    const f32x4 h = b + acc[ai][bj][mm][n] * coef;
                    if (OUT_F32) *(f32x4*)(outf + off + bj * HALF + n * 16) = h;
                    if (OUT_BF) { s += (h[0] * h[0] + h[1] * h[1]) + (h[2] * h[2] + h[3] * h[3]);
                        u32x2 w; w.x = cvt_pk_bf16(h[0], h[1]); w.y = cvt_pk_bf16(h[2], h[3]); *(u32x2*)(xn + off + bj * HALF + n * 16) = w; }
                }
            if (OUT_BF) { s += __shfl_xor(s, 16); s += __shfl_xor(s, 32); if (fq == 0) atomicAdd(ss + row, s); }
        }
#undef ERB_LD
    }
};
template <class Epi, class Sched, bool ALIGN_EPI = false, bool SP2 = false>
__device__ __forceinline__ void gemm_phase(PG8_LAS unsigned char* lds, const Gemm g, const Sched& S, const Epi& E) {
    const int tid = threadIdx.x, wid = __builtin_amdgcn_readfirstlane(tid >> 6), lane = tid & 63, wr = wid >> 2, wc = wid & 3, fr = lane & 15, fq = lane >> 4;
    const int K = g.K, nt = K / BK;
    unsigned voffA[2], voffB[2];
#pragma unroll
    for (int i = 0; i < 2; ++i) { int R, C; stage_rc(tid * 16 + i * 8192, R, C); const int Rb = Epi::PERM ? ((R & ~31) + perm32(R & 31)) : R;
        voffA[i] = (unsigned)(R * g.lda + C) * 2u; voffB[i] = (unsigned)(Rb * g.ldb + C) * 2u; }
    const size_t kstep = (size_t)(BK * 2);
    const size_t hstepA = (size_t)HALF * g.lda * 2, hstepB = (size_t)HALF * g.ldb * 2;
    const size_t tstepA = 2 * hstepA, tstepB = 2 * hstepB;
    const unsigned ldsw = (unsigned)wid * 1024u;
    const int aoff = lds_byte(wr * 64 + fr, fq * 8), boff = lds_byte(wc * 32 + fr, fq * 8);
#define PG8_SA(b, h) (((b) * 2 + (h)) * HTB)
#define PG8_SB(b, h) ((4 + (b) * 2 + (h)) * HTB)
#define PG8_STAGE(bufoff, gbase, voff) do { _Pragma("unroll") for (int _i = 0; _i < 2; ++_i) \
        __builtin_amdgcn_global_load_lds((const unsigned*)((const char*)(gbase) + (voff)[_i]), (PG8_LAS unsigned*)(lds + (bufoff) + ldsw + _i * 8192), 16, 0, 0); } while (0)
#define PG8_LDA(dst, b, h) do { _Pragma("unroll") for (int m = 0; m < 4; ++m) _Pragma("unroll") for (int k = 0; k < 2; ++k) dst[m][k] = *(const PG8_LAS bf16x8*)(lds + PG8_SA(b, h) + aoff + m * 2048 + k * 1024); } while (0)
#define PG8_LDB(dst, b, h) do { _Pragma("unroll") for (int n = 0; n < 2; ++n) _Pragma("unroll") for (int k = 0; k < 2; ++k) dst[n][k] = *(const PG8_LAS bf16x8*)(lds + PG8_SB(b, h) + boff + n * 2048 + k * 1024); } while (0)
#define PG8_MMA(ai, bj, At, Bt) do { __builtin_amdgcn_s_setprio(1); _Pragma("unroll") for (int m = 0; m < 4; ++m) _Pragma("unroll") for (int n = 0; n < 2; ++n) _Pragma("unroll") for (int k = 0; k < 2; ++k) \
        acc[ai][bj][m][n] = __builtin_amdgcn_mfma_f32_16x16x32_bf16(Bt[n][k], At[m][k], acc[ai][bj][m][n], 0, 0, 0); __builtin_amdgcn_s_setprio(0); } while (0)
#define PG8_WAIT_V(n) asm volatile("s_waitcnt vmcnt(" #n ")" ::: "memory")
#define PG8_WAIT_L(n) asm volatile("s_waitcnt lgkmcnt(" #n ")" ::: "memory")
#define PG8_BAR __builtin_amdgcn_s_barrier()
#define PG8_SCHED __builtin_amdgcn_sched_barrier(0)
    Unit cur, nxt; int ui = 0;
    if (!S.next(0, cur)) return;
    f32x4 acc[2][2][4][2];
#pragma unroll
    for (int a = 0; a < 2; ++a)
#pragma unroll
        for (int b = 0; b < 2; ++b)
#pragma unroll
            for (int m = 0; m < 4; ++m)
#pragma unroll
                for (int n = 0; n < 2; ++n) acc[a][b][m][n] = (f32x4){0.f, 0.f, 0.f, 0.f};
    bf16x8 At[4][2], B0[2][2], B1[2][2];
    const char* cA = (const char*)g.A + (size_t)cur.pm * tstepA + (size_t)cur.pn * g.apn; const char* cB = (const char*)g.Bt + (size_t)cur.pn * g.bpn + (size_t)(cur.pm / g.bdiv) * g.bbytes;
    S.a_ready(cur);
    if constexpr (SP2) {
        PG8_STAGE(PG8_SB(0, 0), cB, voffB); PG8_STAGE(PG8_SB(0, 1), cB + hstepB, voffB); PG8_STAGE(PG8_SA(0, 0), cA, voffA); PG8_STAGE(PG8_SA(0, 1), cA + hstepA, voffA);
        if (wr == 1) PG8_BAR;
        PG8_WAIT_V(2); PG8_BAR;
        PG8_STAGE(PG8_SB(1, 0), cB + kstep, voffB); PG8_STAGE(PG8_SA(1, 0), cA + kstep, voffA); PG8_STAGE(PG8_SB(1, 1), cB + hstepB + kstep, voffB);
        PG8_WAIT_V(6); PG8_BAR;
    } else {
        PG8_STAGE(PG8_SB(0, 0), cB, voffB); PG8_STAGE(PG8_SA(0, 0), cA, voffA); PG8_STAGE(PG8_SB(0, 1), cB + hstepB, voffB); PG8_STAGE(PG8_SA(0, 1), cA + hstepA, voffA);
        if (wr == 1) PG8_BAR;
        PG8_WAIT_V(4); PG8_BAR;
        PG8_STAGE(PG8_SB(1, 0), cB + kstep, voffB); PG8_STAGE(PG8_SA(1, 0), cA + kstep, voffA); PG8_STAGE(PG8_SB(1, 1), cB + hstepB + kstep, voffB);
        PG8_WAIT_V(6); PG8_BAR;
    }
    for (;;) {
        const bool has_next = S.next(ui + 1, nxt);
        const char* nA = has_next ? (const char*)g.A + (size_t)nxt.pm * tstepA + (size_t)nxt.pn * g.apn : cA; const char* nB = has_next ? (const char*)g.Bt + (size_t)nxt.pn * g.bpn + (size_t)(nxt.pm / g.bdiv) * g.bbytes : cB;
#pragma nounroll
        for (int t = 0; t < nt; t += 2) {
            const bool last = (t == nt - 2);
            const char* a1 = cA + (size_t)(t + 1) * kstep;
            const char* a2 = last ? nA : cA + (size_t)(t + 2) * kstep; const char* b2 = last ? nB : cB + (size_t)(t + 2) * kstep;
            const char* a3 = a2 + kstep; const char* b3 = b2 + kstep;
            if (last && has_next) S.a_ready(nxt);
            if constexpr (SP2) {
            PG8_LDB(B0, 0, 0); PG8_LDB(B1, 0, 1); PG8_SCHED; PG8_LDA(At, 0, 0); PG8_STAGE(PG8_SA(1, 1), a1 + hstepA, voffA);
            PG8_WAIT_V(8); PG8_WAIT_L(0); PG8_BAR; PG8_MMA(0, 0, At, B0); PG8_MMA(0, 1, At, B1); PG8_BAR; PG8_SCHED;
            PG8_LDA(At, 0, 1); PG8_STAGE(PG8_SB(0, 0), b2, voffB); PG8_STAGE(PG8_SB(0, 1), b2 + hstepB, voffB); PG8_STAGE(PG8_SA(0, 0), a2, voffA);
            PG8_WAIT_V(8); PG8_WAIT_L(0); PG8_BAR; PG8_MMA(1, 0, At, B0); PG8_MMA(1, 1, At, B1); PG8_BAR; PG8_SCHED;
            PG8_LDB(B0, 1, 0); PG8_LDB(B1, 1, 1); PG8_SCHED; PG8_LDA(At, 1, 0); PG8_STAGE(PG8_SA(0, 1), a2 + hstepA, voffA);
            PG8_WAIT_V(8); PG8_WAIT_L(0); PG8_BAR; PG8_MMA(0, 0, At, B0); PG8_MMA(0, 1, At, B1); PG8_BAR; PG8_SCHED;
            PG8_LDA(At, 1, 1); PG8_STAGE(PG8_SB(1, 0), b3, voffB); PG8_STAGE(PG8_SB(1, 1), b3 + hstepB, voffB); PG8_STAGE(PG8_SA(1, 0), a3, voffA);
            PG8_WAIT_V(8); PG8_WAIT_L(0); PG8_BAR; PG8_MMA(1, 0, At, B0); PG8_MMA(1, 1, At, B1); PG8_BAR; PG8_SCHED;
            } else {
            PG8_LDB(B0, 0, 0); PG8_SCHED; PG8_LDA(At, 0, 0); PG8_STAGE(PG8_SA(1, 1), a1 + hstepA, voffA);
            PG8_WAIT_L(8); PG8_BAR; PG8_WAIT_L(0); PG8_MMA(0, 0, At, B0); PG8_BAR; PG8_SCHED;
            PG8_LDB(B1, 0, 1); PG8_STAGE(PG8_SB(0, 0), b2, voffB);
            PG8_BAR; PG8_WAIT_L(0); PG8_MMA(0, 1, At, B1); PG8_BAR;
            PG8_LDA(At, 0, 1); PG8_STAGE(PG8_SA(0, 0), a2, voffA);
            PG8_BAR; PG8_WAIT_L(0); PG8_MMA(1, 0, At, B0); PG8_BAR; PG8_SCHED;
            PG8_STAGE(PG8_SB(0, 1), b2 + hstepB, voffB);
            PG8_WAIT_V(6); PG8_BAR; PG8_MMA(1, 1, At, B1); PG8_BAR;
            PG8_LDB(B0, 1, 0); PG8_SCHED; PG8_LDA(At, 1, 0); PG8_STAGE(PG8_SA(0, 1), a2 + hstepA, voffA);
            PG8_WAIT_L(8); PG8_BAR; PG8_WAIT_L(0); PG8_MMA(0, 0, At, B0); PG8_BAR; PG8_SCHED;
            PG8_LDB(B1, 1, 1); PG8_STAGE(PG8_SB(1, 0), b3, voffB);
            PG8_BAR; PG8_WAIT_L(0); PG8_MMA(0, 1, At, B1); PG8_BAR;
            PG8_LDA(At, 1, 1); PG8_STAGE(PG8_SA(1, 0), a3, voffA);
            PG8_BAR; PG8_WAIT_L(0); PG8_MMA(1, 0, At, B0); PG8_BAR; PG8_SCHED;
            PG8_STAGE(PG8_SB(1, 1), b3 + hstepB, voffB);
            PG8_WAIT_V(6); PG8_BAR; PG8_MMA(1, 1, At, B1); PG8_BAR;
            }
        }
        if constexpr (ALIGN_EPI) { if (wr == 0) PG8_BAR; }
        if constexpr (!Epi::AFTER_DRAIN) { E(acc, cur, wr, wc, fr, fq); S.done(cur); }
        if (!has_next) break;
#pragma unroll
        for (int a = 0; a < 2; ++a)
#pragma unroll
            for (int b = 0; b < 2; ++b)
#pragma unroll
                for (int m = 0; m < 4; ++m)
#pragma unroll
                    for (int n = 0; n < 2; ++n) acc[a][b][m][n] = (f32x4){0.f, 0.f, 0.f, 0.f};
        cur = nxt; cA = nA; cB = nB; ++ui;
        if constexpr (ALIGN_EPI) { if (wr == 1) PG8_BAR; }
    }
    PG8_WAIT_V(0);
    if constexpr (!ALIGN_EPI) { if (wr == 0) PG8_BAR; }
    PG8_BAR;
    if constexpr (Epi::AFTER_DRAIN) { E.fused(acc, cur, wr, wc, fr, fq, lds, wid, lane); S.done(cur); }
#undef PG8_SA
#undef PG8_SB
#undef PG8_STAGE
#undef PG8_LDA
#undef PG8_LDB
#undef PG8_MMA
#undef PG8_WAIT_V
#undef PG8_WAIT_L
#undef PG8_BAR
#undef PG8_SCHED
}
}
namespace nsa {
typedef unsigned short bf16_t;
typedef short bf16x8 __attribute__((ext_vector_type(8)));
typedef short s16x4 __attribute__((ext_vector_type(4)));
typedef float f32x16 __attribute__((ext_vector_type(16)));
typedef float f32x4 __attribute__((ext_vector_type(4)));
typedef unsigned u32x4 __attribute__((ext_vector_type(4)));
constexpr int D = 128, KVBLK = 64, SHM_K = 16384, SHM_V = 16384, SEQ = 8192;
constexpr float SCALE = 0.08838834764831845f, C2 = 1.4426950408889634f * SCALE, THR = 8.f;
constexpr int L_KV = 0  , L_WS = 65536, L_SELM = 67584, L_PARK = 69632  , L_IMP = L_PARK  , L_END = L_PARK + 65536;
#define KSWZ(row, colB) ((row) * 256 + ((colB) ^ (((row) & 7) << 4)))
#define SBAR() __builtin_amdgcn_sched_barrier(0)
__device__ __forceinline__ int v_st(int k, int c) { const int kk = (k & ~0xC) | ((k & 4) << 1) | ((k & 8) >> 1); return ((kk >> 3) * 4 + (c >> 5)) * 512 + ((kk & 7) * 32 + (c & 31)) * 2; }
__device__ __forceinline__ int v_rd_base(int lane) { return ((lane & 3) << 3) | (((lane >> 2) & 3) << 6) | (((lane >> 4) & 1) << 5) | (((lane >> 5) & 1) << 8); }
constexpr int v_rd_off(int d0, int ks, int half) { return d0 * 512 + ks * 4096 + half * 2048; }
__device__ __forceinline__ int crow(int r, int hi) { return (r & 3) + 8 * (r >> 2) + 4 * hi; }
__device__ __forceinline__ unsigned cvtpk(float lo, float hi) { unsigned r; asm volatile("v_cvt_pk_bf16_f32 %0, %1, %2" : "=v"(r) : "v"(lo), "v"(hi)); return r; }
__device__ __forceinline__ void mask_tile(f32x16& p0, f32x16& p1, int dq, unsigned W) {
    const float NEG = -__builtin_inff();
#pragma unroll
    for (int r = 0; r < 16; ++r) {
        const int c = (r & 3) + 8 * (r >> 2);
        if ((unsigned)(dq - c) >= W) p0[r] = NEG;
        if ((unsigned)(dq - c - 32) >= W) p1[r] = NEG;
    }
}
__device__ __forceinline__ float max3f(float a, float b, float c) { float r; asm("v_max3_f32 %0, %1, %2, %3" : "=v"(r) : "v"(a), "v"(b), "v"(c)); return r; }
__device__ __forceinline__ float rowmax32(const f32x16& p0, const f32x16& p1) {
    float pmax = max3f(p0[0], p0[1], p0[2]);
#pragma unroll
    for (int r = 3; r < 15; r += 2) pmax = max3f(pmax, p0[r], p0[r + 1]);
    pmax = max3f(pmax, p0[15], p1[0]);
#pragma unroll
    for (int r = 1; r < 15; r += 2) pmax = max3f(pmax, p1[r], p1[r + 1]);
    pmax = fmaxf(pmax, p1[15]);
    auto rr = __builtin_amdgcn_permlane32_swap(__float_as_uint(pmax), __float_as_uint(pmax), false, false);
    return fmaxf(__uint_as_float(rr[0]), __uint_as_float(rr[1]));
}
__device__ __forceinline__ float rowsum32(const f32x16& p0, const f32x16& p1) {
    float ps = 0.f;
#pragma unroll
    for (int r = 0; r < 16; ++r) ps += p0[r];
#pragma unroll
    for (int r = 0; r < 16; ++r) ps += p1[r];
    auto rr = __builtin_amdgcn_permlane32_swap(__float_as_uint(ps), __float_as_uint(ps), false, false);
    return __uint_as_float(rr[0]) + __uint_as_float(rr[1]);
}
__device__ __forceinline__ void packP(const f32x16& p0, const f32x16& p1, bf16x8& pa0, bf16x8& pa1, bf16x8& pa2, bf16x8& pa3) {
#define PK4(P, B_, OUT) do { unsigned a0 = cvtpk(P[B_+0], P[B_+1]), a1 = cvtpk(P[B_+2], P[B_+3]);                          \
        unsigned b0 = cvtpk(P[B_+4], P[B_+5]), b1 = cvtpk(P[B_+6], P[B_+7]);                                             \
        auto r0 = __builtin_amdgcn_permlane32_swap(a0, b0, false, false); auto r1 = __builtin_amdgcn_permlane32_swap(a1, b1, false, false); \
        u32x4 w = {r0[0], r1[0], r0[1], r1[1]}; OUT = *reinterpret_cast<bf16x8*>(&w); } while (0)
    PK4(p0, 0, pa0); PK4(p0, 8, pa1); PK4(p1, 0, pa2); PK4(p1, 8, pa3);
#undef PK4
}
__device__ __forceinline__ void qkt(f32x16& p0, f32x16& p1, const char* K_lds, int r32, int hi, const bf16x8* qr) {
    p0 = f32x16{}; p1 = f32x16{};
    const char* kb[4];
#pragma unroll
    for (int dd = 0; dd < 4; ++dd) kb[dd] = K_lds + KSWZ(r32, (dd * 16 + hi * 8) * 2);
    bf16x8 fa[2], fb[2], fc[2];
#define QK_LD(F, d0) do { const char* a0_ = kb[(d0) & 3] + ((d0) >> 2) * 128; F[0] = *reinterpret_cast<const bf16x8*>(a0_); F[1] = *reinterpret_cast<const bf16x8*>(a0_ + 32 * 256); } while (0)
#define QK_MM(F, d0) do { p0 = __builtin_amdgcn_mfma_f32_32x32x16_bf16(F[0], qr[d0], p0, 0, 0, 0); p1 = __builtin_amdgcn_mfma_f32_32x32x16_bf16(F[1], qr[d0], p1, 0, 0, 0); } while (0)
#define QK_W(n) do { SBAR(); asm volatile("s_waitcnt lgkmcnt(" #n ")" ::: "memory"); SBAR(); } while (0)
    QK_LD(fa, 0); SBAR(); QK_LD(fb, 1); SBAR(); QK_LD(fc, 2);
    QK_W(4); QK_MM(fa, 0); SBAR(); QK_LD(fa, 3);
    QK_W(4); QK_MM(fb, 1); SBAR(); QK_LD(fb, 4);
    QK_W(4); QK_MM(fc, 2); SBAR(); QK_LD(fc, 5);
    QK_W(4); QK_MM(fa, 3); SBAR(); QK_LD(fa, 6);
    QK_W(4); QK_MM(fb, 4); SBAR(); QK_LD(fb, 7);
    QK_W(4); QK_MM(fc, 5);
    QK_W(2); QK_MM(fa, 6);
    QK_W(0); QK_MM(fb, 7);
#undef QK_LD
#undef QK_MM
#undef QK_W
}
__device__ __forceinline__ void pv_tile(f32x16* o, int vb0, bf16x8 pa0, bf16x8 pa1, bf16x8 pa2, bf16x8 pa3) {
#define TRRD(dst, off) asm volatile("ds_read_b64_tr_b16 %0, %1 offset:%2" : "=&v"(dst) : "v"(vb0), "i"(off) : "memory")
#define PV_RD(S_, d0) do { constexpr int b_ = v_rd_off(d0, 0, 0); TRRD(S_##0, b_); TRRD(S_##4, b_ + 2048); TRRD(S_##1, b_ + 4096); TRRD(S_##5, b_ + 6144); TRRD(S_##2, b_ + 8192); TRRD(S_##6, b_ + 10240); TRRD(S_##3, b_ + 12288); TRRD(S_##7, b_ + 14336); } while (0)
#define PV_MM(S_, d0) do { \
        o[d0] = __builtin_amdgcn_mfma_f32_32x32x16_bf16(pa0, (bf16x8){S_##0[0], S_##0[1], S_##0[2], S_##0[3], S_##4[0], S_##4[1], S_##4[2], S_##4[3]}, o[d0], 0, 0, 0);   \
        o[d0] = __builtin_amdgcn_mfma_f32_32x32x16_bf16(pa1, (bf16x8){S_##1[0], S_##1[1], S_##1[2], S_##1[3], S_##5[0], S_##5[1], S_##5[2], S_##5[3]}, o[d0], 0, 0, 0);   \
        o[d0] = __builtin_amdgcn_mfma_f32_32x32x16_bf16(pa2, (bf16x8){S_##2[0], S_##2[1], S_##2[2], S_##2[3], S_##6[0], S_##6[1], S_##6[2], S_##6[3]}, o[d0], 0, 0, 0);   \
        o[d0] = __builtin_amdgcn_mfma_f32_32x32x16_bf16(pa3, (bf16x8){S_##3[0], S_##3[1], S_##3[2], S_##3[3], S_##7[0], S_##7[1], S_##7[2], S_##7[3]}, o[d0], 0, 0, 0); } while (0)
    s16x4 a0, a1, a2, a3, a4, a5, a6, a7, b0, b1, b2, b3, b4, b5, b6, b7;
    PV_RD(a, 0); PV_RD(b, 1);
    asm volatile("s_waitcnt lgkmcnt(8)" ::: "memory"); SBAR(); PV_MM(a, 0); SBAR();
    PV_RD(a, 2);
    asm volatile("s_waitcnt lgkmcnt(8)" ::: "memory"); SBAR(); PV_MM(b, 1); SBAR();
    PV_RD(b, 3);
    asm volatile("s_waitcnt lgkmcnt(8)" ::: "memory"); SBAR(); PV_MM(a, 2); SBAR();
    asm volatile("s_waitcnt lgkmcnt(0)" ::: "memory"); SBAR(); PV_MM(b, 3);
#undef PV_MM
#undef PV_RD
#undef TRRD
}

#ifndef MK_SEC
#define MK_SEC 0
#endif
#define SEC_T(k) do { if (MK_SEC && MODE == 2 && KIND == 2 && blockIdx.x == 0 && threadIdx.x == 0) { const unsigned t_ = (unsigned)__builtin_amdgcn_s_memrealtime(); if (MK_SEC == (k)) { volatile __attribute__((address_space(3))) unsigned* ap_ = (volatile __attribute__((address_space(3))) unsigned*)152592; *ap_ = *ap_ + (t_ - tsec); } tsec = t_; } } while (0)
template <int MODE, int KIND>
__device__ __forceinline__ void attend(const bf16_t* __restrict__ Kg, const bf16_t* __restrict__ Vg, int j_lo, int j_hi, int pos, unsigned W,
                                       char* lds, const bf16x8* qr, float& m_reg, float& l_reg, f32x16* o, float f_imp, float f_o, int qb) {
    constexpr bool NEEDV = MODE != 0;
    const int tid = threadIdx.x, wid = __builtin_amdgcn_readfirstlane(tid >> 6), lane = tid & 63, r32 = lane & 31, hi = lane >> 5;
    float* al_l = (float*)(lds + L_WS) + wid * 64 + 32;
    const int vbase = (int)(uintptr_t)(lds + L_KV + 16384) + v_rd_base(lane);
    const int qloc = wid * 8 + (r32 >> 2);
    int gk[2], gv[2];
#pragma unroll
    for (int i = 0; i < 2; ++i) { const int X = (wid + 8 * i) * 1024 + lane * 16;
        { const int row = X >> 8, colB = (X & 255) ^ ((row & 7) << 4); gk[i] = row * D + (colB >> 1); }
        { const int sub = X >> 9, within = X & 511, kk = (sub >> 2) * 8 + (within >> 6), k = (kk & ~0xC) | ((kk & 4) << 1) | ((kk & 8) >> 1), cc = (sub & 3) * 32 + ((within & 63) >> 1); gv[i] = k * D + cc; } }
    typedef __attribute__((address_space(3))) unsigned las_u32;
    las_u32* ldsw = (las_u32*)(lds + L_KV + wid * 1024);
#define NSA_DMA(j, b) do { const bf16_t* kt_ = Kg + (size_t)(j) * KVBLK * D; \
        __builtin_amdgcn_global_load_lds((const unsigned*)(kt_ + gk[0]), ldsw + (b) * 8192, 16, 0, 0); __builtin_amdgcn_global_load_lds((const unsigned*)(kt_ + gk[1]), ldsw + (b) * 8192 + 2048, 16, 0, 0); \
        if (NEEDV) { const bf16_t* vt_ = Vg + (size_t)(j) * KVBLK * D; \
            __builtin_amdgcn_global_load_lds((const unsigned*)(vt_ + gv[0]), ldsw + (b) * 8192 + 4096, 16, 0, 0); __builtin_amdgcn_global_load_lds((const unsigned*)(vt_ + gv[1]), ldsw + (b) * 8192 + 4096 + 2048, 16, 0, 0); } } while (0)
    if (j_lo >= j_hi) return;
    NSA_DMA(j_lo, 0);
    __syncthreads();
    unsigned tsec = 0; SEC_T(0);
    for (int j = j_lo; j < j_hi; ++j) {
        const int cur = (j - j_lo) & 1;
        if (j + 1 < j_hi) NSA_DMA(j + 1, cur ^ 1);
        const char* K_lds = lds + L_KV + cur * 32768;
        const int kb = j * KVBLK;
        bool rowsel = true, act = true;
        if (KIND == 2) { const unsigned wsel = ((const unsigned*)(lds + L_SELM))[qloc * 4 + (j >> 5)]; rowsel = ((wsel >> (j & 31)) & 1u) != 0u; act = __any(rowsel); }
        if (act) {
            f32x16 p0, p1;
            SEC_T(5);
            qkt(p0, p1, K_lds, r32, hi, qr);
            SEC_T(1);
            if (KIND == 2) {
                if (j == qb) mask_tile(p0, p1, pos - kb - 4 * hi, W);
            } else if (KIND == 0) { if (j == qb || j + 8 == qb) mask_tile(p0, p1, pos - kb - 4 * hi, W); }
            else { if (kb + 63 > 4 * qb - 2) mask_tile(p0, p1, pos - kb - 4 * hi, W); }
            if (MODE == 0) {
                const float pmax = rowmax32(p0, p1), mn = fmaxf(m_reg, pmax), alpha = __builtin_amdgcn_exp2f((m_reg - mn) * C2), mnL = -mn * C2;
#pragma unroll
                for (int r = 0; r < 16; ++r) { p0[r] = __builtin_amdgcn_exp2f(fmaf(p0[r], C2, mnL)); p1[r] = __builtin_amdgcn_exp2f(fmaf(p1[r], C2, mnL)); }
                l_reg = l_reg * alpha + rowsum32(p0, p1); m_reg = mn;
            } else {
                if (MODE == 1) {
                    const float mnL = -m_reg * C2;
#pragma unroll
                    for (int r = 0; r < 16; ++r) { p0[r] = __builtin_amdgcn_exp2f(fmaf(p0[r], C2, mnL)); p1[r] = __builtin_amdgcn_exp2f(fmaf(p1[r], C2, mnL)); }
                    float* imp = (float*)(lds + L_IMP) + qloc * 128 + (kb >> 2);
#pragma unroll
                    for (int half = 0; half < 2; ++half)
#pragma unroll
                        for (int i = 0; i < 4; ++i) {
                            const f32x16& P = half ? p1 : p0;
                            float G = ((P[4 * i] + P[4 * i + 1]) + (P[4 * i + 2] + P[4 * i + 3])) * f_imp, L = P[4 * i + 3] * f_imp;
                            G += __shfl_xor(G, 1); G += __shfl_xor(G, 2); L += __shfl_xor(L, 1); L += __shfl_xor(L, 2);
                            const int jl = half * 8 + 2 * i + hi;
                            if ((r32 & 3) == 0) { atomicAdd(imp + jl, G); if ((kb >> 2) + jl + 1 < 128) atomicAdd(imp + jl + 1, L); }
                        }
#pragma unroll
                    for (int r = 0; r < 16; ++r) { p0[r] *= f_o; p1[r] *= f_o; }
                } else {
                    float pmax = rowmax32(p0, p1); if (KIND == 2 && !rowsel) pmax = -__builtin_inff();
                    float mn, alpha;
                    if (__all((pmax - m_reg) * SCALE <= THR)) { mn = m_reg; alpha = 1.f; }
                    else { mn = fmaxf(m_reg, pmax); alpha = __builtin_amdgcn_exp2f((m_reg - mn) * C2); m_reg = mn; }
                    const float mnL = (KIND == 2 && !rowsel) ? -__builtin_inff() : -mn * C2;
#pragma unroll
                    for (int r = 0; r < 16; ++r) { p0[r] = __builtin_amdgcn_exp2f(fmaf(p0[r], C2, mnL)); p1[r] = __builtin_amdgcn_exp2f(fmaf(p1[r], C2, mnL)); }
                    l_reg = l_reg * alpha + rowsum32(p0, p1);
                    if (__any(alpha < 1.f)) { asm volatile("s_waitcnt lgkmcnt(0)" ::: "memory"); if (hi == 0) al_l[r32] = alpha; asm volatile("s_waitcnt lgkmcnt(0)" ::: "memory");
#pragma unroll
                        for (int r = 0; r < 16; ++r) { const float a = al_l[crow(r, hi)];
#pragma unroll
                            for (int d_ = 0; d_ < 4; ++d_) o[d_][r] *= a; }
                        asm volatile("s_waitcnt lgkmcnt(0)" ::: "memory"); }
                }
                bf16x8 pa0, pa1, pa2, pa3;
                packP(p0, p1, pa0, pa1, pa2, pa3);
                SEC_T(2);
                pv_tile(o, vbase + cur * 32768, pa0, pa1, pa2, pa3);
                SEC_T(3);
            }
        }
        SEC_T(6);
        __syncthreads();
        SEC_T(4);
    }
#undef NSA_DMA
}
template <int STEP>
__device__ __forceinline__ void fold(const f32x16* o, float f, char* lds, int wid, int r32, int hi, bf16_t* orow0  , bool do_store) {
    float* li_l = (float*)(lds + L_WS) + wid * 64;
    unsigned* park = (unsigned*)(lds + L_PARK + wid * 8192);
    asm volatile("s_waitcnt lgkmcnt(0)" ::: "memory");
    if (hi == 0) li_l[r32] = f;
    asm volatile("s_waitcnt lgkmcnt(0)" ::: "memory");
#pragma unroll
    for (int r = 0; r < 16; ++r) { const int wrow = crow(r, hi); const float a = li_l[wrow];
#pragma unroll
        for (int d0 = 0; d0 < 4; ++d0) { float v = o[d0][r] * a, vn = __shfl_xor(v, 1);
            if ((r32 & 1) == 0) { const int idx = wrow * 64 + d0 * 16 + (r32 >> 1);
                if (STEP > 0) { const unsigned u = park[idx]; v += __builtin_bit_cast(float, u << 16); vn += __builtin_bit_cast(float, u & 0xffff0000u); }
                if (STEP < 2) park[idx] = cvtpk(v, vn);
                else if (do_store) *(unsigned*)(orow0 + (size_t)(wid * 8 + (wrow >> 2)) * 2048 + (wrow & 3) * 128 + d0 * 32 + r32) = cvtpk(v, vn); } } }
    asm volatile("s_waitcnt lgkmcnt(0)" ::: "memory");
}

__device__ __forceinline__ float bf2f(bf16_t v) { return __builtin_bit_cast(float, (unsigned)v << 16); }
__device__ __forceinline__ float sigm(float x) { return __builtin_amdgcn_rcpf(1.f + __builtin_amdgcn_exp2f(-1.4426950408889634f * x)); }

__device__ __forceinline__ void nsa_unit(int b, int g, int qb, const bf16_t* Q, const bf16_t* KV4, const bf16_t* KCMP, const bf16_t* VCMP, const bf16_t* NSAG, bf16_t* OUT, char* lds, bool do_store) {
    const int tid = threadIdx.x, wid = __builtin_amdgcn_readfirstlane(tid >> 6), lane = tid & 63, r32 = lane & 31, hi = lane >> 5;
    const int ql = wid * 8 + (r32 >> 2), h = r32 & 3, t = qb * 64 + ql;
    const size_t row = (size_t)b * SEQ + t;
    bf16x8 qr[8];
    { const bf16_t* qp = Q + row * 2048 + g * 512 + h * 128 + hi * 8;
#pragma unroll
      for (int d0 = 0; d0 < 8; ++d0) qr[d0] = *(const bf16x8*)(qp + d0 * 16); }
    { f32x4* z = (f32x4*)((float*)(lds + L_IMP) + wid * 8 * 128) + lane;
#pragma unroll
      for (int i = 0; i < 4; ++i) z[64 * i] = (f32x4){0.f, 0.f, 0.f, 0.f}; }
    const float gc = sigm(bf2f(NSAG[row * 64 + 0 * 16 + g * 4 + h])), gs = sigm(bf2f(NSAG[row * 64 + 1 * 16 + g * 4 + h])), gw = sigm(bf2f(NSAG[row * 64 + 2 * 16 + g * 4 + h]));
    const int bg = b * 4 + g;
    const size_t TSTR = (size_t)8 * SEQ * D;
    f32x16 o[4];
#pragma unroll
    for (int d_ = 0; d_ < 4; ++d_) o[d_] = f32x16{};
    {
        const bf16_t* kc = KCMP + (size_t)bg * 512 * D; const bf16_t* vc = VCMP + (size_t)bg * 512 * D;
        const int nmax = (t - 31) >> 4, jh = (4 * qb + 3 + 63) >> 6;
        float m1 = -1e30f, l1 = 0.f;
        attend<0, 1>(kc, vc, 0, jh, nmax, 0x7fffffffu, lds, qr, m1, l1, o, 0.f, 0.f, qb);
        const float inv_l = l1 > 0.f ? 1.f / l1 : 0.f;
        attend<1, 1>(kc, vc, 0, jh, nmax, 0x7fffffffu, lds, qr, m1, l1, o, inv_l, gc * inv_l, qb);
    }
    {
        asm volatile("s_waitcnt lgkmcnt(0)" ::: "memory");
        unsigned* SELM = (unsigned*)(lds + L_SELM);
        const unsigned* IMPu = (const unsigned*)(lds + L_IMP);
        if (qb >= 16) {
            for (int i = 0; i < 8; ++i) {
                const int q = wid * 8 + i;
                const unsigned vlo = IMPu[q * 128 + lane], vhi = IMPu[q * 128 + 64 + lane];
                const bool clo = (lane >= 1) && (lane <= qb - 2), chi = (64 + lane <= qb - 2);
                unsigned T = 0u;
                for (int bit = 30; bit >= 0; --bit) { const unsigned c = T | (1u << bit);
                    const int cnt = __popcll(__ballot(clo && vlo >= c)) + __popcll(__ballot(chi && vhi >= c));
                    if (cnt >= 13) T = c; }
                unsigned long long sel_lo = __ballot(clo && vlo > T), sel_hi = __ballot(chi && vhi > T);
                unsigned long long eq_lo = __ballot(clo && vlo == T), eq_hi = __ballot(chi && vhi == T);
                int need = 13 - __popcll(sel_lo) - __popcll(sel_hi);
                for (; need > 0; --need) {
                    if (eq_lo) { const unsigned long long lb = eq_lo & (0ull - eq_lo); sel_lo |= lb; eq_lo ^= lb; }
                    else if (eq_hi) { const unsigned long long lb = eq_hi & (0ull - eq_hi); sel_hi |= lb; eq_hi ^= lb; }
                }
                sel_lo |= 1ull;
                if (qb - 1 < 64) sel_lo |= 1ull << (qb - 1); else sel_hi |= 1ull << (qb - 1 - 64);
                if (qb < 64) sel_lo |= 1ull << qb; else sel_hi |= 1ull << (qb - 64);
                if (lane == 0) { SELM[q * 4 + 0] = (unsigned)sel_lo; SELM[q * 4 + 1] = (unsigned)(sel_lo >> 32); SELM[q * 4 + 2] = (unsigned)sel_hi; SELM[q * 4 + 3] = (unsigned)(sel_hi >> 32); }
            }
        } else {
            if (lane < 8) { const int q = wid * 8 + lane; SELM[q * 4 + 0] = (2u << qb) - 1u; SELM[q * 4 + 1] = 0u; SELM[q * 4 + 2] = 0u; SELM[q * 4 + 3] = 0u; }
        }
        asm volatile("s_waitcnt lgkmcnt(0)" ::: "memory");
    }
    __syncthreads();
    fold<0>(o, 1.f, lds, wid, r32, hi, nullptr, false);
    {
        const bf16_t* ks = KV4 + 0 * TSTR + (size_t)bg * SEQ * D; const bf16_t* vs = KV4 + 1 * TSTR + (size_t)bg * SEQ * D;
#pragma unroll
        for (int d_ = 0; d_ < 4; ++d_) o[d_] = f32x16{};
        float m = -1e30f, l = 0.f;
        attend<2, 2>(ks, vs, 0, qb + 1, t, 0x7fffffffu, lds, qr, m, l, o, 0.f, 0.f, qb);
        fold<1>(o, l > 0.f ? gs / l : 0.f, lds, wid, r32, hi, nullptr, false);
    }
    {
        const bf16_t* kw = KV4 + 2 * TSTR + (size_t)bg * SEQ * D; const bf16_t* vw = KV4 + 3 * TSTR + (size_t)bg * SEQ * D;
#pragma unroll
        for (int d_ = 0; d_ < 4; ++d_) o[d_] = f32x16{};
        float m = -1e30f, l = 0.f;
        attend<2, 0>(kw, vw, qb >= 8 ? qb - 8 : 0, qb + 1, t, 512u, lds, qr, m, l, o, 0.f, 0.f, qb);
        fold<2>(o, l > 0.f ? gw / l : 0.f, lds, wid, r32, hi, OUT + ((size_t)b * SEQ + qb * 64) * 2048 + g * 512, do_store);
    }
    __syncthreads();
}
#undef KSWZ
#undef SBAR
}
constexpr int NWAVES = 8;
constexpr int SEQ = 8192, M = 2 * SEQ, DM = 2048, FF = 5632, INW_SRC = 10288, INW = 10496, PW = 1024;
constexpr float RMS_EPS = 1e-6f;
constexpr size_t MiB = 1u << 20;
constexpr size_t WS_WIN = 0, WS_WPU = 42 * MiB, WS_WNU = 46 * MiB, WS_WOUT = 54 * MiB, WS_POOLW = 62 * MiB, WS_CW1 = 63 * MiB, WS_CW2 = 67 * MiB;
constexpr size_t WS_PEBP = 68 * MiB, WS_PEB = 68 * MiB + 512 * 1024, WS_SS = 68 * MiB + 768 * 1024  , WS_HIDC = 69 * MiB, WS_KVCMP = 73 * MiB;
constexpr size_t WS_CTL = 75 * MiB, CTL_BYTES = 16384;
constexpr size_t WS_WGU = 76 * MiB, WS_WD = 120 * MiB, WS_GNSA = 76 * MiB;
constexpr size_t WS_XN = 142 * MiB;
constexpr size_t WS_HID = 206 * MiB, WS_XP = 206 * MiB, WS_Q = 238 * MiB, WS_NSAG = 302 * MiB  , WS_KV4 = 304 * MiB, WS_HIDCP = 368 * MiB;
constexpr size_t WS_APOOL = 206 * MiB  ;
constexpr size_t WS_GPOOL = 384 * MiB, WS_KCVC = 448 * MiB, WS_POOLED = 481 * MiB, WS_END = 513 * MiB;
static_assert(WS_WIN + (size_t)INW * DM * 2 <= WS_WPU && WS_WGU + (size_t)2 * FF * DM * 2 <= WS_WD && WS_WD + (size_t)DM * FF * 2 <= WS_XN && WS_GNSA + (size_t)M * DM * 2 <= WS_XN, "ws map 1");
static_assert(WS_HID + (size_t)M * FF * 2 <= WS_GPOOL && WS_KV4 + (size_t)4 * M * 512 * 2 <= WS_HIDCP && WS_HIDCP + (size_t)2 * 8192 * 256 * 4 <= WS_GPOOL && WS_NSAG + (size_t)M * 64 * 2 <= WS_KV4 && WS_KCVC + (size_t)2 * M * 512 * 2 + 8192 <= WS_POOLED && WS_POOLED + (size_t)M * PW * 2 <= WS_END, "ws map 2");
constexpr int LDS_BYTES = 153600;
#define GAS __attribute__((address_space(1)))
#define LAS __attribute__((address_space(3)))
typedef unsigned short bf16;
typedef unsigned v4u __attribute__((ext_vector_type(4)));
typedef float f32x4 __attribute__((ext_vector_type(4)));
#define LDS_WAIT() asm volatile("s_waitcnt lgkmcnt(0)" ::: "memory")
__device__ __forceinline__ unsigned f2bf(float f) { unsigned u = __builtin_bit_cast(unsigned, f); return (u + 0x7fffu + ((u >> 16) & 1u)) >> 16; }
__device__ __forceinline__ unsigned pk2(float lo, float hi) { return f2bf(lo) | (f2bf(hi) << 16); }
__device__ __forceinline__ float wave_sum(float v) {
#pragma unroll
    for (int o = 1; o < 64; o <<= 1) v += __shfl_xor(v, o);
    return v;
}
struct TItem { int c0, nv, drow, k0; };
__device__ __forceinline__ void titem_load(float (&v)[32], const float* W, int N, const TItem& t, int lane, const float* kg) {
    const bool cv = 4 * (lane & 7) < t.nv; const float* p = W + (size_t)(t.k0 + (lane >> 3)) * N + t.c0 + 4 * (lane & 7);
#pragma unroll
    for (int i = 0; i < 8; ++i) { f32x4 q = cv ? *(const f32x4*)(p + (size_t)(8 * i) * N) : (f32x4){0.f, 0.f, 0.f, 0.f};
        if (kg) q = q * kg[t.k0 + 8 * i + (lane >> 3)];
        v[4 * i] = q.x; v[4 * i + 1] = q.y; v[4 * i + 2] = q.z; v[4 * i + 3] = q.w; }
}
__device__ __forceinline__ void titem_store(const float (&v)[32], int K, bf16* WT, const TItem& t, LAS float* scr, int lane) {
#pragma unroll
    for (int i = 0; i < 8; ++i)
#pragma unroll
        for (int e = 0; e < 4; ++e) scr[(8 * i + (lane >> 3)) * 33 + 4 * (lane & 7) + e] = v[4 * i + e];
    LDS_WAIT(); asm volatile("" ::: "memory");
    const int c = lane & 7;
#pragma unroll
    for (int j = 0; j < 4; ++j) { const int n = (lane >> 3) + 8 * j; const LAS float* s = scr + (8 * c) * 33 + n;
        v4u o; o.x = pk2(s[0 * 33], s[1 * 33]); o.y = pk2(s[2 * 33], s[3 * 33]); o.z = pk2(s[4 * 33], s[5 * 33]); o.w = pk2(s[6 * 33], s[7 * 33]);
        if (n < t.nv) *(v4u*)(WT + (size_t)(t.drow + n) * K + t.k0 + 8 * c) = o; }
    LDS_WAIT(); asm volatile("" ::: "memory");
}
__device__ __forceinline__ void transpose_seg(const float* W, int K, int N, int src0, int ncols, bf16* WT, int drow0, bool gu, LAS float* scr, int lane, int gw, int NGW, int& base, const float* kg = nullptr) {
    const int nblk = (ncols + 31) >> 5, nitems = (K >> 6) * nblk;
    int first = (gw - base) % NGW; if (first < 0) first += NGW;
    base = (base + nitems) % NGW;
#define TI_DECODE(t, it_) do { const int kb_ = (it_) / nblk, nb_ = (it_) - kb_ * nblk, c0_ = nb_ * 32; (t).nv = (ncols - c0_) < 32 ? (ncols - c0_) : 32; \
        (t).drow = gu ? (256 * (c0_ >> 7) + (c0_ & 127) + drow0) : (drow0 + c0_); (t).c0 = src0 + c0_; (t).k0 = kb_ * 64; } while (0)
    int it = first; if (it >= nitems) return;
    TItem tc, tn; float v[32], vn[32];
    TI_DECODE(tc, it); titem_load(v, W, N, tc, lane, kg);
    for (;;) {
        const int itn = it + NGW; const bool more = itn < nitems;
        if (more) { TI_DECODE(tn, itn); titem_load(vn, W, N, tn, lane, kg); }
        titem_store(v, K, WT, tc, scr, lane);
        if (!more) break;
#pragma unroll
        for (int i = 0; i < 32; ++i) v[i] = vn[i];
        tc = tn; it = itn;
    }
#undef TI_DECODE
}
__device__ __forceinline__ void rms_row_bf16(const float* xrow, const float* g, bf16* orow, int lane) {
    const f32x4* xr = (const f32x4*)xrow + lane; const f32x4* gr = (const f32x4*)g + lane;
    f32x4 v[8]; float s = 0.f;
#pragma unroll
    for (int j = 0; j < 8; ++j) { v[j] = xr[64 * j]; s += (v[j].x * v[j].x + v[j].y * v[j].y) + (v[j].z * v[j].z + v[j].w * v[j].w); }
    const float rs = 1.f / sqrtf(wave_sum(s) * (1.f / DM) + RMS_EPS);
    unsigned long long* o8 = (unsigned long long*)orow + lane;
#pragma unroll
    for (int j = 0; j < 8; ++j) { const f32x4 gg = gr[64 * j];
        o8[64 * j] = (unsigned long long)pk2(v[j].x * rs * gg.x, v[j].y * rs * gg.y) | ((unsigned long long)pk2(v[j].z * rs * gg.z, v[j].w * rs * gg.w) << 32); }
}
__device__ __forceinline__ void xg_row_bf16(const float* xrow, const float* g, bf16* orow, float* ssp, int lane) {
    const f32x4* xr = (const f32x4*)xrow + lane; const f32x4* gr = (const f32x4*)g + lane;
    f32x4 v[8]; float s = 0.f;
#pragma unroll
    for (int j = 0; j < 8; ++j) { v[j] = xr[64 * j]; s += (v[j].x * v[j].x + v[j].y * v[j].y) + (v[j].z * v[j].z + v[j].w * v[j].w); }
    s = wave_sum(s); if (lane == 0) *ssp = s;
    unsigned long long* o8 = (unsigned long long*)orow + lane;
#pragma unroll
    for (int j = 0; j < 8; ++j) { const f32x4 gg = g ? gr[64 * j] : (f32x4){1.f, 1.f, 1.f, 1.f};
        o8[64 * j] = g ? ((unsigned long long)pk2(v[j].x * gg.x, v[j].y * gg.y) | ((unsigned long long)pk2(v[j].z * gg.z, v[j].w * gg.w) << 32)) : ((unsigned long long)pk2(v[j].x, v[j].y) | ((unsigned long long)pk2(v[j].z, v[j].w) << 32)); }
}
__device__ __forceinline__ void rms_row_f32(float* xrow, const float* g, int lane) {
    f32x4* xr = (f32x4*)xrow + lane; const f32x4* gr = (const f32x4*)g + lane;
    f32x4 v[8]; float s = 0.f;
#pragma unroll
    for (int j = 0; j < 8; ++j) { v[j] = xr[64 * j]; s += (v[j].x * v[j].x + v[j].y * v[j].y) + (v[j].z * v[j].z + v[j].w * v[j].w); }
    const float rs = 1.f / sqrtf(wave_sum(s) * (1.f / DM) + RMS_EPS);
#pragma unroll
    for (int j = 0; j < 8; ++j) { const f32x4 gg = gr[64 * j]; xr[64 * j] = (f32x4){v[j].x * rs * gg.x, v[j].y * rs * gg.y, v[j].z * rs * gg.z, v[j].w * rs * gg.w}; }
}
template <int WIN> __device__ __forceinline__ void pool_rows(const bf16* XP, bf16* POOLED, int rp, int gi, int lane) {
    const int row = 2 * rp + (lane >> 5), c8 = gi * 256 + (lane & 31) * 8, t = row & (SEQ - 1);
    v4u w[WIN];
#pragma unroll
    for (int j = 0; j < WIN; ++j) { const int rr = (j <= t) ? row - j : row; w[j] = *(const v4u*)(XP + (size_t)rr * PW + c8); }
    float acc[8] = {0.f, 0.f, 0.f, 0.f, 0.f, 0.f, 0.f, 0.f};
#pragma unroll
    for (int j = 0; j < WIN; ++j) { const float k = (j <= t) ? 1.f : 0.f;
        acc[0] += k * pg8::bf_lo(w[j].x); acc[1] += k * pg8::bf_hi(w[j].x); acc[2] += k * pg8::bf_lo(w[j].y); acc[3] += k * pg8::bf_hi(w[j].y);
        acc[4] += k * pg8::bf_lo(w[j].z); acc[5] += k * pg8::bf_hi(w[j].z); acc[6] += k * pg8::bf_lo(w[j].w); acc[7] += k * pg8::bf_hi(w[j].w); }
    const int n = (t + 1) < WIN ? (t + 1) : WIN; const float inv = 1.f / (float)n;
    v4u o; o.x = pk2(acc[0] * inv - pg8::bf_lo(w[0].x), acc[1] * inv - pg8::bf_hi(w[0].x)); o.y = pk2(acc[2] * inv - pg8::bf_lo(w[0].y), acc[3] * inv - pg8::bf_hi(w[0].y));
    o.z = pk2(acc[4] * inv - pg8::bf_lo(w[0].z), acc[5] * inv - pg8::bf_hi(w[0].z)); o.w = pk2(acc[6] * inv - pg8::bf_lo(w[0].w), acc[7] * inv - pg8::bf_hi(w[0].w));
    *(v4u*)(POOLED + (size_t)row * PW + c8) = o;
}
__device__ __forceinline__ void pool_item(const bf16* XP, bf16* POOLED, int rp, int gi, int lane) {
    if (gi == 0) pool_rows<2>(XP, POOLED, rp, gi, lane); else if (gi == 1) pool_rows<4>(XP, POOLED, rp, gi, lane);
    else if (gi == 2) pool_rows<8>(XP, POOLED, rp, gi, lane); else pool_rows<16>(XP, POOLED, rp, gi, lane);
}
using pg8::u32x4;
struct FWin {
    struct Pre {}; __device__ __forceinline__ void load(Pre&, int, int) const {}
    bf16 *XP, *Q, *KCVC, *KV4, *GPOOL, *GNSA;
    __device__ __forceinline__ void operator()(int row, int col, int pn, pg8::f32x4 v0, pg8::f32x4 v1, const Pre& pre) const {
        const u32x4 w = pg8::pack8(v0, v1); bf16* dst;
        if (pn < 4) dst = XP + (size_t)row * 1024 + col;
        else if (pn < 12) dst = Q + (size_t)row * 2048 + (col - 1024);
        else if (pn < 24) { const int c = col - 3072, tensor = c >> 9, g = (c >> 7) & 3, d = c & 127, b = row >> 13, t = row & 8191;
            dst = (tensor < 2 ? KCVC + (size_t)tensor * 8 * SEQ * 128 : KV4 + (size_t)(tensor - 2) * 8 * SEQ * 128) + ((size_t)(b * 4 + g) * SEQ + t) * 128 + d; }
        else if (pn < 32) dst = GPOOL + (size_t)row * 2048 + (col - 6144);
        else dst = GNSA + (size_t)row * 2048 + (col - 8192);
        *(u32x4*)dst = w;
    }
};
struct FSiluBias { bf16* O; const float* bias;
    struct Pre {}; __device__ __forceinline__ void load(Pre&, int, int) const {}
    __device__ __forceinline__ void operator()(int row, int col, int pn, pg8::f32x4 v0, pg8::f32x4 v1, const Pre& pre) const {
        const float* bp = bias + ((row >> 12) << 8) + col; const pg8::f32x4 b0 = *(const pg8::f32x4*)bp, b1 = *(const pg8::f32x4*)(bp + 4);
#pragma unroll
        for (int j = 0; j < 4; ++j) { v0[j] = pg8::siluf_(v0[j] + b0[j]); v1[j] = pg8::siluf_(v1[j] + b1[j]); }
        *(u32x4*)(O + (size_t)row * 256 + col) = pg8::pack8(v0, v1);
    }
};
struct FGates { bf16* O;
    struct Pre {}; __device__ __forceinline__ void load(Pre&, int, int) const {}
    __device__ __forceinline__ void operator()(int row, int col, int pn, pg8::f32x4 v0, pg8::f32x4 v1, const Pre& pre) const {
        if (col < 64) *(u32x4*)(O + (size_t)row * 64 + col) = pg8::pack8(v0, v1);
    }
};
struct FPartial { float* O;
    struct Pre {}; __device__ __forceinline__ void load(Pre&, int, int) const {}
    __device__ __forceinline__ void operator()(int row, int col, int pn, pg8::f32x4 v0, pg8::f32x4 v1, const Pre& pre) const {
        float* p = O + ((size_t)pn * 8192 + row) * 256 + (col & 255); *(pg8::f32x4*)p = v0; *(pg8::f32x4*)(p + 4) = v1;
    }
};
struct FStore128 { bf16* O;
    struct Pre {}; __device__ __forceinline__ void load(Pre&, int, int) const {}
    __device__ __forceinline__ void operator()(int row, int col, int pn, pg8::f32x4 v0, pg8::f32x4 v1, const Pre& pre) const {
        if (col < 128) *(u32x4*)(O + (size_t)row * 128 + col) = pg8::pack8(v0, v1);
    }
};
struct FPool { bf16* O; const float* scale;
    struct Pre {}; __device__ __forceinline__ void load(Pre&, int, int) const {}
    __device__ __forceinline__ void operator()(int row, int col, int pn, pg8::f32x4 v0, pg8::f32x4 v1, const Pre& pre) const {
        const pg8::f32x4 s0 = *(const pg8::f32x4*)(scale + col), s1 = *(const pg8::f32x4*)(scale + col + 4);
        *(u32x4*)(O + (size_t)row * PW + col) = pg8::pack8(v0 * s0, v1 * s1);
    }
};
struct FGate { bf16* MG; const bf16* Gt; bool add;
    struct Pre { u32x4 g, m; };
    __device__ __forceinline__ void load(Pre& p, int row, int col) const { const size_t off = (size_t)row * DM + col; p.g = *(const u32x4*)(Gt + off); if (add) p.m = *(const u32x4*)(MG + off); }
    __device__ __forceinline__ void operator()(int row, int col, int pn, pg8::f32x4 v0, pg8::f32x4 v1, const Pre& pre) const {
        const size_t off = (size_t)row * DM + col;
        const u32x4 gw = pre.g;
        pg8::f32x4 r0, r1;
        r0[0] = pg8::sigmoidf_(pg8::bf_lo(gw.x)) * v0[0]; r0[1] = pg8::sigmoidf_(pg8::bf_hi(gw.x)) * v0[1]; r0[2] = pg8::sigmoidf_(pg8::bf_lo(gw.y)) * v0[2]; r0[3] = pg8::sigmoidf_(pg8::bf_hi(gw.y)) * v0[3];
        r1[0] = pg8::sigmoidf_(pg8::bf_lo(gw.z)) * v1[0]; r1[1] = pg8::sigmoidf_(pg8::bf_hi(gw.z)) * v1[1]; r1[2] = pg8::sigmoidf_(pg8::bf_lo(gw.w)) * v1[2]; r1[3] = pg8::sigmoidf_(pg8::bf_hi(gw.w)) * v1[3];
        if (add) { const u32x4 mw = pre.m;
            r0[0] += pg8::bf_lo(mw.x); r0[1] += pg8::bf_hi(mw.x); r0[2] += pg8::bf_lo(mw.y); r0[3] += pg8::bf_hi(mw.y);
            r1[0] += pg8::bf_lo(mw.z); r1[1] += pg8::bf_hi(mw.z); r1[2] += pg8::bf_lo(mw.w); r1[3] += pg8::bf_hi(mw.w); }
        *(u32x4*)(MG + off) = pg8::pack8(r0, r1);
    }
};

#define XB_TMO      128
#define XB_XCNT(j)  (256  + 64 * (j))
#define XB_XSUB(j)  (1280 + 64 * (j))
#define XB_XGEN(j)  (2304 + 64 * (j))
#define XB_TOP      3328
#define XB_TOPGEN   3392
#define XCD_BAR_WORDS 3456
#define XB_SPIN_CAP (1u << 18)

__device__ __forceinline__ unsigned xb_ld(unsigned* p)              { return __hip_atomic_load(p, __ATOMIC_RELAXED, __HIP_MEMORY_SCOPE_AGENT); }
__device__ __forceinline__ unsigned xb_add(unsigned* p, unsigned v) { return __hip_atomic_fetch_add(p, v, __ATOMIC_RELAXED, __HIP_MEMORY_SCOPE_AGENT); }
__device__ __forceinline__ unsigned xb_xcc_id() { return (unsigned)__builtin_amdgcn_s_getreg((3 << 11) | 20) & 0xFu; }
#define XB_SPIN(cond, bar) do { unsigned _sp = 0; while (cond) { __builtin_amdgcn_s_sleep(1); \
    if ((++_sp & 255u) == 0u) { if (xb_ld(&(bar)[XB_TMO])) break; if (_sp > XB_SPIN_CAP) { atomicAdd(&(bar)[XB_TMO], 1u); break; } } } } while (0)

struct XcdBarrier {
    unsigned* bar; unsigned x;
    volatile LAS unsigned* st;
};

__device__ __forceinline__ XcdBarrier xcd_barrier_post(unsigned* bar, volatile LAS unsigned* st) {
    XcdBarrier b; b.bar = bar; b.x = xb_xcc_id(); b.st = st;
    if (threadIdx.x == 0) (void)xb_add(&bar[XB_XCNT(b.x)], 1u);
    return b;
}
__device__ __forceinline__ void xcd_barrier_complete(unsigned* bar, unsigned x, unsigned& nloc, unsigned& nx) {
    const unsigned G = gridDim.x * gridDim.y * gridDim.z;
    unsigned sum, cnt, mine, sp = 0u;
    for (;;) {
        sum = 0u; cnt = 0u; mine = 0u;
#pragma unroll
        for (unsigned j = 0; j < 16; ++j) { const unsigned c = xb_ld(&bar[XB_XCNT(j)]); sum += c; cnt += (c > 0u) ? 1u : 0u; mine = (j == x) ? c : mine; }
        if (sum == G) break;
        __builtin_amdgcn_s_sleep(1);
        if ((++sp & 255u) == 0u) { if (xb_ld(&bar[XB_TMO])) break; if (sp > XB_SPIN_CAP) { atomicAdd(&bar[XB_TMO], 1u); break; } }
    }
    nloc = mine > 0u ? mine : 1u; nx = cnt > 0u ? cnt : 1u;
}

__device__ __forceinline__ void xcd_barrier(const XcdBarrier& b) {
    asm volatile("s_waitcnt vmcnt(0)" ::: "memory");
    __syncthreads();
    if (threadIdx.x == 0) {
        unsigned* bar = b.bar;
        __builtin_amdgcn_s_waitcnt(0);
        unsigned nloc = b.st[0], nx = b.st[1];
        if (nloc == 0u) { xcd_barrier_complete(bar, b.x, nloc, nx); b.st[0] = nloc; b.st[1] = nx; }
        const unsigned old = xb_add(&bar[XB_XSUB(b.x)], 1u);
        const unsigned gen = old / nloc;
        if (old + 1u == (gen + 1u) * nloc) {
            __builtin_amdgcn_fence(__ATOMIC_RELEASE, "agent");
            asm volatile("s_waitcnt vmcnt(0)" ::: "memory");
            const unsigned og = xb_add(&bar[XB_TOP], 1u);
            const unsigned tg = og / nx;
            if (og + 1u == (tg + 1u) * nx) xb_add(&bar[XB_TOPGEN], 1u);
            else XB_SPIN(xb_ld(&bar[XB_TOPGEN]) == tg, bar);
            __builtin_amdgcn_fence(__ATOMIC_ACQUIRE, "agent");
            xb_add(&bar[XB_XGEN(b.x)], 1u);
            asm volatile("s_waitcnt vmcnt(0)" ::: "memory");
        } else {
            XB_SPIN(xb_ld(&bar[XB_XGEN(b.x)]) == gen, bar);
            __builtin_amdgcn_fence(__ATOMIC_ACQUIRE, "agent");
            asm volatile("s_waitcnt vmcnt(0)" ::: "memory");
        }
    }
    __syncthreads();
}

struct Args { const float* in[23]; float* out; unsigned char* ws; int ph_lo, ph_hi; };
enum { I_X = 0, I_F1N, I_F1G, I_F1U, I_F1D, I_MIXN, I_WIN, I_POOLW, I_POOLS, I_PEK, I_PEV, I_CKW1, I_CKW2, I_CVW1, I_CVW2, I_WPU, I_WNU, I_WOUT, I_F2N, I_F2G, I_F2U, I_F2D, I_FINN };
constexpr int N_PHASES = 12;

template <class Epi> __device__ __forceinline__ void run_gemm(LAS unsigned char* lds, const bf16* A, int lda, const bf16* Bt, int ldb, int Mr, int N, int K, int G, int c, const Epi& E, int apn = 0, int bdiv = 1 << 30, int bbytes = 0, int bpn = -1) {
    pg8::Gemm g{A, Bt, Mr, N, K, lda, ldb, apn, bpn >= 0 ? bpn : 256 * ldb * 2, bdiv, bbytes}; pg8::StaticOrder S; S.init(Mr, N, G, c);
    pg8::gemm_phase<Epi, pg8::StaticOrder, true, true>(lds, g, S, E);
    __syncthreads();
}

__global__ void __launch_bounds__(NWAVES * 64, 2) mk_fwd(Args a) {
    extern __shared__ __attribute__((aligned(16))) unsigned char lds_raw[];
    LAS unsigned char* lds = (LAS unsigned char*)lds_raw;
    const int tid = threadIdx.x, lane = tid & 63, wave = __builtin_amdgcn_readfirstlane(tid >> 6);
    const int G = gridDim.x, bx = blockIdx.x;
    const int vcu = (G % 8 == 0) ? (bx % 8) * (G / 8) + bx / 8 : bx;
    const int gw = vcu * NWAVES + wave, NGW = G * NWAVES;
    unsigned char* ws = a.ws;
    bf16* Win_t = (bf16*)(ws + WS_WIN); bf16* Wpu_t = (bf16*)(ws + WS_WPU); bf16* Wnu_t = (bf16*)(ws + WS_WNU); bf16* Wout_t = (bf16*)(ws + WS_WOUT);
    bf16* Poolw_t = (bf16*)(ws + WS_POOLW); bf16* Cw1_t = (bf16*)(ws + WS_CW1); bf16* Cw2_t = (bf16*)(ws + WS_CW2);
    float* PEBP = (float*)(ws + WS_PEBP); float* PEB = (float*)(ws + WS_PEB); float* SS0 = (float*)(ws + WS_SS); float* SS1 = SS0 + M; float* SS2 = SS1 + M; float* SS3 = SS2 + M;
    bf16* HIDC = (bf16*)(ws + WS_HIDC); bf16* KVCMP = (bf16*)(ws + WS_KVCMP);
    bf16* Wgu_t = (bf16*)(ws + WS_WGU); bf16* Wd_t = (bf16*)(ws + WS_WD); bf16* GNSA = (bf16*)(ws + WS_GNSA);
    bf16* XN = (bf16*)(ws + WS_XN); bf16* POOLED = (bf16*)(ws + WS_POOLED); bf16* APOOL = (bf16*)(ws + WS_APOOL); float* HIDCP = (float*)(ws + WS_HIDCP);
    bf16* HID = (bf16*)(ws + WS_HID); bf16* XP = (bf16*)(ws + WS_XP); bf16* Q = (bf16*)(ws + WS_Q); bf16* KV4 = (bf16*)(ws + WS_KV4); bf16* KCVC = (bf16*)(ws + WS_KCVC); bf16* NSAG = (bf16*)(ws + WS_NSAG);
    bf16* GPOOL = (bf16*)(ws + WS_GPOOL);
    float* H = a.out;
    const int lo = a.ph_lo, hi = a.ph_hi;
    volatile LAS unsigned* xb_st = (volatile LAS unsigned*)(lds + 152608);
    if (tid == 0) { xb_st[0] = 0u; xb_st[1] = 0u; }
    __syncthreads();
    XcdBarrier xbar; xbar.bar = (unsigned*)(ws + WS_CTL); xbar.x = 0; xbar.st = nullptr;
    if (hi - lo > 1) xbar = xcd_barrier_post((unsigned*)(ws + WS_CTL), xb_st);
#ifndef MK_PHASE_MASK
#define MK_PHASE_MASK 0xfff
#endif
#define IN(k) (((MK_PHASE_MASK >> (k)) & 1) && lo <= (k) && (k) < hi)
#ifndef MK_REP_MASK
#define MK_REP_MASK 0
#endif
#define REP(k) ((MK_REP_MASK >> (k)) & 1)
#ifndef MK_PROBE_K
#define MK_PROBE_K -1
#endif
#ifndef MK_PROBE_MULT
#define MK_PROBE_MULT 1
#endif
    volatile LAS unsigned long long* stamps = (volatile LAS unsigned long long*)(lds + 152576);
    if (bx == 0 && tid == 0) *(volatile LAS unsigned*)(lds + 152592) = 0u;
    if (MK_PROBE_K == 0 && bx == 0 && tid == 0) stamps[0] = __builtin_amdgcn_s_memrealtime();
#ifndef MK_XSYNC
#define MK_XSYNC 0
#endif
#define SEAM(k) do { if (IN(k) && IN((k) + 1)) { if (a.ph_lo < 0) { __syncthreads(); cg::this_grid().sync(); }     \
            xcd_barrier(xbar); for (int xs_ = 0; xs_ < ((k) == 1 ? MK_XSYNC : 0); ++xs_) xcd_barrier(xbar); } \
        if (MK_PROBE_K >= 0 && bx == 0 && tid == 0) { if ((k) == MK_PROBE_K - 1) stamps[0] = __builtin_amdgcn_s_memrealtime(); if ((k) == MK_PROBE_K) stamps[1] = __builtin_amdgcn_s_memrealtime(); } } while (0)
    LAS float* scr = (LAS float*)(lds + wave * 16384);

    if (IN(0)) for (int rep = 0; rep <= REP(0); ++rep) {
        int base = 0;
        transpose_seg(a.in[I_F1G], DM, FF, 0, FF, Wgu_t, 0, true, scr, lane, gw, NGW, base, a.in[I_F1N]);
        transpose_seg(a.in[I_F1U], DM, FF, 0, FF, Wgu_t, 128, true, scr, lane, gw, NGW, base, a.in[I_F1N]);
        transpose_seg(a.in[I_F1D], FF, DM, 0, DM, Wd_t, 0, false, scr, lane, gw, NGW, base);
        transpose_seg(a.in[I_WIN], DM, INW_SRC, 0, 6144, Win_t, 0, false, scr, lane, gw, NGW, base, a.in[I_MIXN]);
        transpose_seg(a.in[I_WIN], DM, INW_SRC, 6192, 2048, Win_t, 6144, false, scr, lane, gw, NGW, base, a.in[I_MIXN]);
        transpose_seg(a.in[I_WIN], DM, INW_SRC, 8240, 2048, Win_t, 8192, false, scr, lane, gw, NGW, base, a.in[I_MIXN]);
        transpose_seg(a.in[I_WIN], DM, INW_SRC, 6144, 48, Win_t, 10240, false, scr, lane, gw, NGW, base, a.in[I_MIXN]);
        transpose_seg(a.in[I_WPU], PW, DM, 0, DM, Wpu_t, 0, false, scr, lane, gw, NGW, base);
        transpose_seg(a.in[I_WNU], DM, DM, 0, DM, Wnu_t, 0, false, scr, lane, gw, NGW, base);
        transpose_seg(a.in[I_WOUT], DM, DM, 0, DM, Wout_t, 0, false, scr, lane, gw, NGW, base);
        for (int gi = 0; gi < 4; ++gi) transpose_seg(a.in[I_POOLW] + (size_t)gi * 65536, 256, 256, 0, 256, Poolw_t + (size_t)gi * 65536, 0, false, scr, lane, gw, NGW, base);
        transpose_seg(a.in[I_CKW1], 4096, 256, 0, 256, Cw1_t, 0, false, scr, lane, gw, NGW, base);
        transpose_seg(a.in[I_CVW1], 4096, 256, 0, 256, Cw1_t + (size_t)256 * 4096, 0, false, scr, lane, gw, NGW, base);
        transpose_seg(a.in[I_CKW2], 256, 128, 0, 128, Cw2_t, 0, false, scr, lane, gw, NGW, base);
        transpose_seg(a.in[I_CVW2], 256, 128, 0, 128, Cw2_t + 65536, 0, false, scr, lane, gw, NGW, base);
        for (int m = gw; m < M; m += NGW) xg_row_bf16(a.in[I_X] + (size_t)m * DM, nullptr, XN + (size_t)m * DM, SS0 + m, lane);
        for (int i = vcu * 512 + tid; i < 3 * M; i += G * 512) SS1[i] = 0.f;
        if (wave == NWAVES - 1) for (int task = vcu; task < 256; task += G) {
            const int tensor = task >> 7, chunk = (task >> 2) & 31, col = (task & 3) * 64 + lane;
            const float* pe = a.in[tensor ? I_PEV : I_PEK] + chunk * 128; const float* w1 = a.in[tensor ? I_CVW1 : I_CKW1] + (size_t)chunk * 128 * 256 + col;
            float acc = 0.f;
#pragma unroll 16
            for (int k = 0; k < 128; ++k) acc += pe[k] * w1[(size_t)k * 256];
            PEBP[(tensor * 32 + chunk) * 256 + col] = acc;
        }
    }
    SEAM(0);
    if (IN(1)) for (int rep = 0; rep <= REP(1); ++rep) { pg8::EpiSwiglu E{HID, FF, SS0}; run_gemm(lds, XN, DM, Wgu_t, DM, M, 2 * FF, DM, G, bx, E); }
    SEAM(1);
    if (IN(2)) { pg8::EpiResBf<false, true, false> E{a.in[I_X], nullptr, nullptr, XN, SS1, DM, 0.5f}; run_gemm(lds, HID, FF, Wd_t, FF, M, DM, FF, G, bx, E); }
    SEAM(2);
    if (IN(3)) for (int rep = 0; rep <= REP(3); ++rep) {
        if (bx == G - 1) { float pv[32];
#pragma unroll
            for (int c = 0; c < 32; ++c) pv[c] = PEBP[((tid >> 8) * 32 + c) * 256 + (tid & 255)];
            float s = 0.f;
#pragma unroll
            for (int c = 0; c < 32; ++c) s += pv[c];
            PEB[tid] = s; }
        pg8::EpiP8<FWin> E{FWin{XP, Q, KCVC, KV4, GPOOL, GNSA}, SS1}; run_gemm(lds, XN, DM, Win_t, DM, M, INW - 256, DM, G, bx, E); }
    SEAM(3);
    if (IN(4)) for (int rep = 0; rep <= REP(4); ++rep) {
        { pg8::EpiP8<FPartial> E{FPartial{HIDCP}, nullptr};
          run_gemm(lds, KCVC, 2048, Cw1_t, 4096, 8192, 512, 2048, G, bx, E, 2048 * 2, 16, 256 * 4096 * 2, 2048 * 2); }
        { pg8::EpiP8<FGates> E{FGates{NSAG}, SS1}; run_gemm(lds, XN, DM, Win_t + (size_t)10240 * DM, DM, M, 256, DM, G, (bx + G - 64 % G) % G, E); }
        const bool std = (G == 256);
        {
            constexpr int NIT = (M / 2) * 4, NA = (NIT * 27 / 32) & ~1023;
            if (!std) { for (int item = gw; item < NIT; item += NGW) pool_item(XP, POOLED, item >> 2, item & 3, lane); }
            else if (bx >= 128) { for (int item = (bx - 128) * NWAVES + wave; item < NA; item += 128 * NWAVES) pool_item(XP, POOLED, item >> 2, item & 3, lane); }
            else { for (int item = NA + bx * NWAVES + wave; item < NIT; item += 128 * NWAVES) pool_item(XP, POOLED, item >> 2, item & 3, lane); }
        }
    }
    SEAM(4);
    if (IN(5)) for (int rep = 0; rep <= REP(5); ++rep) {
        { pg8::StaticOrder S; S.init(8192, 256, G, bx); pg8::Unit u;
          if (S.next(0, u)) {
#pragma unroll 8
              for (int i = 0; i < 16; ++i) { const int e8 = i * 512 + tid, r = u.pm * 256 + (e8 >> 5), c8 = (e8 & 31) * 8;
                  const float* p0 = HIDCP + (size_t)r * 256 + c8; const float* p1 = p0 + (size_t)8192 * 256; const float* bp = PEB + ((r >> 12) << 8) + c8;
                  pg8::f32x4 a0 = *(const pg8::f32x4*)p0 + *(const pg8::f32x4*)p1 + *(const pg8::f32x4*)bp, a1 = *(const pg8::f32x4*)(p0 + 4) + *(const pg8::f32x4*)(p1 + 4) + *(const pg8::f32x4*)(bp + 4);
#pragma unroll
                  for (int j = 0; j < 4; ++j) { a0[j] = pg8::siluf_(a0[j]); a1[j] = pg8::siluf_(a1[j]); }
                  *(u32x4*)(HIDC + (size_t)r * 256 + c8) = pg8::pack8(a0, a1); }
              asm volatile("s_waitcnt vmcnt(0)" ::: "memory"); __syncthreads();
          } }
        { pg8::EpiP8<FStore128> E{FStore128{KVCMP}, nullptr}; run_gemm(lds, HIDC, 256, Cw2_t, 256, 8192, 256, 256, G, bx, E, 0, 16, 65536 * 2); }
        { pg8::EpiP8<FPool> E{FPool{APOOL, a.in[I_POOLS]}, nullptr}; run_gemm(lds, POOLED, PW, Poolw_t, 256, M, PW, 256, G, bx, E, 256 * 2); }
    }
    SEAM(5);
    if (IN(6)) {
        { pg8::EpiP8<FGate> E{FGate{GPOOL, GPOOL, false}, nullptr}; run_gemm(lds, APOOL, PW, Wpu_t, PW, M, DM, PW, G, bx, E); }
        for (int rep = REP(6) ? 0 : 1; rep < 2; ++rep)
        for (int it = vcu; it < 1024; it += G) {
            const int c = it & 255, k = it >> 8, bg = c >> 5, i = c & 31;
            const int qb = (k == 0) ? i : (k == 1) ? 63 - i : (k == 2) ? 64 + i : 127 - i;
            nsa::nsa_unit(bg >> 2, bg & 3, qb, Q, KV4, KVCMP, KVCMP + (size_t)4096 * 128, NSAG, Q, (char*)lds_raw, rep == 1 || a.ph_lo != 0);
        }
    }
    SEAM(6);
    if (IN(7)) { pg8::EpiP8<FGate> E{FGate{GPOOL, GNSA, true}, nullptr}; run_gemm(lds, Q, DM, Wnu_t, DM, M, DM, DM, G, bx, E); }
    SEAM(7);
    if (IN(8)) {
        int base = 0;
        transpose_seg(a.in[I_F2G], DM, FF, 0, FF, Wgu_t, 0, true, scr, lane, gw, NGW, base, a.in[I_F2N]);
        transpose_seg(a.in[I_F2U], DM, FF, 0, FF, Wgu_t, 128, true, scr, lane, gw, NGW, base, a.in[I_F2N]);
        transpose_seg(a.in[I_F2D], FF, DM, 0, DM, Wd_t, 0, false, scr, lane, gw, NGW, base);
        __syncthreads();
        pg8::EpiResBf<true, true, false> E{nullptr, XN, nullptr, XN, SS2, DM, 1.0f}; run_gemm(lds, GPOOL, DM, Wout_t, DM, M, DM, DM, G, bx, E);
    }
    SEAM(8);
    if (IN(9)) for (int rep = 0; rep <= REP(9); ++rep) { pg8::EpiSwiglu E{HID, FF, SS2}; run_gemm(lds, XN, DM, Wgu_t, DM, M, 2 * FF, DM, G, bx, E); }
    SEAM(9);
    if (IN(10)) { pg8::EpiResBf<true, true, false> E{nullptr, XN, nullptr, XN, SS3, DM, 0.5f}; run_gemm(lds, HID, FF, Wd_t, FF, M, DM, FF, G, bx, E); }
    SEAM(10);
    if (IN(11)) {
        for (int m = gw; m < M; m += NGW) {
            const float rs = 1.f / sqrtf(SS3[m] * (1.f / DM) + RMS_EPS);
            const v4u* xr = (const v4u*)(XN + (size_t)m * DM) + lane; const f32x4* gr = (const f32x4*)a.in[I_FINN]; f32x4* orow = (f32x4*)(H + (size_t)m * DM);
#pragma unroll
            for (int j = 0; j < 4; ++j) { const v4u w = xr[64 * j]; const int c4 = (64 * j + lane) * 2;
                const f32x4 g0 = gr[c4], g1 = gr[c4 + 1];
                orow[c4] = (f32x4){pg8::bf_lo(w.x) * rs * g0.x, pg8::bf_hi(w.x) * rs * g0.y, pg8::bf_lo(w.y) * rs * g0.z, pg8::bf_hi(w.y) * rs * g0.w};
                orow[c4 + 1] = (f32x4){pg8::bf_lo(w.z) * rs * g1.x, pg8::bf_hi(w.z) * rs * g1.y, pg8::bf_lo(w.w) * rs * g1.z, pg8::bf_hi(w.w) * rs * g1.w}; }
        }
    }
    if (MK_PROBE_K >= 0 && bx == 0 && tid == 0) {
        const unsigned long long te = __builtin_amdgcn_s_memrealtime(); const unsigned long long t1 = (MK_PROBE_K == N_PHASES - 1) ? te : stamps[1];
        const unsigned long long dt = (t1 - stamps[0]) * MK_PROBE_MULT;
        while (__builtin_amdgcn_s_memrealtime() - te < dt) __builtin_amdgcn_s_sleep(32);
    }
#ifdef MK_SEC
    if (MK_SEC && bx == 0 && tid == 0) { const unsigned long long te = __builtin_amdgcn_s_memrealtime(), dt = (unsigned long long)(*(volatile LAS unsigned*)(lds + 152592)) * MK_PROBE_MULT; while (__builtin_amdgcn_s_memrealtime() - te < dt) __builtin_amdgcn_s_sleep(32); }
#endif
#undef IN
#undef SEAM
}

#ifndef MK_ONE_LAUNCH
#define MK_ONE_LAUNCH 1
#endif
extern "C" void kernel_launch(void* const* d_in, const int* in_sizes, int n_in, void* d_out, int out_size, void* d_ws, size_t ws_size, hipStream_t stream) {
    static int grid = 0;
    if (grid == 0) {
        if (n_in != 23 || out_size != M * DM || ws_size < WS_END) { fprintf(stderr, "kernel_launch: unexpected shapes (n_in %d out %d ws %zu)\n", n_in, out_size, ws_size); grid = -1; return; }
        int dev = 0, cus = 0, per_cu = 0;
        (void)hipGetDevice(&dev); (void)hipDeviceGetAttribute(&cus, hipDeviceAttributeMultiprocessorCount, dev);
        if (hipFuncSetAttribute((const void*)mk_fwd, hipFuncAttributeMaxDynamicSharedMemorySize, LDS_BYTES) != hipSuccess) { fprintf(stderr, "kernel_launch: hipFuncSetAttribute failed\n"); grid = -1; return; }
        if (hipOccupancyMaxActiveBlocksPerMultiprocessor(&per_cu, (const void*)mk_fwd, NWAVES * 64, LDS_BYTES) != hipSuccess || per_cu < 1) { fprintf(stderr, "kernel_launch: occupancy query says %d\n", per_cu); per_cu = 1; }
        (void)hipGetLastError();
        grid = cus > 0 ? cus : 256;
    }
    if (grid < 0) return;
    Args a{};
    for (int i = 0; i < 23; ++i) a.in[i] = (const float*)d_in[i];
    a.out = (float*)d_out; a.ws = (unsigned char*)d_ws;
#if MK_ONE_LAUNCH
    (void)hipMemsetAsync((char*)d_ws + WS_CTL, 0, CTL_BYTES, stream);
    a.ph_lo = 0; a.ph_hi = N_PHASES;
    void* args[] = {&a};
    hipError_t e = hipLaunchCooperativeKernel((const void*)mk_fwd, dim3(grid), dim3(NWAVES * 64), args, LDS_BYTES, stream);
    if (e != hipSuccess) fprintf(stderr, "kernel_launch: cooperative launch failed: %s (grid %d)\n", hipGetErrorString(e), grid);
#else
    for (int p = 0; p < N_PHASES; ++p) { a.ph_lo = p; a.ph_hi = p + 1; hipLaunchKernelGGL(mk_fwd, dim3(grid), dim3(NWAVES * 64), LDS_BYTES, stream, a); }
#endif
}
```
